# Optimizing an MI355X kernel written in HIP

```python
import jax, jax.numpy as jnp
from jax import lax
import numpy as np

D_MODEL = 1024
BATCH = 4
SEQ = 8192
DEPTH = 2
DEC_BATCH = 16
DEC_SEQ = 16
PAST_LEN = 1024

CHUNK = 64
D_FF = 2816
CONV_W = 4
LRU_W = D_MODEL
LRU_BLOCKS = 8
LRU_BD = LRU_W // LRU_BLOCKS
LRU_C = 8.0
M_HEADS = 4
M_W = D_MODEL
M_HD = M_W // M_HEADS
R_HD = 64
R_W = D_MODEL
R_HEADS = R_W // R_HD
R_LORA_W = 64
R_LORA_A = 64
R_LORA_G = 128
N_BRANCH = 3
BR_W = D_MODEL
CONV_CH = LRU_W + 2 * M_W
R_IN = 3 * R_W + R_LORA_W + R_LORA_A + R_LORA_G
IN_SPLITS = [CONV_CH, CONV_CH + M_W, CONV_CH + 2 * M_W, CONV_CH + 2 * M_W + 2 * M_HEADS,
             CONV_CH + 2 * M_W + 2 * M_HEADS + R_IN]
IN_W = CONV_CH + 2 * M_W + 2 * M_HEADS + R_IN + N_BRANCH * D_MODEL
R_SPLITS = [R_W, 2 * R_W, 3 * R_W, 3 * R_W + R_LORA_W, 3 * R_W + R_LORA_W + R_LORA_A]
RMS_EPS = 1e-6
MH_EPS = 1e-6
RWKV_GN_EPS = 64e-5
N_STATE = 7

kernel_name = "hybrid_lru_mlstm_rwkv7_stream_step"


def rms_norm(x, g):
    xf = x.astype(jnp.float32)
    y = xf * lax.rsqrt(jnp.mean(xf * xf, axis=-1, keepdims=True) + RMS_EPS)
    return (y * g.astype(jnp.float32)).astype(x.dtype)


def head_layer_norm(h, eps):
    d = h - jnp.mean(h, axis=-1, keepdims=True)
    return d * lax.rsqrt(jnp.mean(d * d, axis=-1, keepdims=True) + eps)


def swiglu(x, w_gate, w_up, w_down):
    return (jax.nn.silu(x @ w_gate) * (x @ w_up)) @ w_down


def causal_conv(x, prev, w, b):
    t = x.shape[1]
    xp = jnp.concatenate([prev.astype(x.dtype), x], axis=1)
    y = b + xp[:, 0:t] * w[0]
    for j in range(1, CONV_W):
        y = y + xp[:, j:j + t] * w[j]
    return y, xp[:, t:]


def rg_lru(x, h0, wa, ba, wx, bx, lam):
    bsz, t, _ = x.shape
    xb = x.reshape(bsz, t, LRU_BLOCKS, LRU_BD)
    r = jax.nn.sigmoid(jnp.einsum("btni,nij->btnj", xb, wa).reshape(bsz, t, LRU_W) + ba)
    i = jax.nn.sigmoid(jnp.einsum("btni,nij->btnj", xb, wx).reshape(bsz, t, LRU_W) + bx)
    log_a = -LRU_C * r * jax.nn.softplus(-lam)
    a = jnp.exp(log_a)
    b = jnp.sqrt(-jnp.expm1(2.0 * log_a)) * (i * x)
    b = b.at[:, 0].add(a[:, 0] * h0)

    def combine(l, rr):
        return (l[0] * rr[0], rr[0] * l[1] + rr[1])

    _, h = lax.associative_scan(combine, (a, b), axis=1)
    return h, h[:, -1]


def mlstm_block(carry, inp):
    c_prev, n_prev, m_prev = carry
    q, k, v, ig, lf = inp
    lb = q.shape[1]
    bcum = jnp.cumsum(lf, axis=1)
    dmat = bcum[:, :, None, :] - bcum[:, None, :, :] + ig[:, None, :, :]
    causal = jnp.tril(jnp.ones((lb, lb), bool))
    dmat = jnp.where(causal[None, :, :, None], dmat, -jnp.inf)
    inter = bcum + m_prev[:, None, :]
    m_t = jnp.maximum(inter, jnp.max(dmat, axis=2))
    w_intra = jnp.exp(dmat - m_t[:, :, None, :])
    w_inter = jnp.exp(inter - m_t)
    s = jnp.einsum("bthd,bshd->btsh", q, k) * w_intra
    num = jnp.einsum("btsh,bshv->bthv", s, v) + w_inter[..., None] * jnp.einsum("bhvd,bthd->bthv", c_prev, q)
    den = jnp.sum(s, axis=2) + w_inter * jnp.einsum("bhd,bthd->bth", n_prev, q)
    h = num / jnp.maximum(jnp.abs(den), jnp.exp(-m_t))[..., None]
    m_new = m_t[:, -1]
    g_state = jnp.exp(bcum[:, -1] + m_prev - m_new)
    g_src = jnp.exp(bcum[:, -1:, :] - bcum + ig - m_new[:, None, :])
    c_new = g_state[..., None, None] * c_prev + jnp.einsum("bsh,bshv,bshd->bhvd", g_src, v, k)
    n_new = g_state[..., None] * n_prev + jnp.einsum("bsh,bshd->bhd", g_src, k)
    return (c_new, n_new, m_new), h


def mlstm(q, k, v, ig, lf, c0, n0, m0):
    bsz, t, nh, hd = q.shape
    lb = min(CHUNK, t)
    nc = t // lb

    def to_blocks(a):
        return jnp.moveaxis(a.reshape((bsz, nc, lb) + a.shape[2:]), 1, 0)

    (c, n, m), h = lax.scan(mlstm_block, (c0, n0, m0),
                            (to_blocks(q), to_blocks(k), to_blocks(v), to_blocks(ig), to_blocks(lf)))
    h = jnp.moveaxis(h, 0, 1).reshape(bsz, t, nh, hd)
    return h, c, n, m


def rwkv7_scan(r, w, k, v, a_vec, b_vec, s0):
    def step(s, inp):
        r_t, w_t, k_t, v_t, a_t, b_t = inp
        sa = jnp.einsum("bhij,bhj->bhi", s, a_t)
        s = s * w_t[:, :, None, :] + sa[..., None] * b_t[:, :, None, :] + v_t[..., None] * k_t[:, :, None, :]
        return s, jnp.einsum("bhij,bhj->bhi", s, r_t)

    seq = tuple(jnp.moveaxis(a, 1, 0) for a in (r, w, k, v, a_vec, b_vec))
    s, y = lax.scan(step, s0, seq)
    return jnp.moveaxis(y, 0, 1), s


def rwkv7(xs, s0, lp):
    bsz, t, _ = xs.shape
    r, k, v, wd, ad, gd = jnp.split(xs, R_SPLITS, axis=-1)
    w_log = -jax.nn.softplus(-(lp["rwkv_w0"] + jnp.tanh(wd) @ lp["rwkv_w2"])) - 0.5
    decay = jnp.exp(-jnp.exp(w_log))
    a = jax.nn.sigmoid(lp["rwkv_a0"] + ad @ lp["rwkv_a2"])
    g = jax.nn.sigmoid(gd) @ lp["rwkv_g2"]

    def heads(y):
        return y.reshape(bsz, t, R_HEADS, R_HD)

    kk = heads(k * lp["rwkv_k_k"])
    kk = kk * lax.rsqrt(jnp.maximum(jnp.sum(kk * kk, axis=-1, keepdims=True), 1e-24))
    k = k * (1.0 + (a - 1.0) * lp["rwkv_k_a"])
    r_h, k_h, v_h, a_h = heads(r), heads(k), heads(v), heads(a)
    y, s = rwkv7_scan(r_h, heads(decay), k_h, v_h, -kk, kk * a_h, s0)
    y = (head_layer_norm(y, RWKV_GN_EPS) * lp["rwkv_ln_w"].reshape(R_HEADS, R_HD)
         + lp["rwkv_ln_b"].reshape(R_HEADS, R_HD))
    y = y + jnp.sum(r_h * k_h * lp["rwkv_r_k"], axis=-1, keepdims=True) * v_h
    return y.reshape(bsz, t, R_W) * g, s


def token_mix(u, st, lp):
    conv_prev, lru_h, m_c, m_n, m_m, shift_prev, rwkv_s = st
    f32 = jnp.float32
    bsz, t, _ = u.shape
    z = u @ lp["w_in"]
    z_conv, z_mv, z_mo, z_if, z_rw, z_gate = jnp.split(z, IN_SPLITS, axis=-1)

    c, conv_new = causal_conv(z_conv, conv_prev, lp["conv_w"], lp["conv_b"])
    c = c.astype(f32)

    h_lru, lru_new = rg_lru(c[..., :LRU_W], lru_h.astype(f32), lp["lru_wa"], lp["lru_ba"],
                            lp["lru_wx"], lp["lru_bx"], lp["lru_lambda"])

    qk = jax.nn.silu(c[..., LRU_W:])
    q = qk[..., :M_W].reshape(bsz, t, M_HEADS, M_HD)
    k = qk[..., M_W:].reshape(bsz, t, M_HEADS, M_HD) * (M_HD ** -0.5)
    v = z_mv.astype(f32).reshape(bsz, t, M_HEADS, M_HD)
    gif = z_if.astype(f32) + lp["mlstm_if_bias"]
    ig = gif[..., :M_HEADS]
    lf = jax.nn.log_sigmoid(gif[..., M_HEADS:])
    h_m, c_new, n_new, m_new = mlstm(q, k, v, ig, lf, m_c.astype(f32), m_n.astype(f32), m_m.astype(f32))
    h_m = head_layer_norm(h_m, MH_EPS).reshape(bsz, t, M_W) * lp["mlstm_norm"]
    o_m = jax.nn.sigmoid(z_mo.astype(f32)) * h_m

    zr = z_rw.astype(f32)
    zp = jnp.concatenate([shift_prev.astype(f32), zr], axis=1)
    xs = zr + (zp[:, :-1] - zr) * lp["rwkv_mu"]
    shift_new = zr[:, -1:]
    o_r, s_new = rwkv7(xs, rwkv_s.astype(f32), lp)

    outs = jnp.stack([h_lru, o_m, o_r], axis=2)
    proj = jnp.einsum("btgc,gcd->btgd", outs, lp["w_branch"])
    gates = jax.nn.sigmoid(z_gate.astype(f32).reshape(bsz, t, N_BRANCH, D_MODEL))
    y = jnp.sum(gates * proj, axis=2) @ lp["w_out"]
    return y.astype(u.dtype), (conv_new, lru_new, c_new, n_new, m_new, shift_new, s_new)


def layer(x, st, lp):
    x = x + 0.5 * swiglu(rms_norm(x, lp["ffn1_norm"]), lp["ffn1_w_gate"], lp["ffn1_w_up"], lp["ffn1_w_down"])
    mix, new_st = token_mix(rms_norm(x, lp["mix_norm"]), st, lp)
    x = x + mix
    x = x + 0.5 * swiglu(rms_norm(x, lp["ffn2_norm"]), lp["ffn2_w_gate"], lp["ffn2_w_up"], lp["ffn2_w_down"])
    return x, new_st


def run_trunk(x, states, params, final_norm):
    new_states = []
    for l in range(DEPTH):
        lp = {name: w[l] for name, w in params.items()}
        x, st = layer(x, states[l], lp)
        new_states.append(st)
    stacked = tuple(jnp.stack([st[i] for st in new_states]) for i in range(N_STATE))
    return rms_norm(x, final_norm), stacked


def zero_states(bsz):
    f32 = jnp.float32
    return (jnp.zeros((bsz, CONV_W - 1, CONV_CH), f32), jnp.zeros((bsz, LRU_W), f32),
            jnp.zeros((bsz, M_HEADS, M_HD, M_HD), f32), jnp.zeros((bsz, M_HEADS, M_HD), f32),
            jnp.zeros((bsz, M_HEADS), f32), jnp.zeros((bsz, 1, R_IN), f32),
            jnp.zeros((bsz, R_HEADS, R_HD, R_HD), f32))


def setup_inputs(seed: int = 0) -> dict:
    key = jax.random.key(seed)
    keys = iter(jax.random.split(key, 64))

    def nrm(shape, scale):
        return scale * jax.random.normal(next(keys), shape, jnp.float32)

    def unif(shape, lo, hi):
        return jax.random.uniform(next(keys), shape, jnp.float32, lo, hi)

    L = DEPTH
    lam_a = unif((L, LRU_W), 0.9, 0.999) ** (1.0 / LRU_C)
    if_bias = jnp.concatenate([nrm((L, M_HEADS), 0.1),
                               jnp.broadcast_to(jnp.linspace(3.0, 6.0, M_HEADS), (L, M_HEADS))
                               + nrm((L, M_HEADS), 0.01)], axis=-1)
    return {
        "x_prompt": nrm((BATCH, SEQ, D_MODEL), 1.0),
        "x_sample": nrm((DEC_BATCH, DEC_SEQ, D_MODEL), 1.0),
        "state_conv": nrm((L, DEC_BATCH, CONV_W - 1, CONV_CH), 1.0),
        "state_lru_h": nrm((L, DEC_BATCH, LRU_W), 0.5),
        "state_mlstm_C": nrm((L, DEC_BATCH, M_HEADS, M_HD, M_HD), 0.05),
        "state_mlstm_n": nrm((L, DEC_BATCH, M_HEADS, M_HD), 0.05),
        "state_mlstm_m": nrm((L, DEC_BATCH, M_HEADS), 0.5),
        "state_rwkv_shift": nrm((L, DEC_BATCH, 1, R_IN), 1.0),
        "state_rwkv_S": nrm((L, DEC_BATCH, R_HEADS, R_HD, R_HD), 0.1),
        "ffn1_norm": 1.0 + nrm((L, D_MODEL), 0.02),
        "ffn1_w_gate": nrm((L, D_MODEL, D_FF), D_MODEL ** -0.5),
        "ffn1_w_up": nrm((L, D_MODEL, D_FF), D_MODEL ** -0.5),
        "ffn1_w_down": nrm((L, D_FF, D_MODEL), D_FF ** -0.5),
        "mix_norm": 1.0 + nrm((L, D_MODEL), 0.02),
        "w_in": nrm((L, D_MODEL, IN_W), D_MODEL ** -0.5),
        "conv_w": nrm((L, CONV_W, CONV_CH), 0.5),
        "conv_b": nrm((L, CONV_CH), 0.01),
        "lru_wa": nrm((L, LRU_BLOCKS, LRU_BD, LRU_BD), LRU_BD ** -0.5),
        "lru_ba": nrm((L, LRU_W), 0.01),
        "lru_wx": nrm((L, LRU_BLOCKS, LRU_BD, LRU_BD), LRU_BD ** -0.5),
        "lru_bx": nrm((L, LRU_W), 0.01),
        "lru_lambda": jnp.log(lam_a) - jnp.log1p(-lam_a),
        "mlstm_if_bias": if_bias,
        "mlstm_norm": 1.0 + nrm((L, M_W), 0.02),
        "rwkv_mu": unif((L, R_IN), 0.0, 1.0),
        "rwkv_w0": unif((L, R_W), -6.0, 1.0),
        "rwkv_w2": nrm((L, R_LORA_W, R_W), 0.1),
        "rwkv_a0": nrm((L, R_W), 0.1),
        "rwkv_a2": nrm((L, R_LORA_A, R_W), 0.5 * R_LORA_A ** -0.5),
        "rwkv_g2": nrm((L, R_LORA_G, R_W), R_LORA_G ** -0.5),
        "rwkv_k_k": 0.85 + nrm((L, R_W), 0.02),
        "rwkv_k_a": 1.0 + nrm((L, R_W), 0.02),
        "rwkv_r_k": nrm((L, R_HEADS, R_HD), 0.1),
        "rwkv_ln_w": 1.0 + nrm((L, R_W), 0.02),
        "rwkv_ln_b": nrm((L, R_W), 0.01),
        "w_branch": nrm((L, N_BRANCH, BR_W, D_MODEL), BR_W ** -0.5),
        "w_out": nrm((L, D_MODEL, D_MODEL), D_MODEL ** -0.5),
        "ffn2_norm": 1.0 + nrm((L, D_MODEL), 0.02),
        "ffn2_w_gate": nrm((L, D_MODEL, D_FF), D_MODEL ** -0.5),
        "ffn2_w_up": nrm((L, D_MODEL, D_FF), D_MODEL ** -0.5),
        "ffn2_w_down": nrm((L, D_FF, D_MODEL), D_FF ** -0.5),
        "final_norm": 1.0 + nrm((D_MODEL,), 0.02),
    }


def reference(x_prompt, x_sample, state_conv, state_lru_h, state_mlstm_C, state_mlstm_n,
              state_mlstm_m, state_rwkv_shift, state_rwkv_S,
              ffn1_norm, ffn1_w_gate, ffn1_w_up, ffn1_w_down, mix_norm, w_in, conv_w, conv_b,
              lru_wa, lru_ba, lru_wx, lru_bx, lru_lambda, mlstm_if_bias, mlstm_norm,
              rwkv_mu, rwkv_w0, rwkv_w2, rwkv_a0, rwkv_a2, rwkv_g2, rwkv_k_k, rwkv_k_a, rwkv_r_k,
              rwkv_ln_w, rwkv_ln_b, w_branch, w_out,
              ffn2_norm, ffn2_w_gate, ffn2_w_up, ffn2_w_down, final_norm):
    params = dict(ffn1_norm=ffn1_norm, ffn1_w_gate=ffn1_w_gate, ffn1_w_up=ffn1_w_up, ffn1_w_down=ffn1_w_down,
                  mix_norm=mix_norm, w_in=w_in, conv_w=conv_w, conv_b=conv_b,
                  lru_wa=lru_wa, lru_ba=lru_ba, lru_wx=lru_wx, lru_bx=lru_bx, lru_lambda=lru_lambda,
                  mlstm_if_bias=mlstm_if_bias, mlstm_norm=mlstm_norm,
                  rwkv_mu=rwkv_mu, rwkv_w0=rwkv_w0, rwkv_w2=rwkv_w2, rwkv_a0=rwkv_a0, rwkv_a2=rwkv_a2,
                  rwkv_g2=rwkv_g2, rwkv_k_k=rwkv_k_k, rwkv_k_a=rwkv_k_a, rwkv_r_k=rwkv_r_k,
                  rwkv_ln_w=rwkv_ln_w, rwkv_ln_b=rwkv_ln_b, w_branch=w_branch, w_out=w_out,
                  ffn2_norm=ffn2_norm, ffn2_w_gate=ffn2_w_gate, ffn2_w_up=ffn2_w_up, ffn2_w_down=ffn2_w_down)
    states_p = [zero_states(x_prompt.shape[0]) for _ in range(DEPTH)]
    y_prompt, (p_conv, p_lru_h, p_mlstm_C, p_mlstm_n, p_mlstm_m, p_rwkv_shift, p_rwkv_S) = run_trunk(
        x_prompt, states_p, params, final_norm)
    states_s = [(state_conv[l], state_lru_h[l], state_mlstm_C[l], state_mlstm_n[l], state_mlstm_m[l],
                 state_rwkv_shift[l], state_rwkv_S[l]) for l in range(DEPTH)]
    y_sample, (s_conv, s_lru_h, s_mlstm_C, s_mlstm_n, s_mlstm_m, s_rwkv_shift, s_rwkv_S) = run_trunk(
        x_sample, states_s, params, final_norm)
    return (y_prompt, y_sample,
            p_conv, p_lru_h, p_mlstm_C, p_mlstm_n, p_mlstm_m, p_rwkv_shift, p_rwkv_S,
            s_conv, s_lru_h, s_mlstm_C, s_mlstm_n, s_mlstm_m, s_rwkv_shift, s_rwkv_S)
```

```cpp
#include <hip/hip_runtime.h>
#include <hip/hip_cooperative_groups.h>
#include <cstdio>
namespace cg = cooperative_groups;
namespace pg8 {
#define PG8_LAS __attribute__((address_space(3)))
typedef unsigned short bf16_t;
typedef short bf16x8 __attribute__((ext_vector_type(8)));
typedef float f32x4 __attribute__((ext_vector_type(4)));
typedef unsigned u32x4 __attribute__((ext_vector_type(4)));
constexpr int BM = 256, BK = 64, HALF = 128, HTB = HALF * BK * 2  , STAGE_BYTES = 8 * HTB, NXCD = 8, WGM = 8;
__host__ __device__ __forceinline__ int lds_byte(int r, int c) { const int st = (r >> 4) * 2 + (c >> 5), rr = r & 15, cc = c & 31, ob = rr * 64 + cc * 2; return st * 1024 + (ob ^ (((ob >> 9) & 1) << 5)); }
__host__ __device__ __forceinline__ void stage_rc(int b, int& R, int& C) { const int st = b / 1024, sb = b % 1024, swz = sb ^ (((sb >> 9) & 1) << 5); R = (st >> 1) * 16 + swz / 64; C = (st & 1) * 32 + (swz % 64) / 2; }
__host__ __device__ __forceinline__ int perm32(int rho) { const int n = rho >> 4, i = rho & 15; return 8 * (i >> 2) + 4 * n + (i & 3); }
struct Unit { int pm, pn; };
struct Gemm { const bf16_t* A; int lda; const bf16_t* Bt; int ldb; int M, N, K; int amod, astride; int ksn, kchunk;
    __device__ __forceinline__ size_t acol(int pn) const { return (amod ? (size_t)((pn % amod) * astride) * 2 : (size_t)0) + (ksn ? (size_t)((pn / ksn) * kchunk) * 2 : (size_t)0); }
    __device__ __forceinline__ size_t boff(int pn, size_t tstepB) const { return ksn ? (size_t)(pn % ksn) * tstepB + (size_t)((pn / ksn) * kchunk) * 2 : (size_t)pn * tstepB; } };
struct StaticOrder {
    int nM, nN, nwg, G, c;
    __host__ __device__ void init(int M, int N, int G_, int c_) { nM = M / BM; nN = N / BM; nwg = nM * nN; G = G_; c = c_; }
    __host__ __device__ bool next(int i, Unit& u) const {
        const long L = (long)i * G + c; if (L >= nwg) return false;
        int wgid = (int)L; { const int q = nwg / NXCD, r = nwg % NXCD, xcd = wgid % NXCD, off = wgid / NXCD; wgid = (xcd < r ? xcd * (q + 1) : r * (q + 1) + (xcd - r) * q) + off; }
        const int nig = WGM * nN, gid = wgid / nig, fm = gid * WGM, gsz = (nM - fm) < WGM ? (nM - fm) : WGM;
        u.pm = fm + ((wgid % nig) % gsz); u.pn = (wgid % nig) / gsz; return true;
    }
    __device__ __forceinline__ void a_ready(const Unit&) const {}
    __device__ __forceinline__ void done(const Unit&) const {}
};
__device__ __forceinline__ unsigned cvt_pk_bf16(float lo, float hi) { unsigned r; asm volatile("v_cvt_pk_bf16_f32 %0, %1, %2" : "=v"(r) : "v"(lo), "v"(hi)); return r; }
template <class Epi, class Sched>
__device__ __forceinline__ void gemm_phase(PG8_LAS unsigned char* lds, const Gemm g, const Sched& S, const Epi& E, const int tid_in) {
    const int tid = tid_in, wid = __builtin_amdgcn_readfirstlane(tid >> 6), lane = tid & 63, wr = wid >> 2, wc = wid & 3, fr = lane & 15, fq = lane >> 4;
    const int K = g.K, nt = K / BK;
    unsigned voffA[2], voffB[2];
#pragma unroll
    for (int i = 0; i < 2; ++i) { int R, C; stage_rc(tid * 16 + i * 8192, R, C); const int Rb = Epi::PERM ? ((R & ~31) + perm32(R & 31)) : R;
        voffA[i] = (unsigned)(R * g.lda + C) * 2u; voffB[i] = (unsigned)(Rb * g.ldb + C) * 2u; }
    const size_t kstep = (size_t)(BK * 2);
    const size_t hstepA = (size_t)HALF * g.lda * 2, hstepB = (size_t)HALF * g.ldb * 2;
    const size_t tstepA = 2 * hstepA, tstepB = 2 * hstepB;
    const unsigned ldsw = (unsigned)wid * 1024u;
    const int aoff = lds_byte(wr * 64 + fr, fq * 8), boff = lds_byte(wc * 32 + fr, fq * 8);
#define PG8_SA(b, h) (((b) * 2 + (h)) * HTB)
#define PG8_SB(b, h) ((4 + (b) * 2 + (h)) * HTB)
#define PG8_STAGE(bufoff, gbase, voff) do { _Pragma("unroll") for (int _i = 0; _i < 2; ++_i) \
        __builtin_amdgcn_global_load_lds((const unsigned*)((const char*)(gbase) + (voff)[_i]), (PG8_LAS unsigned*)(lds + (bufoff) + ldsw + _i * 8192), 16, 0, 0); } while (0)
#define PG8_LDA(dst, b, h) do { _Pragma("unroll") for (int m = 0; m < 4; ++m) _Pragma("unroll") for (int k = 0; k < 2; ++k) dst[m][k] = *(const PG8_LAS bf16x8*)(lds + PG8_SA(b, h) + aoff + m * 2048 + k * 1024); } while (0)
#define PG8_LDB(dst, b, h) do { _Pragma("unroll") for (int n = 0; n < 2; ++n) _Pragma("unroll") for (int k = 0; k < 2; ++k) dst[n][k] = *(const PG8_LAS bf16x8*)(lds + PG8_SB(b, h) + boff + n * 2048 + k * 1024); } while (0)
#define PG8_MMA(ai, bj, At, Bt) do { __builtin_amdgcn_s_setprio(1); _Pragma("unroll") for (int m = 0; m < 4; ++m) _Pragma("unroll") for (int n = 0; n < 2; ++n) _Pragma("unroll") for (int k = 0; k < 2; ++k) \
        acc[ai][bj][m][n] = __builtin_amdgcn_mfma_f32_16x16x32_bf16(Bt[n][k], At[m][k], acc[ai][bj][m][n], 0, 0, 0); __builtin_amdgcn_s_setprio(0); } while (0)
#define PG8_WAIT_V(n) asm volatile("s_waitcnt vmcnt(" #n ")" ::: "memory")
#define PG8_WAIT_L(n) asm volatile("s_waitcnt lgkmcnt(" #n ")" ::: "memory")
#define PG8_BAR __builtin_amdgcn_s_barrier()
#define PG8_SCHED __builtin_amdgcn_sched_barrier(0)
    Unit cur, nxt; int ui = 0;
    if (!S.next(0, cur)) return;
    f32x4 acc[2][2][4][2];
#pragma unroll
    for (int a = 0; a < 2; ++a)
#pragma unroll
        for (int b = 0; b < 2; ++b)
#pragma unroll
            for (int m = 0; m < 4; ++m)
#pragma unroll
                for (int n = 0; n < 2; ++n) acc[a][b][m][n] = (f32x4){0.f, 0.f, 0.f, 0.f};
    bf16x8 At[4][2], B0[2][2], B1[2][2];
    const char* cA = (const char*)g.A + (size_t)cur.pm * tstepA + g.acol(cur.pn); const char* cB = (const char*)g.Bt + g.boff(cur.pn, tstepB);
    S.a_ready(cur);
    PG8_STAGE(PG8_SB(0, 0), cB, voffB); PG8_STAGE(PG8_SA(0, 0), cA, voffA); PG8_STAGE(PG8_SB(0, 1), cB + hstepB, voffB); PG8_STAGE(PG8_SA(0, 1), cA + hstepA, voffA);
    if (wr == 1) PG8_BAR;
    PG8_WAIT_V(4); PG8_BAR;
    PG8_STAGE(PG8_SB(1, 0), cB + kstep, voffB); PG8_STAGE(PG8_SA(1, 0), cA + kstep, voffA); PG8_STAGE(PG8_SB(1, 1), cB + hstepB + kstep, voffB);
    PG8_WAIT_V(6); PG8_BAR;
    for (;;) {
        const bool has_next = S.next(ui + 1, nxt);
        const char* nA = has_next ? (const char*)g.A + (size_t)nxt.pm * tstepA + g.acol(nxt.pn) : cA; const char* nB = has_next ? (const char*)g.Bt + g.boff(nxt.pn, tstepB) : cB;
        for (int t = 0; t < nt; t += 2) {
            const bool last = (t == nt - 2);
            const char* a1 = cA + (size_t)(t + 1) * kstep;
            const char* a2 = last ? nA : cA + (size_t)(t + 2) * kstep; const char* b2 = last ? nB : cB + (size_t)(t + 2) * kstep;
            const char* a3 = a2 + kstep; const char* b3 = b2 + kstep;
            if (last && has_next) S.a_ready(nxt);
            PG8_LDB(B0, 0, 0); PG8_SCHED; PG8_LDA(At, 0, 0); PG8_STAGE(PG8_SA(1, 1), a1 + hstepA, voffA);
            PG8_WAIT_L(8); PG8_BAR; PG8_WAIT_L(0); PG8_MMA(0, 0, At, B0); PG8_BAR; PG8_SCHED;
            PG8_LDB(B1, 0, 1); PG8_STAGE(PG8_SB(0, 0), b2, voffB);
            PG8_BAR; PG8_WAIT_L(0); PG8_MMA(0, 1, At, B1); PG8_BAR;
            PG8_LDA(At, 0, 1); PG8_STAGE(PG8_SA(0, 0), a2, voffA);
            PG8_BAR; PG8_WAIT_L(0); PG8_MMA(1, 0, At, B0); PG8_BAR; PG8_SCHED;
            PG8_STAGE(PG8_SB(0, 1), b2 + hstepB, voffB);
            PG8_WAIT_V(6); PG8_BAR; PG8_MMA(1, 1, At, B1); PG8_BAR;
            PG8_LDB(B0, 1, 0); PG8_SCHED; PG8_LDA(At, 1, 0); PG8_STAGE(PG8_SA(0, 1), a2 + hstepA, voffA);
            PG8_WAIT_L(8); PG8_BAR; PG8_WAIT_L(0); PG8_MMA(0, 0, At, B0); PG8_BAR; PG8_SCHED;
            PG8_LDB(B1, 1, 1); PG8_STAGE(PG8_SB(1, 0), b3, voffB);
            PG8_BAR; PG8_WAIT_L(0); PG8_MMA(0, 1, At, B1); PG8_BAR;
            PG8_LDA(At, 1, 1); PG8_STAGE(PG8_SA(1, 0), a3, voffA);
            PG8_BAR; PG8_WAIT_L(0); PG8_MMA(1, 0, At, B0); PG8_BAR; PG8_SCHED;
            PG8_STAGE(PG8_SB(1, 1), b3 + hstepB, voffB);
            PG8_WAIT_V(6); PG8_BAR; PG8_MMA(1, 1, At, B1); PG8_BAR;
        }
        if constexpr (!Epi::AFTER_DRAIN) { E(acc, cur, wr, wc, fr, fq); S.done(cur); }
        if (!has_next) break;
#pragma unroll
        for (int a = 0; a < 2; ++a)
#pragma unroll
            for (int b = 0; b < 2; ++b)
#pragma unroll
                for (int m = 0; m < 4; ++m)
#pragma unroll
                    for (int n = 0; n < 2; ++n) acc[a][b][m][n] = (f32x4){0.f, 0.f, 0.f, 0.f};
        cur = nxt; cA = nA; cB = nB; ++ui;
    }
    PG8_WAIT_V(0);
    if (wr == 0) PG8_BAR;
    PG8_BAR;
    if constexpr (Epi::AFTER_DRAIN) { E.fused(acc, cur, wr, wc, fr, fq, lds, wid, lane); S.done(cur); }
#undef PG8_SA
#undef PG8_SB
#undef PG8_STAGE
#undef PG8_LDA
#undef PG8_LDB
#undef PG8_MMA
#undef PG8_WAIT_V
#undef PG8_WAIT_L
#undef PG8_BAR
#undef PG8_SCHED
}

}

#define LAS __attribute__((address_space(3)))
typedef unsigned short bf16_t;
typedef short bf16x8 __attribute__((ext_vector_type(8)));
typedef float f32x4 __attribute__((ext_vector_type(4)));
typedef unsigned u32x4 __attribute__((ext_vector_type(4)));
typedef unsigned u32x2 __attribute__((ext_vector_type(2)));

constexpr int D = 1024, FF = 2816, NTOK = 33024, NPROMPT = 32768, SEQ = 8192, DSEQ = 16, NB = 4, DB = 16;
constexpr int ZW = 8448, C_LRU = 0, C_Q = 1024, C_K = 2048, C_V = 3072, C_O = 4096, C_R = 5120, C_RK = 6144, C_RV = 7168, C_WD = 8192;
constexpr int INW = 11528, CONVCH = 3072, RIN = 3328;
constexpr int NTHREADS = 512;
constexpr int LDS_BYTES = 147456;

constexpr size_t W_GU1 = 0, W_D1 = 11534336, W_GU2 = 17301504, W_D2 = 28835840, W_IN = 34603008, W_G = 51904512, W_LRU = 58195968, W_LORA = 59244544,
                 W_BR = 60817408, W_OUT = 67108864, W_IF = 69206016;
constexpr size_t WS_BAR = 513229056, WS_SL = 504316160;
constexpr size_t WS_UP = 69238784, WS_Z = 103317504, WS_T = 384466944, WS_HALO = 486703104, WS_GIF = 500490240, WS_CAR = 501022720, WS_BONUS = 503250944, WS_END = 513229056 + 4096;

constexpr size_t O_Y = 0, O_PCONV = 33816576, O_PLRU = O_PCONV + 73728, O_PMC = O_PLRU + 8192, O_PMN = O_PMC + 2097152, O_PMM = O_PMN + 8192, O_PSH = O_PMM + 32,
                 O_PRS = O_PSH + 26624, O_SCONV = O_PRS + 524288, O_SLRU = O_SCONV + 294912, O_SMC = O_SLRU + 32768, O_SMN = O_SMC + 8388608, O_SMM = O_SMN + 32768,
                 O_SSH = O_SMM + 128, O_SRS = O_SSH + 106496, O_END = O_SRS + 2097152;

enum { I_XP = 0, I_XS, I_SCONV, I_SLRU, I_SMC, I_SMN, I_SMM, I_SSH, I_SRS, I_F1N, I_F1G, I_F1U, I_F1D, I_MIXN, I_WIN, I_CONVW, I_CONVB, I_LWA, I_LBA, I_LWX, I_LBX,
       I_LLAM, I_IFB, I_MNORM, I_MU, I_W0, I_W2, I_A0, I_A2, I_G2, I_KK, I_KA, I_RK, I_LNW, I_LNB, I_WBR, I_WOUT, I_F2N, I_F2G, I_F2U, I_F2D, I_FN, N_IN };

struct Args { const float* in[N_IN]; float* out; unsigned char* ws; int ph_lo, ph_hi; };

constexpr int TAB_OFF = LDS_BYTES - 512;
struct Ctx {
    float* out; unsigned char* ws; LAS unsigned char* lds;
    int tid, lane, wave, G, bid, dry;
};

__device__ __forceinline__ const float* inp(const Ctx& c, int i) {
    const LAS unsigned* t = (const LAS unsigned*)(c.lds + TAB_OFF);
    const unsigned lo = __builtin_amdgcn_readfirstlane(t[2 * i]), hi = __builtin_amdgcn_readfirstlane(t[2 * i + 1]);
    typedef const float __attribute__((address_space(1)))* gptr_t;
    return (const float*)(gptr_t)(((unsigned long long)hi << 32) | (unsigned long long)lo);
}
#define GAS __attribute__((address_space(1)))
__device__ __forceinline__ unsigned char* wsg(const Ctx& c) { return (unsigned char*)(GAS unsigned char*)(unsigned long long)c.ws; }
__device__ __forceinline__ float* outg(const Ctx& c) { return (float*)(GAS float*)(unsigned long long)c.out; }
__device__ __forceinline__ float bf2f(bf16_t b) { return __uint_as_float(((unsigned)b) << 16); }
__device__ __forceinline__ float bflo(unsigned w) { return __uint_as_float(w << 16); }
__device__ __forceinline__ float bfhi(unsigned w) { return __uint_as_float(w & 0xffff0000u); }
__device__ __forceinline__ bf16_t f2bf(float f) { unsigned u = __float_as_uint(f); u += 0x7FFFu + ((u >> 16) & 1u); return (bf16_t)(u >> 16); }
typedef __bf16 bf16v2_t __attribute__((ext_vector_type(2)));
typedef float f32v2_t __attribute__((ext_vector_type(2)));
__device__ __forceinline__ unsigned pk2(float lo, float hi) {
    const f32v2_t f = {lo, hi}; const bf16v2_t b = __builtin_convertvector(f, bf16v2_t); return __builtin_bit_cast(unsigned, b);
}
__device__ __forceinline__ void unpack8(const u32x4 w, float (&f)[8]) { f[0] = bflo(w.x); f[1] = bfhi(w.x); f[2] = bflo(w.y); f[3] = bfhi(w.y); f[4] = bflo(w.z); f[5] = bfhi(w.z); f[6] = bflo(w.w); f[7] = bfhi(w.w); }
__device__ __forceinline__ u32x4 pack8(const float (&f)[8]) { u32x4 w; w.x = pk2(f[0], f[1]); w.y = pk2(f[2], f[3]); w.z = pk2(f[4], f[5]); w.w = pk2(f[6], f[7]); return w; }
__device__ __forceinline__ float sigmoidf_(float x) { return __builtin_amdgcn_rcpf(1.0f + __expf(-x)); }
__device__ __forceinline__ float siluf_(float x) { return x * __builtin_amdgcn_rcpf(1.0f + __expf(-x)); }
__device__ __forceinline__ float softplusf_(float x) { return fmaxf(x, 0.f) + __logf(1.0f + __expf(-fabsf(x))); }
__device__ __forceinline__ float tanhf_(float x) { return 1.0f - 2.0f * __builtin_amdgcn_rcpf(__expf(2.0f * x) + 1.0f); }
__device__ __forceinline__ float wsum(float v) {
#pragma unroll
    for (int o = 32; o >= 1; o >>= 1) v += __shfl_xor(v, o);
    return v;
}

__device__ __forceinline__ int pass_rows(int p) { return p ? 16640 : 16384; }
__device__ __forceinline__ int pass_nseg(int p) { return p ? 272 : 256; }
__device__ __forceinline__ int pass_nseq(int p) { return p ? 18 : 2; }
struct Seq { int row0, T, sample, b; };
__device__ __forceinline__ Seq seq_of(int p, int q) { Seq s; if (q < 2) { s.row0 = q * SEQ; s.T = SEQ; s.sample = 0; s.b = 2 * p + q; } else { s.row0 = 16384 + (q - 2) * DSEQ; s.T = DSEQ; s.sample = 1; s.b = q - 2; } return s; }
struct Seg { int q, c, row0, n, nch; };
__device__ __forceinline__ Seg seg_of(int s) { Seg g; if (s < 256) { g.q = s >> 7; g.c = s & 127; g.row0 = g.q * SEQ + g.c * 64; g.n = 64; g.nch = 128; } else { g.q = 2 + (s - 256); g.c = 0; g.row0 = 16384 + (s - 256) * DSEQ; g.n = DSEQ; g.nch = 1; } return g; }

__device__ __forceinline__ void grid_bar(unsigned* bar, unsigned& epoch, unsigned G) {
    __syncthreads();
    epoch += 1u;
    if (threadIdx.x == 0) {
        const unsigned ng = (G & 15u) ? 1u : 16u, grp = blockIdx.x % ng, per = G / ng;
        unsigned* xc = bar + 64 + 32 * grp;
        const unsigned old = __hip_atomic_fetch_add(xc, 1u, __ATOMIC_ACQ_REL, __HIP_MEMORY_SCOPE_AGENT);
        if (old + 1u == epoch * per) __hip_atomic_fetch_add(bar, 1u, __ATOMIC_RELEASE, __HIP_MEMORY_SCOPE_AGENT);
        const unsigned target = epoch * ng;
        while (__hip_atomic_load(bar, __ATOMIC_RELAXED, __HIP_MEMORY_SCOPE_AGENT) < target) __builtin_amdgcn_s_sleep(1);
        __builtin_amdgcn_fence(__ATOMIC_ACQUIRE, "agent");
        asm volatile("s_waitcnt vmcnt(0)" ::: "memory");
    }
    __syncthreads();
}

struct EpiSwiglu {
    static constexpr bool PERM = true, AFTER_DRAIN = false;
    bf16_t* H;
    __device__ __forceinline__ void operator()(const f32x4 (&acc)[2][2][4][2], const pg8::Unit& u, int wr, int wc, int fr, int fq) const {
        const int row0 = u.pm * 256 + wr * 64 + fr, col0 = u.pn * 128 + wc * 32 + 8 * fq;
#pragma unroll
        for (int ai = 0; ai < 2; ++ai)
#pragma unroll
            for (int m = 0; m < 4; ++m) {
                float o[8];
#pragma unroll
                for (int n = 0; n < 2; ++n)
#pragma unroll
                    for (int j = 0; j < 4; ++j) o[4 * n + j] = siluf_(acc[ai][0][m][n][j]) * acc[ai][1][m][n][j];
                *(u32x4*)(H + (size_t)(row0 + ai * 128 + m * 16) * FF + col0) = pack8(o);
            }
    }
};
struct EpiResAdd {
    static constexpr bool PERM = false, AFTER_DRAIN = false;
    float* X; float s;
    __device__ __forceinline__ void operator()(const f32x4 (&acc)[2][2][4][2], const pg8::Unit& u, int wr, int wc, int fr, int fq) const {
        const int row0 = u.pm * 256 + wr * 64 + fr, col0 = u.pn * 256 + wc * 32 + 4 * fq;
#pragma unroll
        for (int ai = 0; ai < 2; ++ai)
#pragma unroll
            for (int m = 0; m < 4; ++m) {
                float* rowp = X + (size_t)(row0 + ai * 128 + m * 16) * D + col0;
#pragma unroll
                for (int bj = 0; bj < 2; ++bj)
#pragma unroll
                    for (int n = 0; n < 2; ++n) { f32x4* p = (f32x4*)(rowp + bj * 128 + n * 16); *p = *p + acc[ai][bj][m][n] * s; }
            }
    }
};
struct EpiResAddAtomic {
    static constexpr bool PERM = false, AFTER_DRAIN = false;
    float* X; float s;
    __device__ __forceinline__ void operator()(const f32x4 (&acc)[2][2][4][2], const pg8::Unit& u, int wr, int wc, int fr, int fq) const {
        const int row0 = u.pm * 256 + wr * 64 + fr, col0 = (u.pn & 3) * 256 + wc * 32 + 4 * fq;
#pragma unroll
        for (int ai = 0; ai < 2; ++ai)
#pragma unroll
            for (int m = 0; m < 4; ++m) {
                float* rowp = X + (size_t)(row0 + ai * 128 + m * 16) * D + col0;
#pragma unroll
                for (int bj = 0; bj < 2; ++bj)
#pragma unroll
                    for (int n = 0; n < 2; ++n)
#pragma unroll
                        for (int j = 0; j < 4; ++j) __hip_atomic_fetch_add(rowp + bj * 128 + n * 16 + j, acc[ai][bj][m][n][j] * s, __ATOMIC_RELAXED, __HIP_MEMORY_SCOPE_AGENT);
            }
    }
};
struct EpiStore {
    static constexpr bool PERM = true, AFTER_DRAIN = false;
    bf16_t* O; int ldc, coff;
    __device__ __forceinline__ void operator()(const f32x4 (&acc)[2][2][4][2], const pg8::Unit& u, int wr, int wc, int fr, int fq) const {
        const int row0 = u.pm * 256 + wr * 64 + fr, col0 = coff + u.pn * 256 + wc * 32 + 8 * fq;
#pragma unroll
        for (int ai = 0; ai < 2; ++ai)
#pragma unroll
            for (int m = 0; m < 4; ++m) {
                bf16_t* rowp = O + (size_t)(row0 + ai * 128 + m * 16) * ldc + col0;
#pragma unroll
                for (int bj = 0; bj < 2; ++bj) {
                    u32x4 w; w.x = pk2(acc[ai][bj][m][0][0], acc[ai][bj][m][0][1]); w.y = pk2(acc[ai][bj][m][0][2], acc[ai][bj][m][0][3]);
                    w.z = pk2(acc[ai][bj][m][1][0], acc[ai][bj][m][1][1]); w.w = pk2(acc[ai][bj][m][1][2], acc[ai][bj][m][1][3]);
                    *(u32x4*)(rowp + bj * 128) = w;
                }
            }
    }
};
struct EpiMerge {
    static constexpr bool PERM = true, AFTER_DRAIN = false;
    bf16_t* Mb; const bf16_t* Z; int goff, first;
    __device__ __forceinline__ void operator()(const f32x4 (&acc)[2][2][4][2], const pg8::Unit& u, int wr, int wc, int fr, int fq) const {
        const int row0 = u.pm * 256 + wr * 64 + fr, col0 = u.pn * 256 + wc * 32 + 8 * fq;
#pragma unroll
        for (int ai = 0; ai < 2; ++ai)
#pragma unroll
            for (int m = 0; m < 4; ++m) {
                const size_t row = (size_t)(row0 + ai * 128 + m * 16);
#pragma unroll
                for (int bj = 0; bj < 2; ++bj) {
                    float gt[8], mv[8], o[8];
                    unpack8(*(const u32x4*)(Z + row * ZW + goff + col0 + bj * 128), gt);
                    if (!first) unpack8(*(const u32x4*)(Mb + row * D + col0 + bj * 128), mv);
#pragma unroll
                    for (int n = 0; n < 2; ++n)
#pragma unroll
                        for (int j = 0; j < 4; ++j) o[4 * n + j] = (first ? 0.f : mv[4 * n + j]) + sigmoidf_(gt[4 * n + j]) * acc[ai][bj][m][n][j];
                    *(u32x4*)(Mb + row * D + col0 + bj * 128) = pack8(o);
                }
            }
    }
};

template <class Epi>
__device__ __forceinline__ void run_gemm(const Ctx& c, const bf16_t* A, int lda, const bf16_t* Bt, int ldb, int M, int N, int K, int amod, int astride, const Epi& E) {
    pg8::Gemm g{A, lda, Bt, ldb, M, N, K, amod, astride, 0, 0};
    pg8::StaticOrder S; S.init(M, N, c.G, c.bid);
    pg8::gemm_phase<Epi, pg8::StaticOrder>(c.lds, g, S, E, c.tid);
    __syncthreads();
}

__device__ __forceinline__ void run_gemm_splitk(const Ctx& c, const bf16_t* A, int lda, const bf16_t* Bt, int ldb, int K, float* X, float sc) {
    pg8::Gemm g{A, lda, Bt, ldb, 256, 1024 * (K / 256), 256, 0, 0, 4, 256};
    pg8::StaticOrder S; S.init(256, 1024 * (K / 256), c.G, (c.bid + 128) % c.G);
    pg8::gemm_phase<EpiResAddAtomic, pg8::StaticOrder>(c.lds, g, S, EpiResAddAtomic{X, sc}, c.tid);
    __syncthreads();
}

__device__ __forceinline__ void phase_cvt(const Ctx& c, int l) {
    bf16_t* W = (bf16_t*)wsg(c);
    const int cum[11] = {0, 1408, 2112, 3520, 4224, 6336, 7104, 7232, 7424, 8192, 8448};
    const int tid = c.tid;
    for (int t0 = c.bid * 4; t0 < 8448; t0 += c.G * 4) {
        bf16_t* dsts[4]; int ldds[4]; bool nz[4];
#pragma unroll
        for (int u = 0; u < 4; ++u) {
            const int t = t0 + u;
            int job = 0, base = 0;
#pragma unroll
            for (int j = 1; j < 10; ++j) if (t >= cum[j]) { job = j; base = cum[j]; }
            const int tt = t - base;
            const float* src = nullptr; int ld = 0; bf16_t* dst = nullptr; int ldd = 0;
            if (job == 0 || job == 2) {
                const int tn = tt >> 4, tk = tt & 15, n0 = tn * 64, k0 = tk * 64, pn = n0 >> 8, bj = (n0 >> 7) & 1, cc = n0 & 127;
                const float* g = inp(c, job == 0 ? I_F1G : I_F2G); const float* up = inp(c, job == 0 ? I_F1U : I_F2U);
                src = (bj ? up : g) + (size_t)l * D * FF + (size_t)k0 * FF + 128 * pn + cc; ld = FF;
                dst = W + (job == 0 ? W_GU1 : W_GU2) / 2 + (size_t)n0 * D + k0; ldd = D;
            } else if (job == 1 || job == 3) {
                const int tn = tt / 44, tk = tt % 44, n0 = tn * 64, k0 = tk * 64;
                src = inp(c, job == 1 ? I_F1D : I_F2D) + (size_t)l * FF * D + (size_t)k0 * D + n0; ld = D;
                dst = W + (job == 1 ? W_D1 : W_D2) / 2 + (size_t)n0 * FF + k0; ldd = FF;
            } else if (job == 4) {
                const int tn = tt >> 4, tk = tt & 15, n0 = tn * 64, k0 = tk * 64, col = n0 < 5120 ? n0 : n0 + 8;
                src = inp(c, I_WIN) + (size_t)l * D * INW + (size_t)k0 * INW + col; ld = INW;
                dst = W + W_IN / 2 + (size_t)n0 * D + k0; ldd = D;
            } else if (job == 5) {
                const int tn = tt >> 4, tk = tt & 15, n0 = tn * 64, k0 = tk * 64;
                src = inp(c, I_WIN) + (size_t)l * D * INW + (size_t)k0 * INW + 8456 + n0; ld = INW;
                dst = W + W_G / 2 + (size_t)n0 * D + k0; ldd = D;
            } else if (job == 6) {
                const int tn = tt >> 2, tk = tt & 3, n0 = tn * 64, k0 = tk * 64, which = n0 >> 10, nn = n0 & 1023, blk = nn >> 7, j0 = nn & 127, kblk = k0 >> 7, i0 = k0 & 127;
                if (kblk == (blk & 1)) { src = inp(c, which ? I_LWX : I_LWA) + (size_t)l * 8 * 128 * 128 + (size_t)blk * 128 * 128 + (size_t)i0 * 128 + j0; ld = 128; }
                dst = W + W_LRU / 2 + (size_t)n0 * 256 + k0; ldd = 256;
            } else if (job == 7) {
                const int tn = tt >> 2, tk = tt & 3, n0 = tn * 64, k0 = tk * 64;
                if (n0 < 1024) { if (tk == 0) { src = inp(c, I_W2) + (size_t)l * 64 * D + n0; ld = D; } }
                else if (n0 < 2048) { if (tk == 1) { src = inp(c, I_A2) + (size_t)l * 64 * D + (n0 - 1024); ld = D; } }
                else { if (tk >= 2) { src = inp(c, I_G2) + (size_t)l * 128 * D + (size_t)(k0 - 128) * D + (n0 - 2048); ld = D; } }
                dst = W + W_LORA / 2 + (size_t)n0 * 256 + k0; ldd = 256;
            } else if (job == 8) {
                const int tn = tt >> 4, tk = tt & 15, n0 = tn * 64, k0 = tk * 64, b = n0 >> 10, nn = n0 & 1023;
                src = inp(c, I_WBR) + (size_t)l * 3 * D * D + (size_t)b * D * D + (size_t)k0 * D + nn; ld = D;
                dst = W + W_BR / 2 + (size_t)n0 * D + k0; ldd = D;
            } else {
                const int tn = tt >> 4, tk = tt & 15, n0 = tn * 64, k0 = tk * 64;
                src = inp(c, I_WOUT) + (size_t)l * D * D + (size_t)k0 * D + n0; ld = D;
                dst = W + W_OUT / 2 + (size_t)n0 * D + k0; ldd = D;
            }

            dsts[u] = dst; ldds[u] = ldd; nz[u] = (src != nullptr);
            LAS float* tile = (LAS float*)c.lds + u * (64 * 65);
            if (src) {
                const int i = tid >> 4, j4 = tid & 15;
#pragma unroll
                for (int r = 0; r < 2; ++r) { const int k = i + 32 * r; const f32x4 v = *(const f32x4*)(src + (size_t)k * ld + 4 * j4);
                    tile[k * 65 + 4 * j4 + 0] = v[0]; tile[k * 65 + 4 * j4 + 1] = v[1]; tile[k * 65 + 4 * j4 + 2] = v[2]; tile[k * 65 + 4 * j4 + 3] = v[3]; }
            }
        }
        __syncthreads();
#pragma unroll
        for (int u = 0; u < 4; ++u) {
            const LAS float* tile = (const LAS float*)c.lds + u * (64 * 65);
            const int n = tid >> 3, kq = tid & 7; float f[8];
#pragma unroll
            for (int e = 0; e < 8; ++e) f[e] = nz[u] ? tile[(8 * kq + e) * 65 + n] : 0.f;
            *(u32x4*)(dsts[u] + (size_t)n * ldds[u] + 8 * kq) = pack8(f);
        }
        __syncthreads();
    }
    float* wif = (float*)(wsg(c) + W_IF);
    for (int i = c.bid * NTHREADS + c.tid; i < D * 8; i += c.G * NTHREADS) wif[i] = inp(c, I_WIN)[(size_t)l * D * INW + (size_t)(i >> 3) * INW + 5120 + (i & 7)];
}

__device__ __forceinline__ void phase_norm(const Ctx& c, const float* xin_p, const float* xin_s, float* X, int grow0, int nrows, const float* gamma, bf16_t* dst, const float* wif, float* gif) {
    const int lane = c.lane;
    f32x4 gm[4];
#pragma unroll
    for (int i = 0; i < 4; ++i) gm[i] = *(const f32x4*)(gamma + 256 * i + 4 * lane);
    for (int r = c.bid * 8 + c.wave; r < nrows; r += c.G * 8) {
        const int gr = grow0 + r;
        const float* src = xin_p ? (gr < NPROMPT ? xin_p + (size_t)gr * D : xin_s + (size_t)(gr - NPROMPT) * D) : X + (size_t)gr * D;
        f32x4 v[4]; float ss = 0.f;
#pragma unroll
        for (int i = 0; i < 4; ++i) { v[i] = *(const f32x4*)(src + 256 * i + 4 * lane); ss += v[i][0] * v[i][0] + v[i][1] * v[i][1] + v[i][2] * v[i][2] + v[i][3] * v[i][3]; }
        if (xin_p) {
#pragma unroll
            for (int i = 0; i < 4; ++i) *(f32x4*)(X + (size_t)gr * D + 256 * i + 4 * lane) = v[i];
        }
        ss = wsum(ss);
        const float rstd = __builtin_amdgcn_rsqf(ss * (1.0f / D) + 1e-6f);
#pragma unroll
        for (int i = 0; i < 4; ++i) {
            v[i] = v[i] * rstd * gm[i];
            u32x2 w; w.x = pk2(v[i][0], v[i][1]); w.y = pk2(v[i][2], v[i][3]);
            *(u32x2*)(dst + (size_t)r * D + 256 * i + 4 * lane) = w;
        }
        if (gif) {
            float a8[8];
#pragma unroll
            for (int j = 0; j < 8; ++j) a8[j] = 0.f;
#pragma unroll
            for (int i = 0; i < 4; ++i)
#pragma unroll
                for (int e = 0; e < 4; ++e) {
                    const float* wp = wif + (size_t)(256 * i + 4 * lane + e) * 8; const f32x4 w0 = *(const f32x4*)wp, w1 = *(const f32x4*)(wp + 4);
                    a8[0] += v[i][e] * w0[0]; a8[1] += v[i][e] * w0[1]; a8[2] += v[i][e] * w0[2]; a8[3] += v[i][e] * w0[3];
                    a8[4] += v[i][e] * w1[0]; a8[5] += v[i][e] * w1[1]; a8[6] += v[i][e] * w1[2]; a8[7] += v[i][e] * w1[3];
                }
#pragma unroll
            for (int j = 0; j < 8; ++j) a8[j] = wsum(a8[j]);
            if (lane == 0) {
#pragma unroll
                for (int j = 0; j < 8; ++j) gif[(size_t)r * 8 + j] = a8[j];
            }
        }
    }
}
__device__ __forceinline__ void phase_final_norm(const Ctx& c, float* X, const float* gamma) {
    const int lane = c.lane;
    f32x4 gm[4];
#pragma unroll
    for (int i = 0; i < 4; ++i) gm[i] = *(const f32x4*)(gamma + 256 * i + 4 * lane);
    for (int r = c.bid * 8 + c.wave; r < NTOK; r += c.G * 8) {
        f32x4 v[4]; float ss = 0.f;
#pragma unroll
        for (int i = 0; i < 4; ++i) { v[i] = *(const f32x4*)(X + (size_t)r * D + 256 * i + 4 * lane); ss += v[i][0] * v[i][0] + v[i][1] * v[i][1] + v[i][2] * v[i][2] + v[i][3] * v[i][3]; }
        ss = wsum(ss);
        const float rstd = __builtin_amdgcn_rsqf(ss * (1.0f / D) + 1e-6f);
#pragma unroll
        for (int i = 0; i < 4; ++i) *(f32x4*)(X + (size_t)r * D + 256 * i + 4 * lane) = v[i] * rstd * gm[i];
    }
}

__device__ __forceinline__ void phase_cv1(const Ctx& c, int p, int l) {
    const bf16_t* Z = (const bf16_t*)(wsg(c) + WS_Z); bf16_t* H = (bf16_t*)(wsg(c) + WS_HALO);
    const int nseg = pass_nseg(p), gt = c.bid * NTHREADS + c.tid, gs = c.G * NTHREADS;
    for (int i = gt; i < nseg * 3168; i += gs) {
        const int s = i / 3168, pc = i % 3168, r = pc / 1056, cc = pc % 1056; const Seg g = seg_of(s);
        *(u32x4*)(H + ((size_t)s * 3 + r) * ZW + 8 * cc) = *(const u32x4*)(Z + (size_t)(g.row0 + g.n - 3 + r) * ZW + 8 * cc);
    }
    const int nseq = pass_nseq(p);
    for (int i = gt; i < nseq * 12544; i += gs) {
        const int q = i / 12544, e = i % 12544; const Seq sq = seq_of(p, q);
        if (e < 9216) { const int r = e / 3072, ch = e % 3072;
            float* o = outg(c) + (sq.sample ? O_SCONV + ((size_t)l * DB + sq.b) * 9216 : O_PCONV + ((size_t)l * NB + sq.b) * 9216);
            o[e] = bf2f(Z[(size_t)(sq.row0 + sq.T - 3 + r) * ZW + ch]);
        } else { const int j = e - 9216;
            float* o = outg(c) + (sq.sample ? O_SSH + ((size_t)l * DB + sq.b) * RIN : O_PSH + ((size_t)l * NB + sq.b) * RIN);
            o[j] = bf2f(Z[(size_t)(sq.row0 + sq.T - 1) * ZW + C_R + j]);
        }
    }
}
__device__ __forceinline__ void phase_cv2(const Ctx& c, int p, int l) {
    bf16_t* Z = (bf16_t*)(wsg(c) + WS_Z); const bf16_t* H = (const bf16_t*)(wsg(c) + WS_HALO);
    const int nseg = pass_nseg(p), gt = c.bid * NTHREADS + c.tid, gs = c.G * NTHREADS;
    for (int i = gt; i < nseg * 800; i += gs) {
        const int s = i / 800, cgp = i % 800; const Seg g = seg_of(s); const Seq sq = seq_of(p, g.q);
        if (cgp < 384) {
            const int col = 8 * cgp;
            float p0[8], p1[8], p2[8], w0[8], w1[8], w2[8], w3[8], bb[8];
            const float* cw = inp(c, I_CONVW) + (size_t)l * 4 * CONVCH + col; const float* cb = inp(c, I_CONVB) + (size_t)l * CONVCH + col;
#pragma unroll
            for (int j = 0; j < 8; ++j) { w0[j] = cw[j]; w1[j] = cw[CONVCH + j]; w2[j] = cw[2 * CONVCH + j]; w3[j] = cw[3 * CONVCH + j]; bb[j] = cb[j]; }
            if (g.c > 0) { unpack8(*(const u32x4*)(H + ((size_t)(s - 1) * 3 + 0) * ZW + col), p0); unpack8(*(const u32x4*)(H + ((size_t)(s - 1) * 3 + 1) * ZW + col), p1); unpack8(*(const u32x4*)(H + ((size_t)(s - 1) * 3 + 2) * ZW + col), p2); }
            else if (sq.sample) { const float* st = inp(c, I_SCONV) + ((size_t)l * DB + sq.b) * 3 * CONVCH + col;
#pragma unroll
                for (int j = 0; j < 8; ++j) { p0[j] = st[j]; p1[j] = st[CONVCH + j]; p2[j] = st[2 * CONVCH + j]; } }
            else {
#pragma unroll
                for (int j = 0; j < 8; ++j) { p0[j] = 0.f; p1[j] = 0.f; p2[j] = 0.f; } }
            const int mode = col < 1024 ? 0 : (col < 2048 ? 1 : 2);
            for (int t4 = 0; t4 < g.n; t4 += 4) {
                u32x4 raw[4];
#pragma unroll
                for (int u = 0; u < 4; ++u) raw[u] = *(const u32x4*)(Z + (size_t)(g.row0 + t4 + u) * ZW + col);
#pragma unroll
                for (int u = 0; u < 4; ++u) {
                    bf16_t* zp = Z + (size_t)(g.row0 + t4 + u) * ZW + col; float x[8], y[8];
                    unpack8(raw[u], x);
#pragma unroll
                    for (int j = 0; j < 8; ++j) { float v = bb[j] + p0[j] * w0[j]; v += p1[j] * w1[j]; v += p2[j] * w2[j]; v += x[j] * w3[j];
                        if (mode == 1) v = siluf_(v); else if (mode == 2) v = siluf_(v) * 0.0625f;
                        y[j] = v; p0[j] = p1[j]; p1[j] = p2[j]; p2[j] = x[j]; }
                    *(u32x4*)zp = pack8(y);
                }
            }
        } else {
            const int j0 = 8 * (cgp - 384), col = C_R + j0;
            float pv[8], mu[8];
            const float* mp = inp(c, I_MU) + (size_t)l * RIN + j0;
#pragma unroll
            for (int j = 0; j < 8; ++j) mu[j] = mp[j];
            if (g.c > 0) unpack8(*(const u32x4*)(H + ((size_t)(s - 1) * 3 + 2) * ZW + col), pv);
            else if (sq.sample) { const float* st = inp(c, I_SSH) + ((size_t)l * DB + sq.b) * RIN + j0;
#pragma unroll
                for (int j = 0; j < 8; ++j) pv[j] = st[j]; }
            else {
#pragma unroll
                for (int j = 0; j < 8; ++j) pv[j] = 0.f; }
            const int mode = (j0 >= 3072 && j0 < 3136) ? 1 : (j0 >= 3200 ? 2 : 0);
            for (int t4 = 0; t4 < g.n; t4 += 4) {
                u32x4 raw[4];
#pragma unroll
                for (int u = 0; u < 4; ++u) raw[u] = *(const u32x4*)(Z + (size_t)(g.row0 + t4 + u) * ZW + col);
#pragma unroll
                for (int u = 0; u < 4; ++u) {
                    bf16_t* zp = Z + (size_t)(g.row0 + t4 + u) * ZW + col; float x[8], y[8];
                    unpack8(raw[u], x);
#pragma unroll
                    for (int j = 0; j < 8; ++j) { float v = x[j] + (pv[j] - x[j]) * mu[j];
                        if (mode == 1) v = tanhf_(v); else if (mode == 2) v = sigmoidf_(v);
                        y[j] = v; pv[j] = x[j]; }
                    *(u32x4*)zp = pack8(y);
                }
            }
        }
    }
}

template <int FINAL>
__device__ __forceinline__ void phase_lru(const Ctx& c, int p, int l) {
    bf16_t* Z = (bf16_t*)(wsg(c) + WS_Z); const bf16_t* T = (const bf16_t*)(wsg(c) + WS_T); float* car = (float*)(wsg(c) + WS_CAR);
    const int nseg = pass_nseg(p), gt = c.bid * NTHREADS + c.tid, gs = c.G * NTHREADS;
    for (int i = gt; i < nseg * 128; i += gs) {
        const int s = i >> 7, ch = 8 * (i & 127); const Seg g = seg_of(s); const Seq sq = seq_of(p, g.q);
        float ba[8], bx[8], c1[8], A[8], B[8];
#pragma unroll
        for (int j = 0; j < 8; ++j) { ba[j] = inp(c, I_LBA)[(size_t)l * D + ch + j]; bx[j] = inp(c, I_LBX)[(size_t)l * D + ch + j]; c1[j] = -8.0f * softplusf_(-inp(c, I_LLAM)[(size_t)l * D + ch + j]); A[j] = 1.f; B[j] = 0.f; }
        if (FINAL) {
            if (sq.sample) {
#pragma unroll
                for (int j = 0; j < 8; ++j) B[j] = inp(c, I_SLRU)[((size_t)l * DB + sq.b) * D + ch + j]; }
            for (int cp = 0; cp < g.c; ++cp) { const float* ca = car + (size_t)(s - g.c + cp) * 2048 + ch;
#pragma unroll
                for (int j = 0; j < 8; ++j) B[j] = ca[j] * B[j] + ca[1024 + j]; }
        }
        for (int t4 = 0; t4 < g.n; t4 += 4) {
          u32x4 rx[4], rr[4], ri[4];
#pragma unroll
          for (int u = 0; u < 4; ++u) { const size_t row = (size_t)(g.row0 + t4 + u); rx[u] = *(const u32x4*)(Z + row * ZW + C_LRU + ch); rr[u] = *(const u32x4*)(T + row * 2048 + ch); ri[u] = *(const u32x4*)(T + row * 2048 + 1024 + ch); }
#pragma unroll
          for (int u = 0; u < 4; ++u) {
            const size_t row = (size_t)(g.row0 + t4 + u); float x[8], rp[8], ip[8];
            unpack8(rx[u], x); unpack8(rr[u], rp); unpack8(ri[u], ip);
#pragma unroll
            for (int j = 0; j < 8; ++j) { const float la = c1[j] * sigmoidf_(rp[j] + ba[j]), a = __expf(la), bt = __builtin_amdgcn_sqrtf(fmaxf(1.0f - __expf(2.0f * la), 0.f)) * sigmoidf_(ip[j] + bx[j]) * x[j];
                B[j] = a * B[j] + bt; A[j] *= a; x[j] = B[j]; }
            if (FINAL) *(u32x4*)(Z + row * ZW + C_LRU + ch) = pack8(x);
          }
        }
        if (!FINAL) { float* ca = car + (size_t)s * 2048 + ch;
#pragma unroll
            for (int j = 0; j < 8; ++j) { ca[j] = A[j]; ca[1024 + j] = B[j]; } }
        else if (g.c == g.nch - 1) { float* o = outg(c) + (sq.sample ? O_SLRU + ((size_t)l * DB + sq.b) * D : O_PLRU + ((size_t)l * NB + sq.b) * D) + ch;
#pragma unroll
            for (int j = 0; j < 8; ++j) o[j] = B[j]; }
    }
}

__device__ __forceinline__ f32x4 mma_tile(const LAS bf16_t* A, int lda, const LAS bf16_t* Bt, int ldb, int K, f32x4 acc, int lane) {
    const LAS bf16_t* pa = A + (lane & 15) * lda + (lane >> 4) * 8; const LAS bf16_t* pb = Bt + (lane & 15) * ldb + (lane >> 4) * 8;
    for (int k = 0; k < K; k += 32) { const bf16x8 a = *(const LAS bf16x8*)(pa + k); const bf16x8 b = *(const LAS bf16x8*)(pb + k); acc = __builtin_amdgcn_mfma_f32_16x16x32_bf16(a, b, acc, 0, 0, 0); }
    return acc;
}

__device__ __forceinline__ void phase_mlstm_s(const Ctx& c, int p, int l) {
    const bf16_t* Z = (const bf16_t*)(wsg(c) + WS_Z); const float* gif = (const float*)(wsg(c) + WS_GIF); bf16_t* SL = (bf16_t*)(wsg(c) + WS_SL);
    int tid = c.tid, lane = c.lane; const int w = c.wave;
    const int nitems = p ? 1088 : 1024;
    for (int item = c.bid; item < nitems; item += c.G) {
        asm volatile("" : "+v"(tid), "+v"(lane));
        LAS unsigned char* L = c.lds; asm volatile("" : "+v"(L));
        LAS bf16_t* Qs = (LAS bf16_t*)(L); LAS bf16_t* Ks = (LAS bf16_t*)(L + 33792); LAS bf16_t* St = (LAS bf16_t*)(L + 67584);
        LAS float* bcum = (LAS float*)(L + 76800); LAS float* igs = bcum + 64; LAS float* mloc = bcum + 128;
        int q, h, rbase, nvalid;
        if (item < 1024) { q = item >> 9; h = (item >> 7) & 3; rbase = q * SEQ + (item & 127) * 64; nvalid = 64; }
        else { const int sid = item - 1024; q = 2 + (sid >> 2); h = sid & 3; rbase = 16384 + (sid >> 2) * DSEQ; nvalid = DSEQ; }
        const float bi = inp(c, I_IFB)[l * 8 + h], bf = inp(c, I_IFB)[l * 8 + 4 + h];
#pragma unroll
        for (int i = 0; i < 4; ++i) {
            const int piece = tid + 512 * i, t = piece >> 5, pc = piece & 31; u32x4 qv = {0u, 0u, 0u, 0u}, kv = {0u, 0u, 0u, 0u};
            if (t < nvalid) { qv = *(const u32x4*)(Z + (size_t)(rbase + t) * ZW + C_Q + 256 * h + 8 * pc); kv = *(const u32x4*)(Z + (size_t)(rbase + t) * ZW + C_K + 256 * h + 8 * pc); }
            *(LAS u32x4*)(Qs + t * 264 + 8 * pc) = qv; *(LAS u32x4*)(Ks + t * 264 + 8 * pc) = kv;
        }
        if (w == 0) {
            const int t = lane; float ig = -1e30f, lf = 0.f;
            if (t < nvalid) { ig = gif[(size_t)(rbase + t) * 8 + h] + bi; const float gf = gif[(size_t)(rbase + t) * 8 + 4 + h] + bf; lf = fminf(gf, 0.f) - __logf(1.0f + __expf(-fabsf(gf))); }
            float bc = lf;
#pragma unroll
            for (int o = 1; o < 64; o <<= 1) { const float u = __shfl_up(bc, o); if (lane >= o) bc += u; }
            float cm = ig - bc;
#pragma unroll
            for (int o = 1; o < 64; o <<= 1) { const float u = __shfl_up(cm, o); if (lane >= o) cm = fmaxf(cm, u); }
            bcum[t] = bc; igs[t] = ig; mloc[t] = bc + cm;
        }
        __syncthreads();
        const int ti = w >> 1;
#pragma unroll
        for (int e = 0; e < 2; ++e) {
            const int sj = (w & 1) * 2 + e;
            f32x4 a = {0.f, 0.f, 0.f, 0.f};
            a = mma_tile(Qs + 16 * ti * 264, 264, Ks + 16 * sj * 264, 264, 256, a, lane);
#pragma unroll
            for (int r = 0; r < 4; ++r) {
                const int t = 16 * ti + (lane >> 4) * 4 + r, s2 = 16 * sj + (lane & 15);
                const float wg = (s2 <= t && t < nvalid) ? __expf(bcum[t] - bcum[s2] + igs[s2] - mloc[t]) : 0.f;
                St[t * 72 + s2] = f2bf(a[r] * wg);
            }
        }
        __syncthreads();
        { const int row = tid >> 3, pc = tid & 7; *(u32x4*)(SL + (size_t)item * 4096 + row * 64 + 8 * pc) = *(const LAS u32x4*)(St + row * 72 + 8 * pc); }
        __syncthreads();
    }
}

__device__ __forceinline__ void mlstm_task(const Ctx& c, int p, int l, int q, int h, int slab) {
    bf16_t* Z = (bf16_t*)(wsg(c) + WS_Z); const float* gif = (const float*)(wsg(c) + WS_GIF);
    const bf16_t* SLp = (const bf16_t*)(wsg(c) + WS_SL) + (size_t)(q < 2 ? q * 512 + h * 128 : 1024 + (q - 2) * 4 + h) * 4096 + (c.tid >> 3) * 64 + 8 * (c.tid & 7);
    const Seq sq = seq_of(p, q); const int tid = c.tid, lane = c.lane, w = c.wave;
    LAS bf16_t* Qs = (LAS bf16_t*)(c.lds); LAS bf16_t* Ks = (LAS bf16_t*)(c.lds + 33792); LAS bf16_t* KT = (LAS bf16_t*)(c.lds + 67584); LAS bf16_t* VT = (LAS bf16_t*)(c.lds + 104448);
    LAS bf16_t* VgT = (LAS bf16_t*)(c.lds + 109200); LAS bf16_t* Cs = (LAS bf16_t*)(c.lds + 113952); LAS bf16_t* St = (LAS bf16_t*)(c.lds + 131376);
    LAS float* sc = (LAS float*)(c.lds + 140592);
    LAS float* bcum = sc; LAS float* igs = sc + 64; LAS float* mts = sc + 128; LAS float* wint = sc + 192; LAS float* gsrc = sc + 256; LAS float* dd = sc + 320; LAS float* misc = sc + 384; LAS float* esc = sc + 392;
    const int nvalid = sq.sample ? DSEQ : 64, nch = sq.sample ? 1 : SEQ / 64;
    const float bi = inp(c, I_IFB)[l * 8 + h], bf = inp(c, I_IFB)[l * 8 + 4 + h];
    f32x4 cacc[3][2];
#pragma unroll
    for (int vi = 0; vi < 3; ++vi)
#pragma unroll
        for (int e = 0; e < 2; ++e)
#pragma unroll
            for (int r = 0; r < 4; ++r) {
                const int vloc = 16 * vi + (lane >> 4) * 4 + r, d = 16 * (2 * w + e) + (lane & 15); float v0 = 0.f;
                if (sq.sample) { if (vloc < 32) v0 = inp(c, I_SMC)[(((size_t)l * DB + sq.b) * 4 + h) * 65536 + (size_t)(slab * 32 + vloc) * 256 + d];
                                 else if (vloc == 32) v0 = inp(c, I_SMN)[(((size_t)l * DB + sq.b) * 4 + h) * 256 + d]; }
                cacc[vi][e][r] = v0;
            }
    if (tid < 64) VT[32 * 72 + tid] = (bf16_t)0x3f80u;
    if (tid == 0) misc[0] = sq.sample ? inp(c, I_SMM)[((size_t)l * DB + sq.b) * 4 + h] : 0.f;
    unsigned zz = 0u; asm volatile("" : "+v"(zz)); const u32x4 zv = {zz, zz, zz, zz};
    u32x4 pq[4], pk[4], pvv = zv, psl = zv; float pgi = 0.f, pgf = 0.f; int pfc = 0;
#define ML_PREFETCH(RB) do { psl = *(const u32x4*)(SLp + (size_t)pfc * 4096); ++pfc; \
        _Pragma("unroll") for (int i = 0; i < 4; ++i) { const int piece = tid + 512 * i, t = piece >> 5, pc = piece & 31; pq[i] = zv; pk[i] = zv; \
            if (t < nvalid) { pq[i] = *(const u32x4*)(Z + (size_t)((RB) + t) * ZW + C_Q + 256 * h + 8 * pc); pk[i] = *(const u32x4*)(Z + (size_t)((RB) + t) * ZW + C_K + 256 * h + 8 * pc); } } \
        if (tid < 256) { const int t = tid >> 2, pc = tid & 3; pvv = zv; if (t < nvalid) pvv = *(const u32x4*)(Z + (size_t)((RB) + t) * ZW + C_V + 256 * h + slab * 32 + 8 * pc); } \
        if (w == 0 && lane < nvalid) { pgi = gif[(size_t)((RB) + lane) * 8 + h]; pgf = gif[(size_t)((RB) + lane) * 8 + 4 + h]; } } while (0)
    ML_PREFETCH(sq.row0);
    __syncthreads();
    for (int ck = 0; ck < nch; ++ck) {
        const int rbase = sq.row0 + ck * 64;
#pragma unroll
        for (int i = 0; i < 4; ++i) {
            const int piece = tid + 512 * i, t = piece >> 5, pc = piece & 31;
            *(LAS u32x4*)(Qs + t * 264 + 8 * pc) = pq[i]; *(LAS u32x4*)(Ks + t * 264 + 8 * pc) = pk[i];
        }
        *(LAS u32x4*)(St + (tid >> 3) * 72 + 8 * (tid & 7)) = psl;
        if (tid < 256) {
            const int t = tid >> 2, pc = tid & 3; const u32x4 vv = pvv;
            const unsigned vw[4] = {vv.x, vv.y, vv.z, vv.w};
#pragma unroll
            for (int e = 0; e < 4; ++e) { VT[(8 * pc + 2 * e) * 72 + t] = (bf16_t)(vw[e] & 0xffffu); VT[(8 * pc + 2 * e + 1) * 72 + t] = (bf16_t)(vw[e] >> 16); }
        }
        if (w == 0) {
            const int t = lane; float ig = -1e30f, lf = 0.f;
            if (t < nvalid) { ig = pgi + bi; const float gf = pgf + bf; lf = fminf(gf, 0.f) - __logf(1.0f + __expf(-fabsf(gf))); }
            float bc = lf;
#pragma unroll
            for (int o = 1; o < 64; o <<= 1) { const float u = __shfl_up(bc, o); if (lane >= o) bc += u; }
            float cm = ig - bc;
#pragma unroll
            for (int o = 1; o < 64; o <<= 1) { const float u = __shfl_up(cm, o); if (lane >= o) cm = fmaxf(cm, u); }
            const float mprev = misc[0];
            const float mt = bc + fmaxf(mprev, cm);
            const float wi = __expf(bc + mprev - mt);
            const float bL = __shfl(bc, 63), mnew = __shfl(mt, 63);
            const float gs_ = __expf(bL - bc + ig - mnew);
            mts[t] = mt; wint[t] = wi; gsrc[t] = gs_; VgT[32 * 72 + t] = f2bf(gs_); esc[t] = __expf(cm - fmaxf(mprev, cm));
            if (lane == 0) { misc[1] = __expf(bL + mprev - mnew); misc[2] = mnew; }
        }
#pragma unroll
        for (int vi = 0; vi < 3; ++vi)
#pragma unroll
            for (int e = 0; e < 2; ++e)
#pragma unroll
                for (int r = 0; r < 4; ++r) { const int vloc = 16 * vi + (lane >> 4) * 4 + r; if (vloc <= 32) Cs[vloc * 264 + 16 * (2 * w + e) + (lane & 15)] = f2bf(cacc[vi][e][r]); }
        __syncthreads();
        if (ck + 1 < nch) ML_PREFETCH(rbase + 64);
#pragma unroll
        for (int i = 0; i < 2; ++i) {
            const int idx = tid + 512 * i, dp = idx & 127, so = idx >> 7; unsigned wv[8];
#pragma unroll
            for (int e = 0; e < 8; ++e) wv[e] = *(const LAS unsigned*)(Ks + (8 * so + e) * 264 + 2 * dp);
            u32x4 lo, hi;
            lo.x = (wv[0] & 0xffffu) | (wv[1] << 16); lo.y = (wv[2] & 0xffffu) | (wv[3] << 16); lo.z = (wv[4] & 0xffffu) | (wv[5] << 16); lo.w = (wv[6] & 0xffffu) | (wv[7] << 16);
            hi.x = (wv[0] >> 16) | (wv[1] & 0xffff0000u); hi.y = (wv[2] >> 16) | (wv[3] & 0xffff0000u); hi.z = (wv[4] >> 16) | (wv[5] & 0xffff0000u); hi.w = (wv[6] >> 16) | (wv[7] & 0xffff0000u);
            *(LAS u32x4*)(KT + (2 * dp) * 72 + 8 * so) = lo; *(LAS u32x4*)(KT + (2 * dp + 1) * 72 + 8 * so) = hi;
        }
#pragma unroll
        for (int i = 0; i < 4; ++i) { const int idx = tid + 512 * i, v = idx >> 6, s2 = idx & 63; VgT[v * 72 + s2] = f2bf(bf2f(VT[v * 72 + s2]) * gsrc[s2]); }
        const int ti = w >> 1;
        const int vj = w & 1;
        f32x4 qc = {0.f, 0.f, 0.f, 0.f}, qc2 = {0.f, 0.f, 0.f, 0.f};
        qc = mma_tile(Qs + 16 * ti * 264, 264, Cs + 16 * vj * 264, 264, 256, qc, lane);
        if (w < 4) qc2 = mma_tile(Qs + 16 * w * 264, 264, Cs + 32 * 264, 264, 256, qc2, lane);
        __syncthreads();
        f32x4 num = {0.f, 0.f, 0.f, 0.f};
        num = mma_tile(St + 16 * ti * 72, 72, VT + 16 * vj * 72, 72, 64, num, lane);
#pragma unroll
        for (int r = 0; r < 4; ++r) { const int t = 16 * ti + (lane >> 4) * 4 + r; num[r] = qc[r] * wint[t] + esc[t] * num[r]; }
        if (w < 4) {
            f32x4 sv2 = {0.f, 0.f, 0.f, 0.f};
            sv2 = mma_tile(St + 16 * w * 72, 72, VT + 32 * 72, 72, 64, sv2, lane);
#pragma unroll
            for (int r = 0; r < 4; ++r) { const int t = 16 * w + (lane >> 4) * 4 + r; qc2[r] = qc2[r] * wint[t] + esc[t] * sv2[r]; }
            if ((lane & 15) == 0) {
#pragma unroll
                for (int r = 0; r < 4; ++r) { const int t = 16 * w + (lane >> 4) * 4 + r; dd[t] = fmaxf(fabsf(qc2[r]), __expf(-mts[t])); }
            }
        }
        __syncthreads();
#pragma unroll
        for (int r = 0; r < 4; ++r) {
            const int t = 16 * ti + (lane >> 4) * 4 + r;
            if (t < nvalid) Z[(size_t)(rbase + t) * ZW + C_V + 256 * h + slab * 32 + 16 * vj + (lane & 15)] = f2bf(num[r] * __builtin_amdgcn_rcpf(dd[t]));
        }
        const float gs = misc[1];
#pragma unroll
        for (int vi = 0; vi < 3; ++vi)
#pragma unroll
            for (int e = 0; e < 2; ++e) { cacc[vi][e] = cacc[vi][e] * gs; cacc[vi][e] = mma_tile(VgT + 16 * vi * 72, 72, KT + 16 * (2 * w + e) * 72, 72, 64, cacc[vi][e], lane); }
        if (tid == 0) misc[0] = misc[2];
        __syncthreads();
    }
#undef ML_PREFETCH
    float* oc = outg(c) + (sq.sample ? O_SMC + (((size_t)l * DB + sq.b) * 4 + h) * 65536 : O_PMC + (((size_t)l * NB + sq.b) * 4 + h) * 65536);
#pragma unroll
    for (int vi = 0; vi < 2; ++vi)
#pragma unroll
        for (int e = 0; e < 2; ++e)
#pragma unroll
            for (int r = 0; r < 4; ++r) oc[(size_t)(slab * 32 + 16 * vi + (lane >> 4) * 4 + r) * 256 + 16 * (2 * w + e) + (lane & 15)] = cacc[vi][e][r];
    if (slab == 0) {
        if (lane < 16) {
            float* on = outg(c) + (sq.sample ? O_SMN + (((size_t)l * DB + sq.b) * 4 + h) * 256 : O_PMN + (((size_t)l * NB + sq.b) * 4 + h) * 256);
#pragma unroll
            for (int e = 0; e < 2; ++e) on[16 * (2 * w + e) + lane] = cacc[2][e][0];
        }
        if (tid == 0) outg(c)[(sq.sample ? O_SMM + ((size_t)l * DB + sq.b) * 4 + h : O_PMM + ((size_t)l * NB + sq.b) * 4 + h)] = misc[0];
    }
    __syncthreads();
}

constexpr int RS = 72;
__device__ __forceinline__ void rwkv_apply_tiles(int w, int lane, const LAS bf16_t* S0b, const LAS bf16_t* GTs, const LAS bf16_t* QTs, const LAS bf16_t* Hs, const LAS bf16_t* YHTs, LAS float* yT, f32x4 (&sacc)[4]) {
    if (w < 4) {
#pragma unroll
        for (int b = 0; b < 4; ++b) {
            f32x4 a = {0.f, 0.f, 0.f, 0.f};
            a = mma_tile(S0b + 16 * w * RS, RS, GTs + 16 * b * RS, RS, 64, a, lane);
#pragma unroll
            for (int r = 0; r < 4; ++r) a[r] += bf2f(Hs[(16 * w + (lane >> 4) * 4 + r) * RS + 16 * b + (lane & 15)]);
            sacc[b] = a;
        }
    } else {
        const int wi = w - 4;
#pragma unroll
        for (int b = 0; b < 4; ++b) {
            f32x4 a = {0.f, 0.f, 0.f, 0.f};
            a = mma_tile(S0b + 16 * wi * RS, RS, QTs + 16 * b * RS, RS, 64, a, lane);
            const int t = 16 * b + (lane & 15), i0 = 16 * wi + (lane >> 4) * 4;
            const u32x2 yh = *(const LAS u32x2*)(YHTs + t * RS + i0);
            yT[t * 65 + i0 + 0] = a[0] + bflo(yh.x); yT[t * 65 + i0 + 1] = a[1] + bfhi(yh.x); yT[t * 65 + i0 + 2] = a[2] + bflo(yh.y); yT[t * 65 + i0 + 3] = a[3] + bfhi(yh.y);
        }
    }
}
__device__ __forceinline__ void rwkv_post(int tid, const LAS float* yT, const LAS bf16_t* vblk, const LAS bf16_t* gblk, const LAS float* bon, const float (&lnw)[8], const float (&lnb)[8], bf16_t* zr, int nvalid) {
    const int t = tid >> 3, i0 = 8 * (tid & 7);
    float y[8], s = 0.f;
#pragma unroll
    for (int e = 0; e < 8; ++e) { y[e] = yT[t * 65 + i0 + e]; s += y[e]; }
    s += __shfl_xor(s, 1); s += __shfl_xor(s, 2); s += __shfl_xor(s, 4);
    const float mean = s * (1.0f / 64.0f); float qv = 0.f;
#pragma unroll
    for (int e = 0; e < 8; ++e) { y[e] -= mean; qv += y[e] * y[e]; }
    qv += __shfl_xor(qv, 1); qv += __shfl_xor(qv, 2); qv += __shfl_xor(qv, 4);
    const float rstd = __builtin_amdgcn_rsqf(qv * (1.0f / 64.0f) + 64e-5f), bo = bon[t];
    float vf[8], gf[8], o[8];
    unpack8(*(const LAS u32x4*)(vblk + t * RS + i0), vf); unpack8(*(const LAS u32x4*)(gblk + t * RS + i0), gf);
#pragma unroll
    for (int e = 0; e < 8; ++e) o[e] = (y[e] * rstd * lnw[e] + lnb[e] + bo * vf[e]) * gf[e];
    if (t < nvalid) *(u32x4*)(zr + (size_t)t * ZW + i0) = pack8(o);
}

constexpr int RA_At = 0, RA_Rt = 9216, RA_Bt = 18432, RA_Kt = 27648, RA_AtT = 36864, RA_BtT = 46080, RA_KtT = 55296, RA_VT = 64512, RA_Nf = 73728, RA_MinvT = 92160, RA_AakT = 101376,
              RA_AbrT = 110592, RA_AkrT = 119808, RA_WL = 129024, RA_SEG = 129280, RA_BON = 131328, RA_GB = 131584, RA_VB = 133888  ;
__device__ __forceinline__ void phase_rwkv_ra(const Ctx& c, int p, int l) {
    bf16_t* Z = (bf16_t*)(wsg(c) + WS_Z); bf16_t* T = (bf16_t*)(wsg(c) + WS_T); float* bonus_g = (float*)(wsg(c) + WS_BONUS);
    int tid = c.tid, lane = c.lane; const int w = c.wave;
#define LAUNDER2() asm volatile("" : "+v"(tid), "+v"(lane))
    const int nitems = p ? 4352 : 4096;
    u32x4 nx0, nx1, nx2, nx3, nx4; int have_pf = 0;
#define RA_PREFETCH(IT) do { have_pf = 0; if ((IT) < 4096 && (IT) < nitems && (IT) >= 0) { const int q_ = (IT) >> 11, rem_ = (IT) & 2047, h_ = rem_ & 15; \
        const size_t row_ = (size_t)(q_ * SEQ + (rem_ >> 4) * 64 + (tid >> 3)); const int col_ = 64 * h_ + 8 * (tid & 7); \
        nx0 = *(const u32x4*)(Z + row_ * ZW + C_R + col_); nx1 = *(const u32x4*)(Z + row_ * ZW + C_RK + col_); nx2 = *(const u32x4*)(Z + row_ * ZW + C_RV + col_); \
        nx3 = *(const u32x4*)(T + row_ * 3072 + col_); nx4 = *(const u32x4*)(T + row_ * 3072 + 1024 + col_); have_pf = 1; } } while (0)
    RA_PREFETCH(c.bid - 64);
    for (int item = c.bid - 64; item < nitems; item += c.G - 64) {
        LAUNDER2();
        LAS unsigned char* L = c.lds; asm volatile("" : "+v"(L));
    LAS bf16_t* At = (LAS bf16_t*)(L + RA_At); LAS bf16_t* Rt = (LAS bf16_t*)(L + RA_Rt); LAS bf16_t* Bt_ = (LAS bf16_t*)(L + RA_Bt); LAS bf16_t* Kt = (LAS bf16_t*)(L + RA_Kt);
    LAS bf16_t* AtT = (LAS bf16_t*)(L + RA_AtT); LAS bf16_t* BtT = (LAS bf16_t*)(L + RA_BtT); LAS bf16_t* KtT = (LAS bf16_t*)(L + RA_KtT); LAS bf16_t* VT = (LAS bf16_t*)(L + RA_VT);
    LAS float* cumb = (LAS float*)(L + RA_Nf); LAS float* NfT = (LAS float*)(L + RA_Nf);
    LAS bf16_t* MinvT = (LAS bf16_t*)(L + RA_MinvT); LAS bf16_t* AakT = (LAS bf16_t*)(L + RA_AakT); LAS bf16_t* AbrT = (LAS bf16_t*)(L + RA_AbrT); LAS bf16_t* AkrT = (LAS bf16_t*)(L + RA_AkrT);
    LAS bf16_t* XHm = At; LAS bf16_t* UGm = Kt; LAS bf16_t* UHm = Bt_;
    LAS bf16_t* GT = (LAS bf16_t*)(L + RA_Nf); LAS bf16_t* QT = (LAS bf16_t*)(L + RA_Nf + 9216); LAS bf16_t* Hm = MinvT; LAS bf16_t* YHT = AakT;
    LAS float* WL = (LAS float*)(L + RA_WL); LAS float* seg = (LAS float*)(L + RA_SEG); LAS float* bon = (LAS float*)(L + RA_BON); LAS bf16_t* gblk = (LAS bf16_t*)(L + RA_GB); LAS bf16_t* vblk = (LAS bf16_t*)(L + RA_VB);
        int h, rbase, nvalid, sample, sb = 0;
        if (item < 4096) { const int q = item >> 11, rem = item & 2047; h = rem & 15; rbase = q * SEQ + (rem >> 4) * 64; nvalid = 64; sample = 0; }
        else { const int sid = item - 4096; sb = sid >> 4; h = sid & 15; rbase = 16384 + sb * DSEQ; nvalid = DSEQ; sample = 1; }
        const int t = tid >> 3, jp = tid & 7, j0 = 8 * jp, col = 64 * h + j0; const bool valid = t < nvalid;
        float rf[8], kf[8], vf[8], wpf[8], apf[8], lw[8], av[8], bv[8], kp[8];
        u32x4 vraw = {0u, 0u, 0u, 0u};
        if (have_pf) { unpack8(nx0, rf); unpack8(nx1, kf); vraw = nx2; unpack8(nx3, wpf); unpack8(nx4, apf); }
        else if (valid) {
            const size_t row = (size_t)(rbase + t);
            unpack8(*(const u32x4*)(Z + row * ZW + C_R + col), rf); unpack8(*(const u32x4*)(Z + row * ZW + C_RK + col), kf); vraw = *(const u32x4*)(Z + row * ZW + C_RV + col);
            unpack8(*(const u32x4*)(T + row * 3072 + col), wpf); unpack8(*(const u32x4*)(T + row * 3072 + 1024 + col), apf);
            if (sample) { *(LAS u32x4*)(gblk + t * RS + j0) = *(const u32x4*)(T + row * 3072 + 2048 + col); *(LAS u32x4*)(vblk + t * RS + j0) = vraw; }
        }
        unpack8(vraw, vf);
        {
            const float* pw0 = inp(c, I_W0) + (size_t)l * D + col; const float* pa0 = inp(c, I_A0) + (size_t)l * D + col; const float* pkk = inp(c, I_KK) + (size_t)l * D + col;
            const float* pka = inp(c, I_KA) + (size_t)l * D + col; const float* prk = inp(c, I_RK) + (size_t)l * D + col;
            float ssq = 0.f, bsum = 0.f;
#pragma unroll
            for (int e = 0; e < 8; ++e) {
                if (valid) {
                    const float wlog = -softplusf_(-(pw0[e] + wpf[e])) - 0.5f; lw[e] = -__expf(wlog);
                    const float a = sigmoidf_(pa0[e] + apf[e]); const float kk = kf[e] * pkk[e]; ssq += kk * kk;
                    kp[e] = kf[e] * (1.0f + (a - 1.0f) * pka[e]); bsum += rf[e] * kp[e] * prk[e]; av[e] = kk; bv[e] = a;
                } else { lw[e] = 0.f; rf[e] = 0.f; kp[e] = 0.f; av[e] = 0.f; bv[e] = 0.f; }
            }
            ssq += __shfl_xor(ssq, 1); ssq += __shfl_xor(ssq, 2); ssq += __shfl_xor(ssq, 4);
            bsum += __shfl_xor(bsum, 1); bsum += __shfl_xor(bsum, 2); bsum += __shfl_xor(bsum, 4);
            const float inv = __builtin_amdgcn_rsqf(fmaxf(ssq, 1e-24f));
#pragma unroll
            for (int e = 0; e < 8; ++e) { const float kk = av[e] * inv; av[e] = -kk; bv[e] = kk * bv[e]; }
            if (jp == 0) { bon[t] = bsum; if (!sample) bonus_g[(size_t)(rbase + t) * 16 + h] = bsum; }
        }
#pragma unroll
        for (int e = 0; e < 8; ++e) cumb[t * 64 + j0 + e] = lw[e];
        __syncthreads();
        {
            const int j = tid & 63, sg = tid >> 6; float cs[8], run = 0.f;
#pragma unroll
            for (int e = 0; e < 8; ++e) { run += cumb[(8 * sg + e) * 64 + j]; cs[e] = run; }
            seg[sg * 64 + j] = run;
            __syncthreads();
            float off = 0.f;
#pragma unroll
            for (int s2 = 0; s2 < 8; ++s2) if (s2 < sg) off += seg[s2 * 64 + j];
#pragma unroll
            for (int e = 0; e < 8; ++e) cumb[(8 * sg + e) * 64 + j] = cs[e] + off;
        }
        __syncthreads();
        {
            float cu[8], cp[8], a8[8], r8[8], b8[8], k8[8];
#pragma unroll
            for (int e = 0; e < 8; ++e) { cu[e] = cumb[t * 64 + j0 + e]; cp[e] = t > 0 ? cumb[(t - 1) * 64 + j0 + e] : 0.f; }
#pragma unroll
            for (int e = 0; e < 8; ++e) { const float E = __expf(cu[e]), Em = __expf(-cu[e]), Ep = __expf(cp[e]);
                a8[e] = av[e] * Ep; r8[e] = rf[e] * E; b8[e] = bv[e] * Em; k8[e] = kp[e] * Em; if (t == 63) WL[j0 + e] = E; }
            const u32x4 aw = pack8(a8), rw = pack8(r8), bw = pack8(b8), kw = pack8(k8);
            *(LAS u32x4*)(At + t * RS + j0) = aw; *(LAS u32x4*)(Rt + t * RS + j0) = rw; *(LAS u32x4*)(Bt_ + t * RS + j0) = bw; *(LAS u32x4*)(Kt + t * RS + j0) = kw;
            *(LAS u32x4*)(MinvT + t * RS + j0) = vraw;
        }
        __syncthreads();
        LAUNDER2();
        {
            const int dp = tid & 31, so = (tid >> 5) & 7, which = tid >> 8;
#pragma unroll
            for (int a2 = 0; a2 < 2; ++a2) {
                const int arr = which + 2 * a2;
                const LAS bf16_t* src = arr == 0 ? At : (arr == 1 ? Bt_ : (arr == 2 ? Kt : MinvT));
                LAS bf16_t* dst = arr == 0 ? AtT : (arr == 1 ? BtT : (arr == 2 ? KtT : VT));
                unsigned wv[8];
#pragma unroll
                for (int e = 0; e < 8; ++e) wv[e] = *(const LAS unsigned*)(src + (8 * so + e) * RS + 2 * dp);
                u32x4 lo, hi;
                lo.x = (wv[0] & 0xffffu) | (wv[1] << 16); lo.y = (wv[2] & 0xffffu) | (wv[3] << 16); lo.z = (wv[4] & 0xffffu) | (wv[5] << 16); lo.w = (wv[6] & 0xffffu) | (wv[7] << 16);
                hi.x = (wv[0] >> 16) | (wv[1] & 0xffff0000u); hi.y = (wv[2] >> 16) | (wv[3] & 0xffff0000u); hi.z = (wv[4] >> 16) | (wv[5] & 0xffff0000u); hi.w = (wv[6] >> 16) | (wv[7] & 0xffff0000u);
                *(LAS u32x4*)(dst + (2 * dp) * RS + 8 * so) = lo; *(LAS u32x4*)(dst + (2 * dp + 1) * RS + 8 * so) = hi;
            }
        }
        {
            const int rt = w; const LAS bf16_t* Arow = (rt < 4 ? Bt_ + 16 * rt * RS : Kt + 16 * (rt - 4) * RS);
            f32x4 res[8];
#pragma unroll
            for (int ct = 0; ct < 8; ++ct) { f32x4 a = {0.f, 0.f, 0.f, 0.f}; res[ct] = mma_tile(Arow, RS, (ct < 4 ? At + 16 * ct * RS : Rt + 16 * (ct - 4) * RS), RS, 64, a, lane); }
#pragma unroll
            for (int ct = 0; ct < 8; ++ct) {
                const int s0 = 16 * (rt & 3) + (lane >> 4) * 4, tt = 16 * (ct & 3) + (lane & 15);
                f32x4 a = res[ct];
                if (ct < 4) {
#pragma unroll
                    for (int r = 0; r < 4; ++r) a[r] = (s0 + r < tt) ? a[r] : 0.f;
                    if (rt < 4) *(LAS f32x4*)(NfT + tt * 68 + s0) = a;
                    else { u32x2 wv; wv.x = pk2(a[0], a[1]); wv.y = pk2(a[2], a[3]); *(LAS u32x2*)(AakT + tt * RS + s0) = wv; }
                } else {
#pragma unroll
                    for (int r = 0; r < 4; ++r) a[r] = (s0 + r <= tt) ? a[r] : 0.f;
                    u32x2 wv; wv.x = pk2(a[0], a[1]); wv.y = pk2(a[2], a[3]);
                    if (rt < 4) *(LAS u32x2*)(AbrT + tt * RS + s0) = wv; else *(LAS u32x2*)(AkrT + tt * RS + s0) = wv;
                }
            }
        }
        __syncthreads();
        LAUNDER2();
        if (w == 0) {
            float M[64];
#pragma unroll
            for (int tt = 0; tt < 64; ++tt) {
                float a4[4] = {(lane == tt) ? 1.f : 0.f, 0.f, 0.f, 0.f};
#pragma unroll
                for (int p4 = 0; p4 < (tt + 3) / 4; ++p4) {
                    const f32x4 nv = *(const LAS f32x4*)(NfT + tt * 68 + 4 * p4);
#pragma unroll
                    for (int e = 0; e < 4; ++e) if (4 * p4 + e < tt) a4[e] += M[4 * p4 + e] * nv[e];
                }
                const float a = (a4[0] + a4[1]) + (a4[2] + a4[3]);
                M[tt] = a;
                MinvT[tt * RS + lane] = f2bf(a);
            }
        } else {
            for (int tl = w - 1; tl < 16; tl += 7) {
                const int ti = tl >> 2, tp = tl & 3; f32x4 a = {0.f, 0.f, 0.f, 0.f};
                a = mma_tile(VT + 16 * ti * RS, RS, AakT + 16 * tp * RS, RS, 64, a, lane);
#pragma unroll
                for (int r = 0; r < 4; ++r) XHm[(16 * ti + (lane >> 4) * 4 + r) * RS + 16 * tp + (lane & 15)] = f2bf(a[r]);
            }
        }
        __syncthreads();
        LAUNDER2();
#pragma unroll
        for (int k = 0; k < 4; ++k) {
            const int id = 4 * w + k, rtile = id >> 2, tt4 = id & 3; f32x4 a = {0.f, 0.f, 0.f, 0.f};
            a = mma_tile((rtile < 4 ? AtT + 16 * rtile * RS : XHm + 16 * (rtile - 4) * RS), RS, MinvT + 16 * tt4 * RS, RS, 64, a, lane);
            LAS bf16_t* dst = rtile < 4 ? UGm + 16 * rtile * RS : UHm + 16 * (rtile - 4) * RS;
#pragma unroll
            for (int r = 0; r < 4; ++r) dst[((lane >> 4) * 4 + r) * RS + 16 * tt4 + (lane & 15)] = f2bf(a[r]);
        }
        __syncthreads();
        LAUNDER2();
#pragma unroll
        for (int k = 0; k < 8; ++k) {
            const int mat = k >> 1, tile = w + 8 * (k & 1), ta = tile >> 2, tb = tile & 3, r0 = 16 * ta + (lane >> 4) * 4, cc = 16 * tb + (lane & 15);
            f32x4 a = {0.f, 0.f, 0.f, 0.f};
            if (mat == 0) {
                a = mma_tile(UGm + 16 * ta * RS, RS, BtT + 16 * tb * RS, RS, 64, a, lane);
                const float wl = WL[cc];
#pragma unroll
                for (int r = 0; r < 4; ++r) a[r] = (a[r] + ((r0 + r == cc) ? 1.f : 0.f)) * wl;
                u32x2 wv; wv.x = pk2(a[0], a[1]); wv.y = pk2(a[2], a[3]); *(LAS u32x2*)(GT + cc * RS + r0) = wv;
            } else if (mat == 1) {
                a = mma_tile(UHm + 16 * ta * RS, RS, BtT + 16 * tb * RS, RS, 64, a, lane);
                a = mma_tile(VT + 16 * ta * RS, RS, KtT + 16 * tb * RS, RS, 64, a, lane);
                const float wl = WL[cc];
#pragma unroll
                for (int r = 0; r < 4; ++r) Hm[(r0 + r) * RS + cc] = f2bf(a[r] * wl);
            } else if (mat == 2) {
                a = mma_tile(UGm + 16 * ta * RS, RS, AbrT + 16 * tb * RS, RS, 64, a, lane);
                const u32x2 rr = *(const LAS u32x2*)(Rt + cc * RS + r0);
                u32x2 wv; wv.x = pk2(a[0] + bflo(rr.x), a[1] + bfhi(rr.x)); wv.y = pk2(a[2] + bflo(rr.y), a[3] + bfhi(rr.y)); *(LAS u32x2*)(QT + cc * RS + r0) = wv;
            } else {
                a = mma_tile(UHm + 16 * ta * RS, RS, AbrT + 16 * tb * RS, RS, 64, a, lane);
                a = mma_tile(VT + 16 * ta * RS, RS, AkrT + 16 * tb * RS, RS, 64, a, lane);
                u32x2 wv; wv.x = pk2(a[0], a[1]); wv.y = pk2(a[2], a[3]); *(LAS u32x2*)(YHT + cc * RS + r0) = wv;
            }
        }
        __syncthreads();
        LAUNDER2();
        RA_PREFETCH(item + c.G - 64);
        if (!sample) {
            const int row = tid >> 3, pc = tid & 7; const size_t gr = (size_t)(rbase + row);
            *(u32x4*)(Z + gr * ZW + C_R + 64 * h + 8 * pc) = *(const LAS u32x4*)(GT + row * RS + 8 * pc);
            *(u32x4*)(Z + gr * ZW + C_RK + 64 * h + 8 * pc) = *(const LAS u32x4*)(QT + row * RS + 8 * pc);
            *(u32x4*)(T + gr * 3072 + 64 * h + 8 * pc) = *(const LAS u32x4*)(Hm + row * RS + 8 * pc);
            *(u32x4*)(T + gr * 3072 + 1024 + 64 * h + 8 * pc) = *(const LAS u32x4*)(YHT + row * RS + 8 * pc);
        } else {
            LAS bf16_t* S0b = AtT; LAS float* yT = (LAS float*)(L + RA_BtT);
            {
                const int i = tid >> 3, jq = tid & 7; float sf[8];
                const float* sp = inp(c, I_SRS) + ((((size_t)l * DB + sb) * 16 + h) * 64 + i) * 64 + 8 * jq;
#pragma unroll
                for (int e = 0; e < 8; ++e) sf[e] = sp[e];
                *(LAS u32x4*)(S0b + i * RS + 8 * jq) = pack8(sf);
            }
            __syncthreads();
            f32x4 sacc[4];
            rwkv_apply_tiles(w, lane, S0b, GT, QT, Hm, YHT, yT, sacc);
            if (w < 4) {
                float* os = outg(c) + O_SRS + (((size_t)l * DB + sb) * 16 + h) * 4096;
#pragma unroll
                for (int b = 0; b < 4; ++b)
#pragma unroll
                    for (int r = 0; r < 4; ++r) os[(size_t)(16 * w + (lane >> 4) * 4 + r) * 64 + 16 * b + (lane & 15)] = sacc[b][r];
            }
            __syncthreads();
            float lnw[8], lnb[8];
#pragma unroll
            for (int e = 0; e < 8; ++e) { lnw[e] = inp(c, I_LNW)[(size_t)l * D + 64 * h + 8 * (tid & 7) + e]; lnb[e] = inp(c, I_LNB)[(size_t)l * D + 64 * h + 8 * (tid & 7) + e]; }
            rwkv_post(tid, yT, vblk, gblk, bon, lnw, lnb, Z + (size_t)rbase * ZW + C_R + 64 * h, nvalid);
        }
        __syncthreads();
    }
}

constexpr int RB_S0 = 0, RB_YT = 9216, RB_BUF = 25856, RB_BUFSZ = 55552;
__device__ __forceinline__ void rwkv_rb_chain(const Ctx& c, unsigned& epoch, int p, int l, int q, int h) {
    bf16_t* Z = (bf16_t*)(wsg(c) + WS_Z); const bf16_t* T = (const bf16_t*)(wsg(c) + WS_T); const float* bonus_g = (const float*)(wsg(c) + WS_BONUS);
    const int tid = c.tid, lane = c.lane, w = c.wave; const Seq sq = seq_of(p, q);
    LAS unsigned char* L = c.lds; asm volatile("" : "+v"(L));
    LAS bf16_t* S0b = (LAS bf16_t*)(L + RB_S0); LAS float* yT = (LAS float*)(L + RB_YT);
    const int row = tid >> 3, pc = tid & 7, NCH = SEQ / 64;
    float lnw[8], lnb[8];
#pragma unroll
    for (int e = 0; e < 8; ++e) { lnw[e] = inp(c, I_LNW)[(size_t)l * D + 64 * h + 8 * pc + e]; lnb[e] = inp(c, I_LNB)[(size_t)l * D + 64 * h + 8 * pc + e]; }
    { unsigned zz = 0u; asm volatile("" : "+v"(zz)); const u32x4 z4 = {zz, zz, zz, zz}; *(LAS u32x4*)(S0b + row * RS + 8 * pc) = z4; }
    f32x4 sacc[4];
#pragma unroll
    for (int b = 0; b < 4; ++b) sacc[b] = (f32x4){0.f, 0.f, 0.f, 0.f};
    u32x4 pg, pq, ph, py, pv, pgb; float pbon = 0.f;
#define RB_LOAD(RB) do { const size_t gr = (size_t)((RB) + row); \
        pg = *(const u32x4*)(Z + gr * ZW + C_R + 64 * h + 8 * pc); pq = *(const u32x4*)(Z + gr * ZW + C_RK + 64 * h + 8 * pc); pv = *(const u32x4*)(Z + gr * ZW + C_RV + 64 * h + 8 * pc); \
        ph = *(const u32x4*)(T + gr * 3072 + 64 * h + 8 * pc); py = *(const u32x4*)(T + gr * 3072 + 1024 + 64 * h + 8 * pc); pgb = *(const u32x4*)(T + gr * 3072 + 2048 + 64 * h + 8 * pc); \
        if (tid < 64) pbon = bonus_g[(size_t)((RB) + tid) * 16 + h]; } while (0)
#define RB_PARK(BUF) do { LAS unsigned char* bb_ = L + RB_BUF + (BUF) * RB_BUFSZ; const int o_ = (row * RS + 8 * pc) * 2; \
        *(LAS u32x4*)(bb_ + o_) = pg; *(LAS u32x4*)(bb_ + 9216 + o_) = pq; *(LAS u32x4*)(bb_ + 18432 + o_) = ph; *(LAS u32x4*)(bb_ + 27648 + o_) = py; \
        *(LAS u32x4*)(bb_ + 36864 + o_) = pv; *(LAS u32x4*)(bb_ + 46080 + o_) = pgb; if (tid < 64) ((LAS float*)(bb_ + 55296))[tid] = pbon; } while (0)
    RB_LOAD(sq.row0); RB_PARK(0); RB_LOAD(sq.row0 + 64);
    __syncthreads();
    for (int ck = 0; ck < NCH; ++ck) {
        const int rbase = sq.row0 + ck * 64, cur = ck & 1;
        LAS unsigned char* bb = L + RB_BUF + cur * RB_BUFSZ;
        rwkv_apply_tiles(w, lane, S0b, (const LAS bf16_t*)bb, (const LAS bf16_t*)(bb + 9216), (const LAS bf16_t*)(bb + 18432), (const LAS bf16_t*)(bb + 27648), yT, sacc);
        __syncthreads();
        if (w < 4) {
#pragma unroll
            for (int b = 0; b < 4; ++b)
#pragma unroll
                for (int r = 0; r < 4; ++r) S0b[(16 * w + (lane >> 4) * 4 + r) * RS + 16 * b + (lane & 15)] = f2bf(sacc[b][r]);
        }
        rwkv_post(tid, yT, (const LAS bf16_t*)(bb + 36864), (const LAS bf16_t*)(bb + 46080), (const LAS float*)(bb + 55296), lnw, lnb, Z + (size_t)rbase * ZW + C_R + 64 * h, 64);
        if (ck + 1 < NCH) { RB_PARK(cur ^ 1); if (ck + 2 < NCH) RB_LOAD(rbase + 128); }
        __syncthreads();
        if (ck == 15 || ck == 79) grid_bar((unsigned*)(wsg(c) + WS_BAR), epoch, (unsigned)gridDim.x);
    }
#undef RB_LOAD
#undef RB_PARK
    if (w < 4) {
        float* os = outg(c) + O_PRS + (((size_t)l * NB + sq.b) * 16 + h) * 4096;
#pragma unroll
        for (int b = 0; b < 4; ++b)
#pragma unroll
            for (int r = 0; r < 4; ++r) os[(size_t)(16 * w + (lane >> 4) * 4 + r) * 64 + 16 * b + (lane & 15)] = sacc[b][r];
    }
}

__device__ __forceinline__ void phase_seqmix_a(const Ctx& c, int p, int l) {
    if (c.bid < 64) { const int q = c.bid >> 5, h = (c.bid >> 3) & 3, slab = c.bid & 7; mlstm_task(c, p, l, q, h, slab); }
    else {
        phase_rwkv_ra(c, p, l);
        if (p == 1) { const int nw = c.G - 64, wgi = c.bid - 64;
            for (int t = wgi; t < 512; t += nw) { const int q = 2 + (t >> 5), h = (t >> 3) & 3, slab = t & 7; mlstm_task(c, p, l, q, h, slab); } }
    }
}

__device__ __forceinline__ void phase_om(const Ctx& c, int p, int l) {
    bf16_t* Z = (bf16_t*)(wsg(c) + WS_Z); const int nrows = pass_rows(p), lane = c.lane, head = lane >> 4, part = lane & 15, col = 256 * head + 16 * part;
    float nm[16];
#pragma unroll
    for (int e = 0; e < 16; ++e) nm[e] = inp(c, I_MNORM)[(size_t)l * D + col + e];
    for (int r = c.bid * 8 + c.wave; r < nrows; r += c.G * 8) {
        float hv[16], zo[16];
        unpack8(*(const u32x4*)(Z + (size_t)r * ZW + C_V + col), *(float(*)[8])&hv[0]); unpack8(*(const u32x4*)(Z + (size_t)r * ZW + C_V + col + 8), *(float(*)[8])&hv[8]);
        unpack8(*(const u32x4*)(Z + (size_t)r * ZW + C_O + col), *(float(*)[8])&zo[0]); unpack8(*(const u32x4*)(Z + (size_t)r * ZW + C_O + col + 8), *(float(*)[8])&zo[8]);
        float s = 0.f;
#pragma unroll
        for (int e = 0; e < 16; ++e) s += hv[e];
        s += __shfl_xor(s, 1); s += __shfl_xor(s, 2); s += __shfl_xor(s, 4); s += __shfl_xor(s, 8);
        const float mean = s * (1.0f / 256.0f); float q = 0.f;
#pragma unroll
        for (int e = 0; e < 16; ++e) { hv[e] -= mean; q += hv[e] * hv[e]; }
        q += __shfl_xor(q, 1); q += __shfl_xor(q, 2); q += __shfl_xor(q, 4); q += __shfl_xor(q, 8);
        const float rstd = __builtin_amdgcn_rsqf(q * (1.0f / 256.0f) + 1e-6f);
        float o0[8], o1[8];
#pragma unroll
        for (int e = 0; e < 8; ++e) { o0[e] = sigmoidf_(zo[e]) * hv[e] * rstd * nm[e]; o1[e] = sigmoidf_(zo[8 + e]) * hv[8 + e] * rstd * nm[8 + e]; }
        *(u32x4*)(Z + (size_t)r * ZW + C_O + col) = pack8(o0); *(u32x4*)(Z + (size_t)r * ZW + C_O + col + 8) = pack8(o1);
    }
}

__global__ void __launch_bounds__(NTHREADS, 2) mega_fwd(Args args) {
    extern __shared__ __attribute__((aligned(16))) unsigned char lds_raw[];
    cg::grid_group grid = cg::this_grid();
    Ctx c; c.out = args.out; c.ws = args.ws; c.lds = (LAS unsigned char*)lds_raw;
    c.tid = threadIdx.x; c.lane = c.tid & 63; c.wave = __builtin_amdgcn_readfirstlane(c.tid >> 6); c.G = gridDim.x; c.bid = blockIdx.x; c.dry = 0;
    if (c.tid < N_IN) { const unsigned long long v = (unsigned long long)args.in[c.tid]; LAS unsigned* t = (LAS unsigned*)(c.lds + TAB_OFF); t[2 * c.tid] = (unsigned)v; t[2 * c.tid + 1] = (unsigned)(v >> 32); }
    __syncthreads();
    const int lo = args.ph_lo, hi = args.ph_hi; int ph = 0;
    unsigned epoch = 0u;
    grid.sync();
#define GSYNC() grid_bar((unsigned*)(wsg(c) + WS_BAR), epoch, (unsigned)gridDim.x)
#define W ((bf16_t*)wsg(c))
#define UP ((bf16_t*)(wsg(c) + WS_UP))
#define Zb ((bf16_t*)(wsg(c) + WS_Z))
#define Tb ((bf16_t*)(wsg(c) + WS_T))
#define X (outg(c))
#define PH(body) do { if (ph >= lo && ph < hi) { asm volatile("" : "+v"(c.tid), "+v"(c.lane), "+s"(c.bid), "+s"(c.wave), "+s"(c.G), "+s"(c.ws), "+s"(c.out), "+s"(c.lds)); body; if (ph + 1 < hi) GSYNC(); } ++ph; } while (0)
#define PHD(grp, body) PH(body)
    for (int l = 0; l < 2; ++l) {
        for (int st = 0; st < 3; ++st) {
            if (st != 1) {
                const int f = st >> 1;
                PH((f == 0 ? phase_cvt(c, l) : (void)0, phase_norm(c, (l == 0 && f == 0) ? inp(c, I_XP) : nullptr, inp(c, I_XS), X, 0, NTOK, inp(c, f ? I_F2N : I_F1N) + (size_t)l * D, Tb, nullptr, nullptr)));
                PHD(1, run_gemm(c, Tb, D, W + (f ? W_GU2 : W_GU1) / 2, D, NTOK, 2 * FF, D, 0, 0, EpiSwiglu{Zb}));
                PH((run_gemm(c, Zb, FF, W + (f ? W_D2 : W_D1) / 2, FF, NPROMPT, D, FF, 0, 0, EpiResAdd{X, 0.5f}),
                    run_gemm_splitk(c, Zb + (size_t)NPROMPT * FF, FF, W + (f ? W_D2 : W_D1) / 2, FF, FF, X + (size_t)NPROMPT * D, 0.5f)));
            } else {
                for (int p = 0; p < 2; ++p) {
                    const int Mp = pass_rows(p), g0 = p * 16384;
                    PH(phase_norm(c, nullptr, nullptr, X, g0, Mp, inp(c, I_MIXN) + (size_t)l * D, UP, (const float*)(wsg(c) + W_IF), (float*)(wsg(c) + WS_GIF)));
                    PHD(1, run_gemm(c, UP, D, W + W_IN / 2, D, Mp, ZW, D, 0, 0, EpiStore{Zb, ZW, 0}));
                    PH(phase_cv1(c, p, l));
                    PH(phase_cv2(c, p, l));
                    PH(run_gemm(c, Zb + C_LRU, ZW, W + W_LRU / 2, 256, Mp, 2048, 256, 4, 256, EpiStore{Tb, 2048, 0}));
                    PH((phase_lru<0>(c, p, l), phase_mlstm_s(c, p, l)));
                    PH(phase_lru<1>(c, p, l));
                    PH(run_gemm(c, Zb + C_WD, ZW, W + W_LORA / 2, 256, Mp, 3072, 256, 0, 0, EpiStore{Tb, 3072, 0}));
                    PHD(2, phase_seqmix_a(c, p, l));
                    {
                        asm volatile("" : "+v"(c.tid), "+v"(c.lane), "+s"(c.bid), "+s"(c.wave), "+s"(c.G), "+s"(c.ws), "+s"(c.out), "+s"(c.lds));
                        if (c.bid < 32) { rwkv_rb_chain(c, epoch, p, l, c.bid >> 4, c.bid & 15); GSYNC(); }
                        else {
                            Ctx c2 = c; c2.bid = c.bid - 32; c2.G = c.G - 32;
                            phase_om(c2, p, l); GSYNC();
                            asm volatile("" : "+v"(c2.tid), "+v"(c2.lane));
                            run_gemm(c2, (bf16_t*)(wsg(c2) + WS_UP), D, (bf16_t*)wsg(c2) + W_G / 2, D, Mp, 3072, D, 0, 0, EpiStore{(bf16_t*)(wsg(c2) + WS_Z), ZW, C_Q}); GSYNC();
                            for (int b = 0; b < 2; ++b) {
                                asm volatile("" : "+v"(c2.tid), "+v"(c2.lane));
                                run_gemm(c2, (bf16_t*)(wsg(c2) + WS_Z) + (b == 0 ? C_LRU : C_O), ZW, (bf16_t*)wsg(c2) + W_BR / 2 + (size_t)b * D * D, D, Mp, D, D, 0, 0, EpiMerge{(bf16_t*)(wsg(c2) + WS_UP), (const bf16_t*)(wsg(c2) + WS_Z), C_Q + 1024 * b, b == 0});
                            }
                            GSYNC();
                        }
                    }
                    PH(run_gemm(c, Zb + C_R, ZW, W + W_BR / 2 + (size_t)2 * D * D, D, Mp, D, D, 0, 0, EpiMerge{UP, Zb, C_Q + 2048, 0}));
                    PH(run_gemm(c, UP, D, W + W_OUT / 2, D, Mp, D, D, 0, 0, EpiResAdd{X + (size_t)g0 * D, 1.0f}));
                }
            }
        }
    }
    PH(phase_final_norm(c, X, inp(c, I_FN)));
#undef PH
#undef GSYNC
#undef PHD
#undef W
#undef UP
#undef Zb
#undef Tb
#undef X
}

extern "C" void kernel_launch(void* const* d_in, const int* in_sizes, int n_in, void* d_out, int out_size, void* d_ws, size_t ws_size, hipStream_t stream) {
    static int grid = 0;
    if (grid == 0) {
        if (n_in != N_IN || (size_t)out_size != O_END || ws_size < WS_END) { fprintf(stderr, "kernel_launch: unexpected shapes n_in %d out %d ws %zu\n", n_in, out_size, ws_size); grid = -1; return; }
        int dev = 0, cus = 0, per_cu = 0;
        hipGetDevice(&dev); hipDeviceGetAttribute(&cus, hipDeviceAttributeMultiprocessorCount, dev);
        if (hipFuncSetAttribute((const void*)mega_fwd, hipFuncAttributeMaxDynamicSharedMemorySize, LDS_BYTES) != hipSuccess) { fprintf(stderr, "hipFuncSetAttribute failed\n"); grid = -1; return; }
        hipOccupancyMaxActiveBlocksPerMultiprocessor(&per_cu, (const void*)mega_fwd, NTHREADS, LDS_BYTES);
        (void)hipGetLastError();
        if (per_cu < 1) per_cu = 1;
        grid = cus;
        if (grid > 256) grid = 256;
    }
    if (grid < 0) return;
    if (hipMemsetAsync((char*)d_ws + WS_BAR, 0, 4096, stream) != hipSuccess) { fprintf(stderr, "memset failed\n"); return; }
    Args a{};
    for (int i = 0; i < N_IN; ++i) a.in[i] = (const float*)d_in[i];
    a.out = (float*)d_out; a.ws = (unsigned char*)d_ws; a.ph_lo = 0; a.ph_hi = 1000;
    void* kargs[] = {&a};
    hipError_t e = hipLaunchCooperativeKernel((const void*)mega_fwd, dim3(grid), dim3(NTHREADS), kargs, LDS_BYTES, stream);
    if (e != hipSuccess) fprintf(stderr, "cooperative launch failed: %s (grid %d)\n", hipGetErrorString(e), grid);
}
```

```cpp
#include <hip/hip_runtime.h>
#include <hip/hip_cooperative_groups.h>
#include <cstdio>
namespace cg = cooperative_groups;
namespace pg8 {
#define PG8_LAS __attribute__((address_space(3)))
typedef unsigned short bf16_t;
typedef short bf16x8 __attribute__((ext_vector_type(8)));
typedef float f32x4 __attribute__((ext_vector_type(4)));
typedef unsigned u32x4 __attribute__((ext_vector_type(4)));
constexpr int BM = 256, BK = 64, HALF = 128, HTB = HALF * BK * 2  , STAGE_BYTES = 8 * HTB, NXCD = 8, WGM = 8;
__host__ __device__ __forceinline__ int lds_byte(int r, int c) { const int st = (r >> 4) * 2 + (c >> 5), rr = r & 15, cc = c & 31, ob = rr * 64 + cc * 2; return st * 1024 + (ob ^ (((ob >> 9) & 1) << 5)); }
__host__ __device__ __forceinline__ void stage_rc(int b, int& R, int& C) { const int st = b / 1024, sb = b % 1024, swz = sb ^ (((sb >> 9) & 1) << 5); R = (st >> 1) * 16 + swz / 64; C = (st & 1) * 32 + (swz % 64) / 2; }
__host__ __device__ __forceinline__ int perm32(int rho) { const int n = rho >> 4, i = rho & 15; return 8 * (i >> 2) + 4 * n + (i & 3); }
struct Unit { int pm, pn; };
struct Gemm { const bf16_t* A; int lda; const bf16_t* Bt; int ldb; int M, N, K; int amod, astride; int ksn, kchunk;
    __device__ __forceinline__ size_t acol(int pn) const { return (amod ? (size_t)((pn % amod) * astride) * 2 : (size_t)0) + (ksn ? (size_t)((pn / ksn) * kchunk) * 2 : (size_t)0); }
    __device__ __forceinline__ size_t boff(int pn, size_t tstepB) const { return ksn ? (size_t)(pn % ksn) * tstepB + (size_t)((pn / ksn) * kchunk) * 2 : (size_t)pn * tstepB; } };
struct StaticOrder {
    int nM, nN, nwg, G, c;
    __host__ __device__ void init(int M, int N, int G_, int c_) { nM = M / BM; nN = N / BM; nwg = nM * nN; G = G_; c = c_; }
    __host__ __device__ bool next(int i, Unit& u) const {
        const long L = (long)i * G + c; if (L >= nwg) return false;
        int wgid = (int)L; { const int q = nwg / NXCD, r = nwg % NXCD, xcd = wgid % NXCD, off = wgid / NXCD; wgid = (xcd < r ? xcd * (q + 1) : r * (q + 1) + (xcd - r) * q) + off; }
        const int nig = WGM * nN, gid = wgid / nig, fm = gid * WGM, gsz = (nM - fm) < WGM ? (nM - fm) : WGM;
        u.pm = fm + ((wgid % nig) % gsz); u.pn = (wgid % nig) / gsz; return true;
    }
    __device__ __forceinline__ void a_ready(const Unit&) const {}
    __device__ __forceinline__ void done(const Unit&) const {}
};
__device__ __forceinline__ unsigned cvt_pk_bf16(float lo, float hi) { unsigned r; asm volatile("v_cvt_pk_bf16_f32 %0, %1, %2" : "=v"(r) : "v"(lo), "v"(hi)); return r; }
template <class Epi, class Sched>
__device__ __forceinline__ void gemm_phase(PG8_LAS unsigned char* lds, const Gemm g, const Sched& S, const Epi& E, const int tid_in) {
    const int tid = tid_in, wid = __builtin_amdgcn_readfirstlane(tid >> 6), lane = tid & 63, wr = wid >> 2, wc = wid & 3, fr = lane & 15, fq = lane >> 4;
    const int K = g.K, nt = K / BK;
    unsigned voffA[2], voffB[2];
#pragma unroll
    for (int i = 0; i < 2; ++i) { int R, C; stage_rc(tid * 16 + i * 8192, R, C); const int Rb = Epi::PERM ? ((R & ~31) + perm32(R & 31)) : R;
        voffA[i] = (unsigned)(R * g.lda + C) * 2u; voffB[i] = (unsigned)(Rb * g.ldb + C) * 2u; }
    const size_t kstep = (size_t)(BK * 2);
    const size_t hstepA = (size_t)HALF * g.lda * 2, hstepB = (size_t)HALF * g.ldb * 2;
    const size_t tstepA = 2 * hstepA, tstepB = 2 * hstepB;
    const unsigned ldsw = (unsigned)wid * 1024u;
    const int aoff = lds_byte(wr * 64 + fr, fq * 8), boff = lds_byte(wc * 32 + fr, fq * 8);
#define PG8_SA(b, h) (((b) * 2 + (h)) * HTB)
#define PG8_SB(b, h) ((4 + (b) * 2 + (h)) * HTB)
#define PG8_STAGE(bufoff, gbase, voff) do { _Pragma("unroll") for (int _i = 0; _i < 2; ++_i) \
        __builtin_amdgcn_global_load_lds((const unsigned*)((const char*)(gbase) + (voff)[_i]), (PG8_LAS unsigned*)(lds + (bufoff) + ldsw + _i * 8192), 16, 0, 0); } while (0)
#define PG8_LDA(dst, b, h) do { _Pragma("unroll") for (int m = 0; m < 4; ++m) _Pragma("unroll") for (int k = 0; k < 2; ++k) dst[m][k] = *(const PG8_LAS bf16x8*)(lds + PG8_SA(b, h) + aoff + m * 2048 + k * 1024); } while (0)
#define PG8_LDB(dst, b, h) do { _Pragma("unroll") for (int n = 0; n < 2; ++n) _Pragma("unroll") for (int k = 0; k < 2; ++k) dst[n][k] = *(const PG8_LAS bf16x8*)(lds + PG8_SB(b, h) + boff + n * 2048 + k * 1024); } while (0)
#define PG8_MMA(ai, bj, At, Bt) do { __builtin_amdgcn_s_setprio(1); _Pragma("unroll") for (int m = 0; m < 4; ++m) _Pragma("unroll") for (int n = 0; n < 2; ++n) _Pragma("unroll") for (int k = 0; k < 2; ++k) \
        acc[ai][bj][m][n] = __builtin_amdgcn_mfma_f32_16x16x32_bf16(Bt[n][k], At[m][k], acc[ai][bj][m][n], 0, 0, 0); __builtin_amdgcn_s_setprio(0); } while (0)
#define PG8_WAIT_V(n) asm volatile("s_waitcnt vmcnt(" #n ")" ::: "memory")
#define PG8_WAIT_L(n) asm volatile("s_waitcnt lgkmcnt(" #n ")" ::: "memory")
#define PG8_BAR __builtin_amdgcn_s_barrier()
#define PG8_SCHED __builtin_amdgcn_sched_barrier(0)
    Unit cur, nxt; int ui = 0;
    if (!S.next(0, cur)) return;
    f32x4 acc[2][2][4][2];
#pragma unroll
    for (int a = 0; a < 2; ++a)
#pragma unroll
        for (int b = 0; b < 2; ++b)
#pragma unroll
            for (int m = 0; m < 4; ++m)
#pragma unroll
                for (int n = 0; n < 2; ++n) acc[a][b][m][n] = (f32x4){0.f, 0.f, 0.f, 0.f};
    bf16x8 At[4][2], B0[2][2], B1[2][2];
    const char* cA = (const char*)g.A + (size_t)cur.pm * tstepA + g.acol(cur.pn); const char* cB = (const char*)g.Bt + g.boff(cur.pn, tstepB);
    S.a_ready(cur);
    PG8_STAGE(PG8_SB(0, 0), cB, voffB); PG8_STAGE(PG8_SA(0, 0), cA, voffA); PG8_STAGE(PG8_SB(0, 1), cB + hstepB, voffB); PG8_STAGE(PG8_SA(0, 1), cA + hstepA, voffA);
    if (wr == 1) PG8_BAR;
    PG8_WAIT_V(4); PG8_BAR;
    PG8_STAGE(PG8_SB(1, 0), cB + kstep, voffB); PG8_STAGE(PG8_SA(1, 0), cA + kstep, voffA); PG8_STAGE(PG8_SB(1, 1), cB + hstepB + kstep, voffB);
    PG8_WAIT_V(6); PG8_BAR;
    for (;;) {
        const bool has_next = S.next(ui + 1, nxt);
        const char* nA = has_next ? (const char*)g.A + (size_t)nxt.pm * tstepA + g.acol(nxt.pn) : cA; const char* nB = has_next ? (const char*)g.Bt + g.boff(nxt.pn, tstepB) : cB;
        for (int t = 0; t < nt; t += 2) {
            const bool last = (t == nt - 2);
            const char* a1 = cA + (size_t)(t + 1) * kstep;
            const char* a2 = last ? nA : cA + (size_t)(t + 2) * kstep; const char* b2 = last ? nB : cB + (size_t)(t + 2) * kstep;
            const char* a3 = a2 + kstep; const char* b3 = b2 + kstep;
            if (last && has_next) S.a_ready(nxt);
            PG8_LDB(B0, 0, 0); PG8_SCHED; PG8_LDA(At, 0, 0); PG8_STAGE(PG8_SA(1, 1), a1 + hstepA, voffA);
            PG8_WAIT_L(8); PG8_BAR; PG8_WAIT_L(0); PG8_MMA(0, 0, At, B0); PG8_BAR; PG8_SCHED;
            PG8_LDB(B1, 0, 1); PG8_STAGE(PG8_SB(0, 0), b2, voffB);
            PG8_BAR; PG8_WAIT_L(0); PG8_MMA(0, 1, At, B1); PG8_BAR;
            PG8_LDA(At, 0, 1); PG8_STAGE(PG8_SA(0, 0), a2, voffA);
            PG8_BAR; PG8_WAIT_L(0); PG8_MMA(1, 0, At, B0); PG8_BAR; PG8_SCHED;
            PG8_STAGE(PG8_SB(0, 1), b2 + hstepB, voffB);
            PG8_WAIT_V(6); PG8_BAR; PG8_MMA(1, 1, At, B1); PG8_BAR;
            PG8_LDB(B0, 1, 0); PG8_SCHED; PG8_LDA(At, 1, 0); PG8_STAGE(PG8_SA(0, 1), a2 + hstepA, voffA);
            PG8_WAIT_L(8); PG8_BAR; PG8_WAIT_L(0); PG8_MMA(0, 0, At, B0); PG8_BAR; PG8_SCHED;
            PG8_LDB(B1, 1, 1); PG8_STAGE(PG8_SB(1, 0), b3, voffB);
            PG8_BAR; PG8_WAIT_L(0); PG8_MMA(0, 1, At, B1); PG8_BAR;
            PG8_LDA(At, 1, 1); PG8_STAGE(PG8_SA(1, 0), a3, voffA);
            PG8_BAR; PG8_WAIT_L(0); PG8_MMA(1, 0, At, B0); PG8_BAR; PG8_SCHED;
            PG8_STAGE(PG8_SB(1, 1), b3 + hstepB, voffB);
            PG8_WAIT_V(6); PG8_BAR; PG8_MMA(1, 1, At, B1); PG8_BAR;
        }
        if constexpr (!Epi::AFTER_DRAIN) { E(acc, cur, wr, wc, fr, fq); S.done(cur); }
        if (!has_next) break;
#pragma unroll
        for (int a = 0; a < 2; ++a)
#pragma unroll
            for (int b = 0; b < 2; ++b)
#pragma unroll
                for (int m = 0; m < 4; ++m)
#pragma unroll
                    for (int n = 0; n < 2; ++n) acc[a][b][m][n] = (f32x4){0.f, 0.f, 0.f, 0.f};
        cur = nxt; cA = nA; cB = nB; ++ui;
    }
    PG8_WAIT_V(0);
    if (wr == 0) PG8_BAR;
    PG8_BAR;
    if constexpr (Epi::AFTER_DRAIN) { E.fused(acc, cur, wr, wc, fr, fq, lds, wid, lane); S.done(cur); }
#undef PG8_SA
#undef PG8_SB
#undef PG8_STAGE
#undef PG8_LDA
#undef PG8_LDB
#undef PG8_MMA
#undef PG8_WAIT_V
#undef PG8_WAIT_L
#undef PG8_BAR
#undef PG8_SCHED
}

}

#define LAS __attribute__((address_space(3)))
typedef unsigned short bf16_t;
typedef short bf16x8 __attribute__((ext_vector_type(8)));
typedef float f32x4 __attribute__((ext_vector_type(4)));
typedef unsigned u32x4 __attribute__((ext_vector_type(4)));
typedef unsigned u32x2 __attribute__((ext_vector_type(2)));

constexpr int D = 1024, FF = 2816, NTOK = 33024, NPROMPT = 32768, SEQ = 8192, DSEQ = 16, NB = 4, DB = 16;
constexpr int ZW = 8448, C_LRU = 0, C_Q = 1024, C_K = 2048, C_V = 3072, C_O = 4096, C_R = 5120, C_RK = 6144, C_RV = 7168, C_WD = 8192;
constexpr int INW = 11528, CONVCH = 3072, RIN = 3328;
constexpr int NTHREADS = 512;
constexpr int LDS_BYTES = 147456;

constexpr size_t W_GU1 = 0, W_D1 = 11534336, W_GU2 = 17301504, W_D2 = 28835840, W_IN = 34603008, W_G = 51904512, W_LRU = 58195968, W_LORA = 59244544,
                 W_BR = 60817408, W_OUT = 67108864, W_IF = 69206016;
constexpr size_t WS_BAR = 513229056, WS_SL = 504316160;
constexpr size_t WS_UP = 69238784, WS_Z = 103317504, WS_T = 384466944, WS_HALO = 486703104, WS_GIF = 500490240, WS_CAR = 501022720, WS_BONUS = 503250944, WS_END = 513229056 + 4096;

constexpr size_t O_Y = 0, O_PCONV = 33816576, O_PLRU = O_PCONV + 73728, O_PMC = O_PLRU + 8192, O_PMN = O_PMC + 2097152, O_PMM = O_PMN + 8192, O_PSH = O_PMM + 32,
                 O_PRS = O_PSH + 26624, O_SCONV = O_PRS + 524288, O_SLRU = O_SCONV + 294912, O_SMC = O_SLRU + 32768, O_SMN = O_SMC + 8388608, O_SMM = O_SMN + 32768,
                 O_SSH = O_SMM + 128, O_SRS = O_SSH + 106496, O_END = O_SRS + 2097152;

enum { I_XP = 0, I_XS, I_SCONV, I_SLRU, I_SMC, I_SMN, I_SMM, I_SSH, I_SRS, I_F1N, I_F1G, I_F1U, I_F1D, I_MIXN, I_WIN, I_CONVW, I_CONVB, I_LWA, I_LBA, I_LWX, I_LBX,
       I_LLAM, I_IFB, I_MNORM, I_MU, I_W0, I_W2, I_A0, I_A2, I_G2, I_KK, I_KA, I_RK, I_LNW, I_LNB, I_WBR, I_WOUT, I_F2N, I_F2G, I_F2U, I_F2D, I_FN, N_IN };

struct Args { const float* in[N_IN]; float* out; unsigned char* ws; int ph_lo, ph_hi; };

constexpr int TAB_OFF = LDS_BYTES - 512;
struct Ctx {
    float* out; unsigned char* ws; LAS unsigned char* lds;
    int tid, lane, wave, G, bid, dry;
};

__device__ __forceinline__ const float* inp(const Ctx& c, int i) {
    const LAS unsigned* t = (const LAS unsigned*)(c.lds + TAB_OFF);
    const unsigned lo = __builtin_amdgcn_readfirstlane(t[2 * i]), hi = __builtin_amdgcn_readfirstlane(t[2 * i + 1]);
    typedef const float __attribute__((address_space(1)))* gptr_t;
    return (const float*)(gptr_t)(((unsigned long long)hi << 32) | (unsigned long long)lo);
}
#define GAS __attribute__((address_space(1)))
__device__ __forceinline__ unsigned char* wsg(const Ctx& c) { return (unsigned char*)(GAS unsigned char*)(unsigned long long)c.ws; }
__device__ __forceinline__ float* outg(const Ctx& c) { return (float*)(GAS float*)(unsigned long long)c.out; }
__device__ __forceinline__ float bf2f(bf16_t b) { return __uint_as_float(((unsigned)b) << 16); }
__device__ __forceinline__ float bflo(unsigned w) { return __uint_as_float(w << 16); }
__device__ __forceinline__ float bfhi(unsigned w) { return __uint_as_float(w & 0xffff0000u); }
__device__ __forceinline__ bf16_t f2bf(float f) { unsigned u = __float_as_uint(f); u += 0x7FFFu + ((u >> 16) & 1u); return (bf16_t)(u >> 16); }
typedef __bf16 bf16v2_t __attribute__((ext_vector_type(2)));
typedef float f32v2_t __attribute__((ext_vector_type(2)));
__device__ __forceinline__ unsigned pk2(float lo, float hi) {
    const f32v2_t f = {lo, hi}; const bf16v2_t b = __builtin_convertvector(f, bf16v2_t); return __builtin_bit_cast(unsigned, b);
}
__device__ __forceinline__ void unpack8(const u32x4 w, float (&f)[8]) { f[0] = bflo(w.x); f[1] = bfhi(w.x); f[2] = bflo(w.y); f[3] = bfhi(w.y); f[4] = bflo(w.z); f[5] = bfhi(w.z); f[6] = bflo(w.w); f[7] = bfhi(w.w); }
__device__ __forceinline__ u32x4 pack8(const float (&f)[8]) { u32x4 w; w.x = pk2(f[0], f[1]); w.y = pk2(f[2], f[3]); w.z = pk2(f[4], f[5]); w.w = pk2(f[6], f[7]); return w; }
__device__ __forceinline__ float sigmoidf_(float x) { return __builtin_amdgcn_rcpf(1.0f + __expf(-x)); }
__device__ __forceinline__ float siluf_(float x) { return x * __builtin_amdgcn_rcpf(1.0f + __expf(-x)); }
__device__ __forceinline__ float softplusf_(float x) { return fmaxf(x, 0.f) + __logf(1.0f + __expf(-fabsf(x))); }
__device__ __forceinline__ float tanhf_(float x) { return 1.0f - 2.0f * __builtin_amdgcn_rcpf(__expf(2.0f * x) + 1.0f); }
__device__ __forceinline__ float wsum(float v) {
#pragma unroll
    for (int o = 32; o >= 1; o >>= 1) v += __shfl_xor(v, o);
    return v;
}

__device__ __forceinline__ int pass_rows(int p) { return p ? 16640 : 16384; }
__device__ __forceinline__ int pass_nseg(int p) { return p ? 272 : 256; }
__device__ __forceinline__ int pass_nseq(int p) { return p ? 18 : 2; }
struct Seq { int row0, T, sample, b; };
__device__ __forceinline__ Seq seq_of(int p, int q) { Seq s; if (q < 2) { s.row0 = q * SEQ; s.T = SEQ; s.sample = 0; s.b = 2 * p + q; } else { s.row0 = 16384 + (q - 2) * DSEQ; s.T = DSEQ; s.sample = 1; s.b = q - 2; } return s; }
struct Seg { int q, c, row0, n, nch; };
__device__ __forceinline__ Seg seg_of(int s) { Seg g; if (s < 256) { g.q = s >> 7; g.c = s & 127; g.row0 = g.q * SEQ + g.c * 64; g.n = 64; g.nch = 128; } else { g.q = 2 + (s - 256); g.c = 0; g.row0 = 16384 + (s - 256) * DSEQ; g.n = DSEQ; g.nch = 1; } return g; }

__device__ __forceinline__ void grid_bar(unsigned* bar, unsigned& epoch, unsigned G) {
    __syncthreads();
    epoch += 1u;
    if (threadIdx.x == 0) {
        const unsigned ng = (G & 7u) ? 1u : 8u, grp = blockIdx.x % ng, per = G / ng;
        unsigned* xc = bar + 64 + 64 * grp;
        const unsigned old = __hip_atomic_fetch_add(xc, 1u, __ATOMIC_ACQ_REL, __HIP_MEMORY_SCOPE_AGENT);
        if (old + 1u == epoch * per) {
            const unsigned og = __hip_atomic_fetch_add(bar, 1u, __ATOMIC_ACQ_REL, __HIP_MEMORY_SCOPE_AGENT);
            if (og + 1u == epoch * ng)
                for (unsigned g2 = 0; g2 < ng; ++g2) __hip_atomic_store(bar + 640 + 32 * g2, epoch, __ATOMIC_RELEASE, __HIP_MEMORY_SCOPE_AGENT);
        }
        while (__hip_atomic_load(bar + 640 + 32 * grp, __ATOMIC_RELAXED, __HIP_MEMORY_SCOPE_AGENT) < epoch) __builtin_amdgcn_s_sleep(1);
        __builtin_amdgcn_fence(__ATOMIC_ACQUIRE, "agent");
        asm volatile("s_waitcnt vmcnt(0)" ::: "memory");
    }
    __syncthreads();
}

struct EpiSwiglu {
    static constexpr bool PERM = true, AFTER_DRAIN = false;
    bf16_t* H;
    __device__ __forceinline__ void operator()(const f32x4 (&acc)[2][2][4][2], const pg8::Unit& u, int wr, int wc, int fr, int fq) const {
        const int row0 = u.pm * 256 + wr * 64 + fr, col0 = u.pn * 128 + wc * 32 + 8 * fq;
#pragma unroll
        for (int ai = 0; ai < 2; ++ai)
#pragma unroll
            for (int m = 0; m < 4; ++m) {
                float o[8];
#pragma unroll
                for (int n = 0; n < 2; ++n)
#pragma unroll
                    for (int j = 0; j < 4; ++j) o[4 * n + j] = siluf_(acc[ai][0][m][n][j]) * acc[ai][1][m][n][j];
                *(u32x4*)(H + (size_t)(row0 + ai * 128 + m * 16) * FF + col0) = pack8(o);
            }
    }
};
struct EpiResAdd {
    static constexpr bool PERM = false, AFTER_DRAIN = false;
    float* X; float s;
    __device__ __forceinline__ void operator()(const f32x4 (&acc)[2][2][4][2], const pg8::Unit& u, int wr, int wc, int fr, int fq) const {
        const int row0 = u.pm * 256 + wr * 64 + fr, col0 = u.pn * 256 + wc * 32 + 4 * fq;
#pragma unroll
        for (int ai = 0; ai < 2; ++ai)
#pragma unroll
            for (int m = 0; m < 4; ++m) {
                float* rowp = X + (size_t)(row0 + ai * 128 + m * 16) * D + col0;
#pragma unroll
                for (int bj = 0; bj < 2; ++bj)
#pragma unroll
                    for (int n = 0; n < 2; ++n) { f32x4* p = (f32x4*)(rowp + bj * 128 + n * 16); *p = *p + acc[ai][bj][m][n] * s; }
            }
    }
};
struct EpiResAddAtomic {
    static constexpr bool PERM = false, AFTER_DRAIN = false;
    float* X; float s;
    __device__ __forceinline__ void operator()(const f32x4 (&acc)[2][2][4][2], const pg8::Unit& u, int wr, int wc, int fr, int fq) const {
        const int row0 = u.pm * 256 + wr * 64 + fr, col0 = (u.pn & 3) * 256 + wc * 32 + 4 * fq;
#pragma unroll
        for (int ai = 0; ai < 2; ++ai)
#pragma unroll
            for (int m = 0; m < 4; ++m) {
                float* rowp = X + (size_t)(row0 + ai * 128 + m * 16) * D + col0;
#pragma unroll
                for (int bj = 0; bj < 2; ++bj)
#pragma unroll
                    for (int n = 0; n < 2; ++n)
#pragma unroll
                        for (int j = 0; j < 4; ++j) __hip_atomic_fetch_add(rowp + bj * 128 + n * 16 + j, acc[ai][bj][m][n][j] * s, __ATOMIC_RELAXED, __HIP_MEMORY_SCOPE_AGENT);
            }
    }
};
struct EpiStore {
    static constexpr bool PERM = true, AFTER_DRAIN = false;
    bf16_t* O; int ldc, coff;
    __device__ __forceinline__ void operator()(const f32x4 (&acc)[2][2][4][2], const pg8::Unit& u, int wr, int wc, int fr, int fq) const {
        const int row0 = u.pm * 256 + wr * 64 + fr, col0 = coff + u.pn * 256 + wc * 32 + 8 * fq;
#pragma unroll
        for (int ai = 0; ai < 2; ++ai)
#pragma unroll
            for (int m = 0; m < 4; ++m) {
                bf16_t* rowp = O + (size_t)(row0 + ai * 128 + m * 16) * ldc + col0;
#pragma unroll
                for (int bj = 0; bj < 2; ++bj) {
                    u32x4 w; w.x = pk2(acc[ai][bj][m][0][0], acc[ai][bj][m][0][1]); w.y = pk2(acc[ai][bj][m][0][2], acc[ai][bj][m][0][3]);
                    w.z = pk2(acc[ai][bj][m][1][0], acc[ai][bj][m][1][1]); w.w = pk2(acc[ai][bj][m][1][2], acc[ai][bj][m][1][3]);
                    *(u32x4*)(rowp + bj * 128) = w;
                }
            }
    }
};
struct EpiMerge {
    static constexpr bool PERM = true, AFTER_DRAIN = false;
    bf16_t* Mb; const bf16_t* Z; int goff, first;
    __device__ __forceinline__ void operator()(const f32x4 (&acc)[2][2][4][2], const pg8::Unit& u, int wr, int wc, int fr, int fq) const {
        const int row0 = u.pm * 256 + wr * 64 + fr, col0 = u.pn * 256 + wc * 32 + 8 * fq;
#pragma unroll
        for (int ai = 0; ai < 2; ++ai)
#pragma unroll
            for (int m = 0; m < 4; ++m) {
                const size_t row = (size_t)(row0 + ai * 128 + m * 16);
#pragma unroll
                for (int bj = 0; bj < 2; ++bj) {
                    float gt[8], mv[8], o[8];
                    unpack8(*(const u32x4*)(Z + row * ZW + goff + col0 + bj * 128), gt);
                    if (!first) unpack8(*(const u32x4*)(Mb + row * D + col0 + bj * 128), mv);
#pragma unroll
                    for (int n = 0; n < 2; ++n)
#pragma unroll
                        for (int j = 0; j < 4; ++j) o[4 * n + j] = (first ? 0.f : mv[4 * n + j]) + sigmoidf_(gt[4 * n + j]) * acc[ai][bj][m][n][j];
                    *(u32x4*)(Mb + row * D + col0 + bj * 128) = pack8(o);
                }
            }
    }
};

template <class Epi>
__device__ __forceinline__ void run_gemm(const Ctx& c, const bf16_t* A, int lda, const bf16_t* Bt, int ldb, int M, int N, int K, int amod, int astride, const Epi& E) {
    pg8::Gemm g{A, lda, Bt, ldb, M, N, K, amod, astride, 0, 0};
    pg8::StaticOrder S; S.init(M, N, c.G, c.bid);
    pg8::gemm_phase<Epi, pg8::StaticOrder>(c.lds, g, S, E, c.tid);
    __syncthreads();
}

__device__ __forceinline__ void run_gemm_splitk(const Ctx& c, const bf16_t* A, int lda, const bf16_t* Bt, int ldb, int K, float* X, float sc) {
    pg8::Gemm g{A, lda, Bt, ldb, 256, 1024 * (K / 256), 256, 0, 0, 4, 256};
    pg8::StaticOrder S; S.init(256, 1024 * (K / 256), c.G, (c.bid + 128) % c.G);
    pg8::gemm_phase<EpiResAddAtomic, pg8::StaticOrder>(c.lds, g, S, EpiResAddAtomic{X, sc}, c.tid);
    __syncthreads();
}

__device__ __forceinline__ void phase_cvt(const Ctx& c, int l) {
    bf16_t* W = (bf16_t*)wsg(c);
    const int cum[11] = {0, 1408, 2112, 3520, 4224, 6336, 7104, 7232, 7424, 8192, 8448};
    const int tid = c.tid;
    for (int t0 = c.bid * 4; t0 < 8448; t0 += c.G * 4) {
        bf16_t* dsts[4]; int ldds[4]; bool nz[4];
#pragma unroll
        for (int u = 0; u < 4; ++u) {
            const int t = t0 + u;
            int job = 0, base = 0;
#pragma unroll
            for (int j = 1; j < 10; ++j) if (t >= cum[j]) { job = j; base = cum[j]; }
            const int tt = t - base;
            const float* src = nullptr; int ld = 0; bf16_t* dst = nullptr; int ldd = 0;
            if (job == 0 || job == 2) {
                const int tn = tt >> 4, tk = tt & 15, n0 = tn * 64, k0 = tk * 64, pn = n0 >> 8, bj = (n0 >> 7) & 1, cc = n0 & 127;
                const float* g = inp(c, job == 0 ? I_F1G : I_F2G); const float* up = inp(c, job == 0 ? I_F1U : I_F2U);
                src = (bj ? up : g) + (size_t)l * D * FF + (size_t)k0 * FF + 128 * pn + cc; ld = FF;
                dst = W + (job == 0 ? W_GU1 : W_GU2) / 2 + (size_t)n0 * D + k0; ldd = D;
            } else if (job == 1 || job == 3) {
                const int tn = tt / 44, tk = tt % 44, n0 = tn * 64, k0 = tk * 64;
                src = inp(c, job == 1 ? I_F1D : I_F2D) + (size_t)l * FF * D + (size_t)k0 * D + n0; ld = D;
                dst = W + (job == 1 ? W_D1 : W_D2) / 2 + (size_t)n0 * FF + k0; ldd = FF;
            } else if (job == 4) {
                const int tn = tt >> 4, tk = tt & 15, n0 = tn * 64, k0 = tk * 64, col = n0 < 5120 ? n0 : n0 + 8;
                src = inp(c, I_WIN) + (size_t)l * D * INW + (size_t)k0 * INW + col; ld = INW;
                dst = W + W_IN / 2 + (size_t)n0 * D + k0; ldd = D;
            } else if (job == 5) {
                const int tn = tt >> 4, tk = tt & 15, n0 = tn * 64, k0 = tk * 64;
                src = inp(c, I_WIN) + (size_t)l * D * INW + (size_t)k0 * INW + 8456 + n0; ld = INW;
                dst = W + W_G / 2 + (size_t)n0 * D + k0; ldd = D;
            } else if (job == 6) {
                const int tn = tt >> 2, tk = tt & 3, n0 = tn * 64, k0 = tk * 64, which = n0 >> 10, nn = n0 & 1023, blk = nn >> 7, j0 = nn & 127, kblk = k0 >> 7, i0 = k0 & 127;
                if (kblk == (blk & 1)) { src = inp(c, which ? I_LWX : I_LWA) + (size_t)l * 8 * 128 * 128 + (size_t)blk * 128 * 128 + (size_t)i0 * 128 + j0; ld = 128; }
                dst = W + W_LRU / 2 + (size_t)n0 * 256 + k0; ldd = 256;
            } else if (job == 7) {
                const int tn = tt >> 2, tk = tt & 3, n0 = tn * 64, k0 = tk * 64;
                if (n0 < 1024) { if (tk == 0) { src = inp(c, I_W2) + (size_t)l * 64 * D + n0; ld = D; } }
                else if (n0 < 2048) { if (tk == 1) { src = inp(c, I_A2) + (size_t)l * 64 * D + (n0 - 1024); ld = D; } }
                else { if (tk >= 2) { src = inp(c, I_G2) + (size_t)l * 128 * D + (size_t)(k0 - 128) * D + (n0 - 2048); ld = D; } }
                dst = W + W_LORA / 2 + (size_t)n0 * 256 + k0; ldd = 256;
            } else if (job == 8) {
                const int tn = tt >> 4, tk = tt & 15, n0 = tn * 64, k0 = tk * 64, b = n0 >> 10, nn = n0 & 1023;
                src = inp(c, I_WBR) + (size_t)l * 3 * D * D + (size_t)b * D * D + (size_t)k0 * D + nn; ld = D;
                dst = W + W_BR / 2 + (size_t)n0 * D + k0; ldd = D;
            } else {
                const int tn = tt >> 4, tk = tt & 15, n0 = tn * 64, k0 = tk * 64;
                src = inp(c, I_WOUT) + (size_t)l * D * D + (size_t)k0 * D + n0; ld = D;
                dst = W + W_OUT / 2 + (size_t)n0 * D + k0; ldd = D;
            }

            dsts[u] = dst; ldds[u] = ldd; nz[u] = (src != nullptr);
            LAS float* tile = (LAS float*)c.lds + u * (64 * 65);
            if (src) {
                const int i = tid >> 4, j4 = tid & 15;
#pragma unroll
                for (int r = 0; r < 2; ++r) { const int k = i + 32 * r; const f32x4 v = *(const f32x4*)(src + (size_t)k * ld + 4 * j4);
                    tile[k * 65 + 4 * j4 + 0] = v[0]; tile[k * 65 + 4 * j4 + 1] = v[1]; tile[k * 65 + 4 * j4 + 2] = v[2]; tile[k * 65 + 4 * j4 + 3] = v[3]; }
            }
        }
        __syncthreads();
#pragma unroll
        for (int u = 0; u < 4; ++u) {
            const LAS float* tile = (const LAS float*)c.lds + u * (64 * 65);
            const int n = tid >> 3, kq = tid & 7; float f[8];
#pragma unroll
            for (int e = 0; e < 8; ++e) f[e] = nz[u] ? tile[(8 * kq + e) * 65 + n] : 0.f;
            *(u32x4*)(dsts[u] + (size_t)n * ldds[u] + 8 * kq) = pack8(f);
        }
        __syncthreads();
    }
    float* wif = (float*)(wsg(c) + W_IF);
    for (int i = c.bid * NTHREADS + c.tid; i < D * 8; i += c.G * NTHREADS) wif[i] = inp(c, I_WIN)[(size_t)l * D * INW + (size_t)(i >> 3) * INW + 5120 + (i & 7)];
}

__device__ __forceinline__ void phase_norm(const Ctx& c, const float* xin_p, const float* xin_s, float* X, int grow0, int nrows, const float* gamma, bf16_t* dst, const float* wif, float* gif) {
    const int lane = c.lane;
    f32x4 gm[4];
#pragma unroll
    for (int i = 0; i < 4; ++i) gm[i] = *(const f32x4*)(gamma + 256 * i + 4 * lane);
    for (int r = c.bid * 8 + c.wave; r < nrows; r += c.G * 8) {
        const int gr = grow0 + r;
        const float* src = xin_p ? (gr < NPROMPT ? xin_p + (size_t)gr * D : xin_s + (size_t)(gr - NPROMPT) * D) : X + (size_t)gr * D;
        f32x4 v[4]; float ss = 0.f;
#pragma unroll
        for (int i = 0; i < 4; ++i) { v[i] = *(const f32x4*)(src + 256 * i + 4 * lane); ss += v[i][0] * v[i][0] + v[i][1] * v[i][1] + v[i][2] * v[i][2] + v[i][3] * v[i][3]; }
        if (xin_p) {
#pragma unroll
            for (int i = 0; i < 4; ++i) *(f32x4*)(X + (size_t)gr * D + 256 * i + 4 * lane) = v[i];
        }
        ss = wsum(ss);
        const float rstd = __builtin_amdgcn_rsqf(ss * (1.0f / D) + 1e-6f);
#pragma unroll
        for (int i = 0; i < 4; ++i) {
            v[i] = v[i] * rstd * gm[i];
            u32x2 w; w.x = pk2(v[i][0], v[i][1]); w.y = pk2(v[i][2], v[i][3]);
            *(u32x2*)(dst + (size_t)r * D + 256 * i + 4 * lane) = w;
        }
        if (gif) {
            float a8[8];
#pragma unroll
            for (int j = 0; j < 8; ++j) a8[j] = 0.f;
#pragma unroll
            for (int i = 0; i < 4; ++i)
#pragma unroll
                for (int e = 0; e < 4; ++e) {
                    const float* wp = wif + (size_t)(256 * i + 4 * lane + e) * 8; const f32x4 w0 = *(const f32x4*)wp, w1 = *(const f32x4*)(wp + 4);
                    a8[0] += v[i][e] * w0[0]; a8[1] += v[i][e] * w0[1]; a8[2] += v[i][e] * w0[2]; a8[3] += v[i][e] * w0[3];
                    a8[4] += v[i][e] * w1[0]; a8[5] += v[i][e] * w1[1]; a8[6] += v[i][e] * w1[2]; a8[7] += v[i][e] * w1[3];
                }
#pragma unroll
            for (int j = 0; j < 8; ++j) a8[j] = wsum(a8[j]);
            if (lane == 0) {
#pragma unroll
                for (int j = 0; j < 8; ++j) gif[(size_t)r * 8 + j] = a8[j];
            }
        }
    }
}
__device__ __forceinline__ void phase_final_norm(const Ctx& c, float* X, const float* gamma) {
    const int lane = c.lane;
    f32x4 gm[4];
#pragma unroll
    for (int i = 0; i < 4; ++i) gm[i] = *(const f32x4*)(gamma + 256 * i + 4 * lane);
    for (int r = c.bid * 8 + c.wave; r < NTOK; r += c.G * 8) {
        f32x4 v[4]; float ss = 0.f;
#pragma unroll
        for (int i = 0; i < 4; ++i) { v[i] = *(const f32x4*)(X + (size_t)r * D + 256 * i + 4 * lane); ss += v[i][0] * v[i][0] + v[i][1] * v[i][1] + v[i][2] * v[i][2] + v[i][3] * v[i][3]; }
        ss = wsum(ss);
        const float rstd = __builtin_amdgcn_rsqf(ss * (1.0f / D) + 1e-6f);
#pragma unroll
        for (int i = 0; i < 4; ++i) *(f32x4*)(X + (size_t)r * D + 256 * i + 4 * lane) = v[i] * rstd * gm[i];
    }
}

__device__ __forceinline__ void phase_cv1(const Ctx& c, int p, int l) {
    const bf16_t* Z = (const bf16_t*)(wsg(c) + WS_Z); bf16_t* H = (bf16_t*)(wsg(c) + WS_HALO);
    const int nseg = pass_nseg(p), gt = c.bid * NTHREADS + c.tid, gs = c.G * NTHREADS;
    for (int i = gt; i < nseg * 3168; i += gs) {
        const int s = i / 3168, pc = i % 3168, r = pc / 1056, cc = pc % 1056; const Seg g = seg_of(s);
        *(u32x4*)(H + ((size_t)s * 3 + r) * ZW + 8 * cc) = *(const u32x4*)(Z + (size_t)(g.row0 + g.n - 3 + r) * ZW + 8 * cc);
    }
    const int nseq = pass_nseq(p);
    for (int i = gt; i < nseq * 12544; i += gs) {
        const int q = i / 12544, e = i % 12544; const Seq sq = seq_of(p, q);
        if (e < 9216) { const int r = e / 3072, ch = e % 3072;
            float* o = outg(c) + (sq.sample ? O_SCONV + ((size_t)l * DB + sq.b) * 9216 : O_PCONV + ((size_t)l * NB + sq.b) * 9216);
            o[e] = bf2f(Z[(size_t)(sq.row0 + sq.T - 3 + r) * ZW + ch]);
        } else { const int j = e - 9216;
            float* o = outg(c) + (sq.sample ? O_SSH + ((size_t)l * DB + sq.b) * RIN : O_PSH + ((size_t)l * NB + sq.b) * RIN);
            o[j] = bf2f(Z[(size_t)(sq.row0 + sq.T - 1) * ZW + C_R + j]);
        }
    }
}
__device__ __forceinline__ void phase_cv2(const Ctx& c, int p, int l) {
    bf16_t* Z = (bf16_t*)(wsg(c) + WS_Z); const bf16_t* H = (const bf16_t*)(wsg(c) + WS_HALO);
    const int nseg = pass_nseg(p), gt = c.bid * NTHREADS + c.tid, gs = c.G * NTHREADS;
    for (int i = gt; i < nseg * 800; i += gs) {
        const int s = i / 800, cgp = i % 800; const Seg g = seg_of(s); const Seq sq = seq_of(p, g.q);
        if (cgp < 384) {
            const int col = 8 * cgp;
            float p0[8], p1[8], p2[8], w0[8], w1[8], w2[8], w3[8], bb[8];
            const float* cw = inp(c, I_CONVW) + (size_t)l * 4 * CONVCH + col; const float* cb = inp(c, I_CONVB) + (size_t)l * CONVCH + col;
#pragma unroll
            for (int j = 0; j < 8; ++j) { w0[j] = cw[j]; w1[j] = cw[CONVCH + j]; w2[j] = cw[2 * CONVCH + j]; w3[j] = cw[3 * CONVCH + j]; bb[j] = cb[j]; }
            if (g.c > 0) { unpack8(*(const u32x4*)(H + ((size_t)(s - 1) * 3 + 0) * ZW + col), p0); unpack8(*(const u32x4*)(H + ((size_t)(s - 1) * 3 + 1) * ZW + col), p1); unpack8(*(const u32x4*)(H + ((size_t)(s - 1) * 3 + 2) * ZW + col), p2); }
            else if (sq.sample) { const float* st = inp(c, I_SCONV) + ((size_t)l * DB + sq.b) * 3 * CONVCH + col;
#pragma unroll
                for (int j = 0; j < 8; ++j) { p0[j] = st[j]; p1[j] = st[CONVCH + j]; p2[j] = st[2 * CONVCH + j]; } }
            else {
#pragma unroll
                for (int j = 0; j < 8; ++j) { p0[j] = 0.f; p1[j] = 0.f; p2[j] = 0.f; } }
            const int mode = col < 1024 ? 0 : (col < 2048 ? 1 : 2);
            for (int t4 = 0; t4 < g.n; t4 += 4) {
                u32x4 raw[4];
#pragma unroll
                for (int u = 0; u < 4; ++u) raw[u] = *(const u32x4*)(Z + (size_t)(g.row0 + t4 + u) * ZW + col);
#pragma unroll
                for (int u = 0; u < 4; ++u) {
                    bf16_t* zp = Z + (size_t)(g.row0 + t4 + u) * ZW + col; float x[8], y[8];
                    unpack8(raw[u], x);
#pragma unroll
                    for (int j = 0; j < 8; ++j) { float v = bb[j] + p0[j] * w0[j]; v += p1[j] * w1[j]; v += p2[j] * w2[j]; v += x[j] * w3[j];
                        if (mode == 1) v = siluf_(v); else if (mode == 2) v = siluf_(v) * 0.0625f;
                        y[j] = v; p0[j] = p1[j]; p1[j] = p2[j]; p2[j] = x[j]; }
                    *(u32x4*)zp = pack8(y);
                }
            }
        } else {
            const int j0 = 8 * (cgp - 384), col = C_R + j0;
            float pv[8], mu[8];
            const float* mp = inp(c, I_MU) + (size_t)l * RIN + j0;
#pragma unroll
            for (int j = 0; j < 8; ++j) mu[j] = mp[j];
            if (g.c > 0) unpack8(*(const u32x4*)(H + ((size_t)(s - 1) * 3 + 2) * ZW + col), pv);
            else if (sq.sample) { const float* st = inp(c, I_SSH) + ((size_t)l * DB + sq.b) * RIN + j0;
#pragma unroll
                for (int j = 0; j < 8; ++j) pv[j] = st[j]; }
            else {
#pragma unroll
                for (int j = 0; j < 8; ++j) pv[j] = 0.f; }
            const int mode = (j0 >= 3072 && j0 < 3136) ? 1 : (j0 >= 3200 ? 2 : 0);
            for (int t4 = 0; t4 < g.n; t4 += 4) {
                u32x4 raw[4];
#pragma unroll
                for (int u = 0; u < 4; ++u) raw[u] = *(const u32x4*)(Z + (size_t)(g.row0 + t4 + u) * ZW + col);
#pragma unroll
                for (int u = 0; u < 4; ++u) {
                    bf16_t* zp = Z + (size_t)(g.row0 + t4 + u) * ZW + col; float x[8], y[8];
                    unpack8(raw[u], x);
#pragma unroll
                    for (int j = 0; j < 8; ++j) { float v = x[j] + (pv[j] - x[j]) * mu[j];
                        if (mode == 1) v = tanhf_(v); else if (mode == 2) v = sigmoidf_(v);
                        y[j] = v; pv[j] = x[j]; }
                    *(u32x4*)zp = pack8(y);
                }
            }
        }
    }
}

template <int FINAL>
__device__ __forceinline__ void phase_lru(const Ctx& c, int p, int l) {
    bf16_t* Z = (bf16_t*)(wsg(c) + WS_Z); const bf16_t* T = (const bf16_t*)(wsg(c) + WS_T); float* car = (float*)(wsg(c) + WS_CAR);
    const int nseg = pass_nseg(p), gt = c.bid * NTHREADS + c.tid, gs = c.G * NTHREADS;
    for (int i = gt; i < nseg * 128; i += gs) {
        const int s = i >> 7, ch = 8 * (i & 127); const Seg g = seg_of(s); const Seq sq = seq_of(p, g.q);
        float ba[8], bx[8], c1[8], A[8], B[8];
#pragma unroll
        for (int j = 0; j < 8; ++j) { ba[j] = inp(c, I_LBA)[(size_t)l * D + ch + j]; bx[j] = inp(c, I_LBX)[(size_t)l * D + ch + j]; c1[j] = -8.0f * softplusf_(-inp(c, I_LLAM)[(size_t)l * D + ch + j]); A[j] = 1.f; B[j] = 0.f; }
        if (FINAL) {
            if (sq.sample) {
#pragma unroll
                for (int j = 0; j < 8; ++j) B[j] = inp(c, I_SLRU)[((size_t)l * DB + sq.b) * D + ch + j]; }
            for (int cp = 0; cp < g.c; ++cp) { const float* ca = car + (size_t)(s - g.c + cp) * 2048 + ch;
#pragma unroll
                for (int j = 0; j < 8; ++j) B[j] = ca[j] * B[j] + ca[1024 + j]; }
        }
        for (int t4 = 0; t4 < g.n; t4 += 4) {
          u32x4 rx[4], rr[4], ri[4];
#pragma unroll
          for (int u = 0; u < 4; ++u) { const size_t row = (size_t)(g.row0 + t4 + u); rx[u] = *(const u32x4*)(Z + row * ZW + C_LRU + ch); rr[u] = *(const u32x4*)(T + row * 2048 + ch); ri[u] = *(const u32x4*)(T + row * 2048 + 1024 + ch); }
#pragma unroll
          for (int u = 0; u < 4; ++u) {
            const size_t row = (size_t)(g.row0 + t4 + u); float x[8], rp[8], ip[8];
            unpack8(rx[u], x); unpack8(rr[u], rp); unpack8(ri[u], ip);
#pragma unroll
            for (int j = 0; j < 8; ++j) { const float la = c1[j] * sigmoidf_(rp[j] + ba[j]), a = __expf(la), bt = __builtin_amdgcn_sqrtf(fmaxf(1.0f - __expf(2.0f * la), 0.f)) * sigmoidf_(ip[j] + bx[j]) * x[j];
                B[j] = a * B[j] + bt; A[j] *= a; x[j] = B[j]; }
            if (FINAL) *(u32x4*)(Z + row * ZW + C_LRU + ch) = pack8(x);
          }
        }
        if (!FINAL) { float* ca = car + (size_t)s * 2048 + ch;
#pragma unroll
            for (int j = 0; j < 8; ++j) { ca[j] = A[j]; ca[1024 + j] = B[j]; } }
        else if (g.c == g.nch - 1) { float* o = outg(c) + (sq.sample ? O_SLRU + ((size_t)l * DB + sq.b) * D : O_PLRU + ((size_t)l * NB + sq.b) * D) + ch;
#pragma unroll
            for (int j = 0; j < 8; ++j) o[j] = B[j]; }
    }
}

__device__ __forceinline__ f32x4 mma_tile(const LAS bf16_t* A, int lda, const LAS bf16_t* Bt, int ldb, int K, f32x4 acc, int lane) {
    const LAS bf16_t* pa = A + (lane & 15) * lda + (lane >> 4) * 8; const LAS bf16_t* pb = Bt + (lane & 15) * ldb + (lane >> 4) * 8;
    for (int k = 0; k < K; k += 32) { const bf16x8 a = *(const LAS bf16x8*)(pa + k); const bf16x8 b = *(const LAS bf16x8*)(pb + k); acc = __builtin_amdgcn_mfma_f32_16x16x32_bf16(a, b, acc, 0, 0, 0); }
    return acc;
}

__device__ __forceinline__ void phase_mlstm_s(const Ctx& c, int p, int l) {
    const bf16_t* Z = (const bf16_t*)(wsg(c) + WS_Z); const float* gif = (const float*)(wsg(c) + WS_GIF); bf16_t* SL = (bf16_t*)(wsg(c) + WS_SL);
    int tid = c.tid, lane = c.lane; const int w = c.wave;
    const int nitems = p ? 1088 : 1024;
    for (int item = c.bid; item < nitems; item += c.G) {
        asm volatile("" : "+v"(tid), "+v"(lane));
        LAS unsigned char* L = c.lds; asm volatile("" : "+v"(L));
        LAS bf16_t* Qs = (LAS bf16_t*)(L); LAS bf16_t* Ks = (LAS bf16_t*)(L + 33792); LAS bf16_t* St = (LAS bf16_t*)(L + 67584);
        LAS float* bcum = (LAS float*)(L + 76800); LAS float* igs = bcum + 64; LAS float* mloc = bcum + 128;
        int q, h, rbase, nvalid;
        if (item < 1024) { q = item >> 9; h = (item >> 7) & 3; rbase = q * SEQ + (item & 127) * 64; nvalid = 64; }
        else { const int sid = item - 1024; q = 2 + (sid >> 2); h = sid & 3; rbase = 16384 + (sid >> 2) * DSEQ; nvalid = DSEQ; }
        const float bi = inp(c, I_IFB)[l * 8 + h], bf = inp(c, I_IFB)[l * 8 + 4 + h];
#pragma unroll
        for (int i = 0; i < 4; ++i) {
            const int piece = tid + 512 * i, t = piece >> 5, pc = piece & 31; u32x4 qv = {0u, 0u, 0u, 0u}, kv = {0u, 0u, 0u, 0u};
            if (t < nvalid) { qv = *(const u32x4*)(Z + (size_t)(rbase + t) * ZW + C_Q + 256 * h + 8 * pc); kv = *(const u32x4*)(Z + (size_t)(rbase + t) * ZW + C_K + 256 * h + 8 * pc); }
            *(LAS u32x4*)(Qs + t * 264 + 8 * pc) = qv; *(LAS u32x4*)(Ks + t * 264 + 8 * pc) = kv;
        }
        if (w == 0) {
            const int t = lane; float ig = -1e30f, lf = 0.f;
            if (t < nvalid) { ig = gif[(size_t)(rbase + t) * 8 + h] + bi; const float gf = gif[(size_t)(rbase + t) * 8 + 4 + h] + bf; lf = fminf(gf, 0.f) - __logf(1.0f + __expf(-fabsf(gf))); }
            float bc = lf;
#pragma unroll
            for (int o = 1; o < 64; o <<= 1) { const float u = __shfl_up(bc, o); if (lane >= o) bc += u; }
            float cm = ig - bc;
#pragma unroll
            for (int o = 1; o < 64; o <<= 1) { const float u = __shfl_up(cm, o); if (lane >= o) cm = fmaxf(cm, u); }
            bcum[t] = bc; igs[t] = ig; mloc[t] = bc + cm;
        }
        __syncthreads();
        const int ti = w >> 1;
#pragma unroll
        for (int e = 0; e < 2; ++e) {
            const int sj = (w & 1) * 2 + e;
            f32x4 a = {0.f, 0.f, 0.f, 0.f};
            a = mma_tile(Qs + 16 * ti * 264, 264, Ks + 16 * sj * 264, 264, 256, a, lane);
#pragma unroll
            for (int r = 0; r < 4; ++r) {
                const int t = 16 * ti + (lane >> 4) * 4 + r, s2 = 16 * sj + (lane & 15);
                const float wg = (s2 <= t && t < nvalid) ? __expf(bcum[t] - bcum[s2] + igs[s2] - mloc[t]) : 0.f;
                St[t * 72 + s2] = f2bf(a[r] * wg);
            }
        }
        __syncthreads();
        { const int row = tid >> 3, pc = tid & 7; *(u32x4*)(SL + (size_t)item * 4096 + row * 64 + 8 * pc) = *(const LAS u32x4*)(St + row * 72 + 8 * pc); }
        __syncthreads();
    }
}

__device__ __forceinline__ void mlstm_task(const Ctx& c, int p, int l, int q, int h, int slab) {
    bf16_t* Z = (bf16_t*)(wsg(c) + WS_Z); const float* gif = (const float*)(wsg(c) + WS_GIF);
    const bf16_t* SLp = (const bf16_t*)(wsg(c) + WS_SL) + (size_t)(q < 2 ? q * 512 + h * 128 : 1024 + (q - 2) * 4 + h) * 4096 + (c.tid >> 3) * 64 + 8 * (c.tid & 7);
    const Seq sq = seq_of(p, q); const int tid = c.tid, lane = c.lane, w = c.wave;
    LAS bf16_t* Qs = (LAS bf16_t*)(c.lds); LAS bf16_t* Ks = (LAS bf16_t*)(c.lds + 33792); LAS bf16_t* KT = (LAS bf16_t*)(c.lds + 67584); LAS bf16_t* VT = (LAS bf16_t*)(c.lds + 104448);
    LAS bf16_t* VgT = (LAS bf16_t*)(c.lds + 109200); LAS bf16_t* Cs = (LAS bf16_t*)(c.lds + 113952); LAS bf16_t* St = (LAS bf16_t*)(c.lds + 131376);
    LAS float* sc = (LAS float*)(c.lds + 140592);
    LAS float* bcum = sc; LAS float* igs = sc + 64; LAS float* mts = sc + 128; LAS float* wint = sc + 192; LAS float* gsrc = sc + 256; LAS float* dd = sc + 320; LAS float* misc = sc + 384; LAS float* esc = sc + 392;
    const int nvalid = sq.sample ? DSEQ : 64, nch = sq.sample ? 1 : SEQ / 64;
    const float bi = inp(c, I_IFB)[l * 8 + h], bf = inp(c, I_IFB)[l * 8 + 4 + h];
    f32x4 cacc[3][2];
#pragma unroll
    for (int vi = 0; vi < 3; ++vi)
#pragma unroll
        for (int e = 0; e < 2; ++e)
#pragma unroll
            for (int r = 0; r < 4; ++r) {
                const int vloc = 16 * vi + (lane >> 4) * 4 + r, d = 16 * (2 * w + e) + (lane & 15); float v0 = 0.f;
                if (sq.sample) { if (vloc < 32) v0 = inp(c, I_SMC)[(((size_t)l * DB + sq.b) * 4 + h) * 65536 + (size_t)(slab * 32 + vloc) * 256 + d];
                                 else if (vloc == 32) v0 = inp(c, I_SMN)[(((size_t)l * DB + sq.b) * 4 + h) * 256 + d]; }
                cacc[vi][e][r] = v0;
            }
    if (tid < 64) VT[32 * 72 + tid] = (bf16_t)0x3f80u;
    if (tid == 0) misc[0] = sq.sample ? inp(c, I_SMM)[((size_t)l * DB + sq.b) * 4 + h] : 0.f;
    unsigned zz = 0u; asm volatile("" : "+v"(zz)); const u32x4 zv = {zz, zz, zz, zz};
    u32x4 pq[4], pk[4], pvv = zv, psl = zv; float pgi = 0.f, pgf = 0.f; int pfc = 0;
#define ML_PREFETCH(RB) do { psl = *(const u32x4*)(SLp + (size_t)pfc * 4096); ++pfc; \
        _Pragma("unroll") for (int i = 0; i < 4; ++i) { const int piece = tid + 512 * i, t = piece >> 5, pc = piece & 31; pq[i] = zv; pk[i] = zv; \
            if (t < nvalid) { pq[i] = *(const u32x4*)(Z + (size_t)((RB) + t) * ZW + C_Q + 256 * h + 8 * pc); pk[i] = *(const u32x4*)(Z + (size_t)((RB) + t) * ZW + C_K + 256 * h + 8 * pc); } } \
        if (tid < 256) { const int t = tid >> 2, pc = tid & 3; pvv = zv; if (t < nvalid) pvv = *(const u32x4*)(Z + (size_t)((RB) + t) * ZW + C_V + 256 * h + slab * 32 + 8 * pc); } \
        if (w == 0 && lane < nvalid) { pgi = gif[(size_t)((RB) + lane) * 8 + h]; pgf = gif[(size_t)((RB) + lane) * 8 + 4 + h]; } } while (0)
    ML_PREFETCH(sq.row0);
    __syncthreads();
    for (int ck = 0; ck < nch; ++ck) {
        const int rbase = sq.row0 + ck * 64;
#pragma unroll
        for (int i = 0; i < 4; ++i) {
            const int piece = tid + 512 * i, t = piece >> 5, pc = piece & 31;
            *(LAS u32x4*)(Qs + t * 264 + 8 * pc) = pq[i]; *(LAS u32x4*)(Ks + t * 264 + 8 * pc) = pk[i];
        }
        *(LAS u32x4*)(St + (tid >> 3) * 72 + 8 * (tid & 7)) = psl;
        if (tid < 256) {
            const int t = tid >> 2, pc = tid & 3; const u32x4 vv = pvv;
            const unsigned vw[4] = {vv.x, vv.y, vv.z, vv.w};
#pragma unroll
            for (int e = 0; e < 4; ++e) { VT[(8 * pc + 2 * e) * 72 + t] = (bf16_t)(vw[e] & 0xffffu); VT[(8 * pc + 2 * e + 1) * 72 + t] = (bf16_t)(vw[e] >> 16); }
        }
        if (w == 0) {
            const int t = lane; float ig = -1e30f, lf = 0.f;
            if (t < nvalid) { ig = pgi + bi; const float gf = pgf + bf; lf = fminf(gf, 0.f) - __logf(1.0f + __expf(-fabsf(gf))); }
            float bc = lf;
#pragma unroll
            for (int o = 1; o < 64; o <<= 1) { const float u = __shfl_up(bc, o); if (lane >= o) bc += u; }
            float cm = ig - bc;
#pragma unroll
            for (int o = 1; o < 64; o <<= 1) { const float u = __shfl_up(cm, o); if (lane >= o) cm = fmaxf(cm, u); }
            const float mprev = misc[0];
            const float mt = bc + fmaxf(mprev, cm);
            const float wi = __expf(bc + mprev - mt);
            const float bL = __shfl(bc, 63), mnew = __shfl(mt, 63);
            const float gs_ = __expf(bL - bc + ig - mnew);
            mts[t] = mt; wint[t] = wi; gsrc[t] = gs_; VgT[32 * 72 + t] = f2bf(gs_); esc[t] = __expf(cm - fmaxf(mprev, cm));
            if (lane == 0) { misc[1] = __expf(bL + mprev - mnew); misc[2] = mnew; }
        }
#pragma unroll
        for (int vi = 0; vi < 3; ++vi)
#pragma unroll
            for (int e = 0; e < 2; ++e)
#pragma unroll
                for (int r = 0; r < 4; ++r) { const int vloc = 16 * vi + (lane >> 4) * 4 + r; if (vloc <= 32) Cs[vloc * 264 + 16 * (2 * w + e) + (lane & 15)] = f2bf(cacc[vi][e][r]); }
        __syncthreads();
        if (ck + 1 < nch) ML_PREFETCH(rbase + 64);
#pragma unroll
        for (int i = 0; i < 2; ++i) {
            const int idx = tid + 512 * i, dp = idx & 127, so = idx >> 7; unsigned wv[8];
#pragma unroll
            for (int e = 0; e < 8; ++e) wv[e] = *(const LAS unsigned*)(Ks + (8 * so + e) * 264 + 2 * dp);
            u32x4 lo, hi;
            lo.x = (wv[0] & 0xffffu) | (wv[1] << 16); lo.y = (wv[2] & 0xffffu) | (wv[3] << 16); lo.z = (wv[4] & 0xffffu) | (wv[5] << 16); lo.w = (wv[6] & 0xffffu) | (wv[7] << 16);
            hi.x = (wv[0] >> 16) | (wv[1] & 0xffff0000u); hi.y = (wv[2] >> 16) | (wv[3] & 0xffff0000u); hi.z = (wv[4] >> 16) | (wv[5] & 0xffff0000u); hi.w = (wv[6] >> 16) | (wv[7] & 0xffff0000u);
            *(LAS u32x4*)(KT + (2 * dp) * 72 + 8 * so) = lo; *(LAS u32x4*)(KT + (2 * dp + 1) * 72 + 8 * so) = hi;
        }
#pragma unroll
        for (int i = 0; i < 4; ++i) { const int idx = tid + 512 * i, v = idx >> 6, s2 = idx & 63; VgT[v * 72 + s2] = f2bf(bf2f(VT[v * 72 + s2]) * gsrc[s2]); }
        const int ti = w >> 1;
        const int vj = w & 1;
        f32x4 qc = {0.f, 0.f, 0.f, 0.f}, qc2 = {0.f, 0.f, 0.f, 0.f};
        qc = mma_tile(Qs + 16 * ti * 264, 264, Cs + 16 * vj * 264, 264, 256, qc, lane);
        if (w < 4) qc2 = mma_tile(Qs + 16 * w * 264, 264, Cs + 32 * 264, 264, 256, qc2, lane);
        __syncthreads();
        f32x4 num = {0.f, 0.f, 0.f, 0.f};
        num = mma_tile(St + 16 * ti * 72, 72, VT + 16 * vj * 72, 72, 64, num, lane);
#pragma unroll
        for (int r = 0; r < 4; ++r) { const int t = 16 * ti + (lane >> 4) * 4 + r; num[r] = qc[r] * wint[t] + esc[t] * num[r]; }
        if (w < 4) {
            f32x4 sv2 = {0.f, 0.f, 0.f, 0.f};
            sv2 = mma_tile(St + 16 * w * 72, 72, VT + 32 * 72, 72, 64, sv2, lane);
#pragma unroll
            for (int r = 0; r < 4; ++r) { const int t = 16 * w + (lane >> 4) * 4 + r; qc2[r] = qc2[r] * wint[t] + esc[t] * sv2[r]; }
            if ((lane & 15) == 0) {
#pragma unroll
                for (int r = 0; r < 4; ++r) { const int t = 16 * w + (lane >> 4) * 4 + r; dd[t] = fmaxf(fabsf(qc2[r]), __expf(-mts[t])); }
            }
        }
        __syncthreads();
#pragma unroll
        for (int r = 0; r < 4; ++r) {
            const int t = 16 * ti + (lane >> 4) * 4 + r;
            if (t < nvalid) Z[(size_t)(rbase + t) * ZW + C_V + 256 * h + slab * 32 + 16 * vj + (lane & 15)] = f2bf(num[r] * __builtin_amdgcn_rcpf(dd[t]));
        }
        const float gs = misc[1];
#pragma unroll
        for (int vi = 0; vi < 3; ++vi)
#pragma unroll
            for (int e = 0; e < 2; ++e) { cacc[vi][e] = cacc[vi][e] * gs; cacc[vi][e] = mma_tile(VgT + 16 * vi * 72, 72, KT + 16 * (2 * w + e) * 72, 72, 64, cacc[vi][e], lane); }
        if (tid == 0) misc[0] = misc[2];
        __syncthreads();
    }
#undef ML_PREFETCH
    float* oc = outg(c) + (sq.sample ? O_SMC + (((size_t)l * DB + sq.b) * 4 + h) * 65536 : O_PMC + (((size_t)l * NB + sq.b) * 4 + h) * 65536);
#pragma unroll
    for (int vi = 0; vi < 2; ++vi)
#pragma unroll
        for (int e = 0; e < 2; ++e)
#pragma unroll
            for (int r = 0; r < 4; ++r) oc[(size_t)(slab * 32 + 16 * vi + (lane >> 4) * 4 + r) * 256 + 16 * (2 * w + e) + (lane & 15)] = cacc[vi][e][r];
    if (slab == 0) {
        if (lane < 16) {
            float* on = outg(c) + (sq.sample ? O_SMN + (((size_t)l * DB + sq.b) * 4 + h) * 256 : O_PMN + (((size_t)l * NB + sq.b) * 4 + h) * 256);
#pragma unroll
            for (int e = 0; e < 2; ++e) on[16 * (2 * w + e) + lane] = cacc[2][e][0];
        }
        if (tid == 0) outg(c)[(sq.sample ? O_SMM + ((size_t)l * DB + sq.b) * 4 + h : O_PMM + ((size_t)l * NB + sq.b) * 4 + h)] = misc[0];
    }
    __syncthreads();
}

constexpr int RS = 72;
__device__ __forceinline__ void rwkv_apply_tiles(int w, int lane, const LAS bf16_t* S0b, const LAS bf16_t* GTs, const LAS bf16_t* QTs, const LAS bf16_t* Hs, const LAS bf16_t* YHTs, LAS float* yT, f32x4 (&sacc)[4]) {
    if (w < 4) {
#pragma unroll
        for (int b = 0; b < 4; ++b) {
            f32x4 a = {0.f, 0.f, 0.f, 0.f};
            a = mma_tile(S0b + 16 * w * RS, RS, GTs + 16 * b * RS, RS, 64, a, lane);
#pragma unroll
            for (int r = 0; r < 4; ++r) a[r] += bf2f(Hs[(16 * w + (lane >> 4) * 4 + r) * RS + 16 * b + (lane & 15)]);
            sacc[b] = a;
        }
    } else {
        const int wi = w - 4;
#pragma unroll
        for (int b = 0; b < 4; ++b) {
            f32x4 a = {0.f, 0.f, 0.f, 0.f};
            a = mma_tile(S0b + 16 * wi * RS, RS, QTs + 16 * b * RS, RS, 64, a, lane);
            const int t = 16 * b + (lane & 15), i0 = 16 * wi + (lane >> 4) * 4;
            const u32x2 yh = *(const LAS u32x2*)(YHTs + t * RS + i0);
            yT[t * 65 + i0 + 0] = a[0] + bflo(yh.x); yT[t * 65 + i0 + 1] = a[1] + bfhi(yh.x); yT[t * 65 + i0 + 2] = a[2] + bflo(yh.y); yT[t * 65 + i0 + 3] = a[3] + bfhi(yh.y);
        }
    }
}
__device__ __forceinline__ void rwkv_post(int tid, const LAS float* yT, const LAS bf16_t* vblk, const LAS bf16_t* gblk, const LAS float* bon, const float (&lnw)[8], const float (&lnb)[8], bf16_t* zr, int nvalid) {
    const int t = tid >> 3, i0 = 8 * (tid & 7);
    float y[8], s = 0.f;
#pragma unroll
    for (int e = 0; e < 8; ++e) { y[e] = yT[t * 65 + i0 + e]; s += y[e]; }
    s += __shfl_xor(s, 1); s += __shfl_xor(s, 2); s += __shfl_xor(s, 4);
    const float mean = s * (1.0f / 64.0f); float qv = 0.f;
#pragma unroll
    for (int e = 0; e < 8; ++e) { y[e] -= mean; qv += y[e] * y[e]; }
    qv += __shfl_xor(qv, 1); qv += __shfl_xor(qv, 2); qv += __shfl_xor(qv, 4);
    const float rstd = __builtin_amdgcn_rsqf(qv * (1.0f / 64.0f) + 64e-5f), bo = bon[t];
    float vf[8], gf[8], o[8];
    unpack8(*(const LAS u32x4*)(vblk + t * RS + i0), vf); unpack8(*(const LAS u32x4*)(gblk + t * RS + i0), gf);
#pragma unroll
    for (int e = 0; e < 8; ++e) o[e] = (y[e] * rstd * lnw[e] + lnb[e] + bo * vf[e]) * gf[e];
    if (t < nvalid) *(u32x4*)(zr + (size_t)t * ZW + i0) = pack8(o);
}

constexpr int RA_At = 0, RA_Rt = 9216, RA_Bt = 18432, RA_Kt = 27648, RA_AtT = 36864, RA_BtT = 46080, RA_KtT = 55296, RA_VT = 64512, RA_Nf = 73728, RA_MinvT = 92160, RA_AakT = 101376,
              RA_AbrT = 110592, RA_AkrT = 119808, RA_WL = 129024, RA_SEG = 129280, RA_BON = 131328, RA_GB = 131584, RA_VB = 133888  ;
__device__ __forceinline__ void phase_rwkv_ra(const Ctx& c, int p, int l) {
    bf16_t* Z = (bf16_t*)(wsg(c) + WS_Z); bf16_t* T = (bf16_t*)(wsg(c) + WS_T); float* bonus_g = (float*)(wsg(c) + WS_BONUS);
    int tid = c.tid, lane = c.lane; const int w = c.wave;
#define LAUNDER2() asm volatile("" : "+v"(tid), "+v"(lane))
    const int nitems = p ? 4352 : 4096;
    u32x4 nx0, nx1, nx2, nx3, nx4; int have_pf = 0;
#define RA_PREFETCH(IT) do { have_pf = 0; if ((IT) < 4096 && (IT) < nitems && (IT) >= 0) { const int q_ = (IT) >> 11, rem_ = (IT) & 2047, h_ = rem_ & 15; \
        const size_t row_ = (size_t)(q_ * SEQ + (rem_ >> 4) * 64 + (tid >> 3)); const int col_ = 64 * h_ + 8 * (tid & 7); \
        nx0 = *(const u32x4*)(Z + row_ * ZW + C_R + col_); nx1 = *(const u32x4*)(Z + row_ * ZW + C_RK + col_); nx2 = *(const u32x4*)(Z + row_ * ZW + C_RV + col_); \
        nx3 = *(const u32x4*)(T + row_ * 3072 + col_); nx4 = *(const u32x4*)(T + row_ * 3072 + 1024 + col_); have_pf = 1; } } while (0)
    RA_PREFETCH(c.bid - 64);
    for (int item = c.bid - 64; item < nitems; item += c.G - 64) {
        LAUNDER2();
        LAS unsigned char* L = c.lds; asm volatile("" : "+v"(L));
    LAS bf16_t* At = (LAS bf16_t*)(L + RA_At); LAS bf16_t* Rt = (LAS bf16_t*)(L + RA_Rt); LAS bf16_t* Bt_ = (LAS bf16_t*)(L + RA_Bt); LAS bf16_t* Kt = (LAS bf16_t*)(L + RA_Kt);
    LAS bf16_t* AtT = (LAS bf16_t*)(L + RA_AtT); LAS bf16_t* BtT = (LAS bf16_t*)(L + RA_BtT); LAS bf16_t* KtT = (LAS bf16_t*)(L + RA_KtT); LAS bf16_t* VT = (LAS bf16_t*)(L + RA_VT);
    LAS float* cumb = (LAS float*)(L + RA_Nf); LAS float* NfT = (LAS float*)(L + RA_Nf);
    LAS bf16_t* MinvT = (LAS bf16_t*)(L + RA_MinvT); LAS bf16_t* AakT = (LAS bf16_t*)(L + RA_AakT); LAS bf16_t* AbrT = (LAS bf16_t*)(L + RA_AbrT); LAS bf16_t* AkrT = (LAS bf16_t*)(L + RA_AkrT);
    LAS bf16_t* XHm = At; LAS bf16_t* UGm = Kt; LAS bf16_t* UHm = Bt_;
    LAS bf16_t* GT = (LAS bf16_t*)(L + RA_Nf); LAS bf16_t* QT = (LAS bf16_t*)(L + RA_Nf + 9216); LAS bf16_t* Hm = MinvT; LAS bf16_t* YHT = AakT;
    LAS float* WL = (LAS float*)(L + RA_WL); LAS float* seg = (LAS float*)(L + RA_SEG); LAS float* bon = (LAS float*)(L + RA_BON); LAS bf16_t* gblk = (LAS bf16_t*)(L + RA_GB); LAS bf16_t* vblk = (LAS bf16_t*)(L + RA_VB);
        int h, rbase, nvalid, sample, sb = 0;
        if (item < 4096) { const int q = item >> 11, rem = item & 2047; h = rem & 15; rbase = q * SEQ + (rem >> 4) * 64; nvalid = 64; sample = 0; }
        else { const int sid = item - 4096; sb = sid >> 4; h = sid & 15; rbase = 16384 + sb * DSEQ; nvalid = DSEQ; sample = 1; }
        const int t = tid >> 3, jp = tid & 7, j0 = 8 * jp, col = 64 * h + j0; const bool valid = t < nvalid;
        float rf[8], kf[8], vf[8], wpf[8], apf[8], lw[8], av[8], bv[8], kp[8];
        u32x4 vraw = {0u, 0u, 0u, 0u};
        if (have_pf) { unpack8(nx0, rf); unpack8(nx1, kf); vraw = nx2; unpack8(nx3, wpf); unpack8(nx4, apf); }
        else if (valid) {
            const size_t row = (size_t)(rbase + t);
            unpack8(*(const u32x4*)(Z + row * ZW + C_R + col), rf); unpack8(*(const u32x4*)(Z + row * ZW + C_RK + col), kf); vraw = *(const u32x4*)(Z + row * ZW + C_RV + col);
            unpack8(*(const u32x4*)(T + row * 3072 + col), wpf); unpack8(*(const u32x4*)(T + row * 3072 + 1024 + col), apf);
            if (sample) { *(LAS u32x4*)(gblk + t * RS + j0) = *(const u32x4*)(T + row * 3072 + 2048 + col); *(LAS u32x4*)(vblk + t * RS + j0) = vraw; }
        }
        unpack8(vraw, vf);
        {
            const float* pw0 = inp(c, I_W0) + (size_t)l * D + col; const float* pa0 = inp(c, I_A0) + (size_t)l * D + col; const float* pkk = inp(c, I_KK) + (size_t)l * D + col;
            const float* pka = inp(c, I_KA) + (size_t)l * D + col; const float* prk = inp(c, I_RK) + (size_t)l * D + col;
            float ssq = 0.f, bsum = 0.f;
#pragma unroll
            for (int e = 0; e < 8; ++e) {
                if (valid) {
                    const float wlog = -softplusf_(-(pw0[e] + wpf[e])) - 0.5f; lw[e] = -__expf(wlog);
                    const float a = sigmoidf_(pa0[e] + apf[e]); const float kk = kf[e] * pkk[e]; ssq += kk * kk;
                    kp[e] = kf[e] * (1.0f + (a - 1.0f) * pka[e]); bsum += rf[e] * kp[e] * prk[e]; av[e] = kk; bv[e] = a;
                } else { lw[e] = 0.f; rf[e] = 0.f; kp[e] = 0.f; av[e] = 0.f; bv[e] = 0.f; }
            }
            ssq += __shfl_xor(ssq, 1); ssq += __shfl_xor(ssq, 2); ssq += __shfl_xor(ssq, 4);
            bsum += __shfl_xor(bsum, 1); bsum += __shfl_xor(bsum, 2); bsum += __shfl_xor(bsum, 4);
            const float inv = __builtin_amdgcn_rsqf(fmaxf(ssq, 1e-24f));
#pragma unroll
            for (int e = 0; e < 8; ++e) { const float kk = av[e] * inv; av[e] = -kk; bv[e] = kk * bv[e]; }
            if (jp == 0) { bon[t] = bsum; if (!sample) bonus_g[(size_t)(rbase + t) * 16 + h] = bsum; }
        }
#pragma unroll
        for (int e = 0; e < 8; ++e) cumb[t * 64 + j0 + e] = lw[e];
        __syncthreads();
        {
            const int j = tid & 63, sg = tid >> 6; float cs[8], run = 0.f;
#pragma unroll
            for (int e = 0; e < 8; ++e) { run += cumb[(8 * sg + e) * 64 + j]; cs[e] = run; }
            seg[sg * 64 + j] = run;
            __syncthreads();
            float off = 0.f;
#pragma unroll
            for (int s2 = 0; s2 < 8; ++s2) if (s2 < sg) off += seg[s2 * 64 + j];
#pragma unroll
            for (int e = 0; e < 8; ++e) cumb[(8 * sg + e) * 64 + j] = cs[e] + off;
        }
        __syncthreads();
        {
            float cu[8], cp[8], a8[8], r8[8], b8[8], k8[8];
#pragma unroll
            for (int e = 0; e < 8; ++e) { cu[e] = cumb[t * 64 + j0 + e]; cp[e] = t > 0 ? cumb[(t - 1) * 64 + j0 + e] : 0.f; }
#pragma unroll
            for (int e = 0; e < 8; ++e) { const float E = __expf(cu[e]), Em = __expf(-cu[e]), Ep = __expf(cp[e]);
                a8[e] = av[e] * Ep; r8[e] = rf[e] * E; b8[e] = bv[e] * Em; k8[e] = kp[e] * Em; if (t == 63) WL[j0 + e] = E; }
            const u32x4 aw = pack8(a8), rw = pack8(r8), bw = pack8(b8), kw = pack8(k8);
            *(LAS u32x4*)(At + t * RS + j0) = aw; *(LAS u32x4*)(Rt + t * RS + j0) = rw; *(LAS u32x4*)(Bt_ + t * RS + j0) = bw; *(LAS u32x4*)(Kt + t * RS + j0) = kw;
            *(LAS u32x4*)(MinvT + t * RS + j0) = vraw;
        }
        __syncthreads();
        LAUNDER2();
        {
            const int dp = tid & 31, so = (tid >> 5) & 7, which = tid >> 8;
#pragma unroll
            for (int a2 = 0; a2 < 2; ++a2) {
                const int arr = which + 2 * a2;
                const LAS bf16_t* src = arr == 0 ? At : (arr == 1 ? Bt_ : (arr == 2 ? Kt : MinvT));
                LAS bf16_t* dst = arr == 0 ? AtT : (arr == 1 ? BtT : (arr == 2 ? KtT : VT));
                unsigned wv[8];
#pragma unroll
                for (int e = 0; e < 8; ++e) wv[e] = *(const LAS unsigned*)(src + (8 * so + e) * RS + 2 * dp);
                u32x4 lo, hi;
                lo.x = (wv[0] & 0xffffu) | (wv[1] << 16); lo.y = (wv[2] & 0xffffu) | (wv[3] << 16); lo.z = (wv[4] & 0xffffu) | (wv[5] << 16); lo.w = (wv[6] & 0xffffu) | (wv[7] << 16);
                hi.x = (wv[0] >> 16) | (wv[1] & 0xffff0000u); hi.y = (wv[2] >> 16) | (wv[3] & 0xffff0000u); hi.z = (wv[4] >> 16) | (wv[5] & 0xffff0000u); hi.w = (wv[6] >> 16) | (wv[7] & 0xffff0000u);
                *(LAS u32x4*)(dst + (2 * dp) * RS + 8 * so) = lo; *(LAS u32x4*)(dst + (2 * dp + 1) * RS + 8 * so) = hi;
            }
        }
        {
            const int rt = w; const LAS bf16_t* Arow = (rt < 4 ? Bt_ + 16 * rt * RS : Kt + 16 * (rt - 4) * RS);
            f32x4 res[8];
#pragma unroll
            for (int ct = 0; ct < 8; ++ct) { f32x4 a = {0.f, 0.f, 0.f, 0.f}; res[ct] = mma_tile(Arow, RS, (ct < 4 ? At + 16 * ct * RS : Rt + 16 * (ct - 4) * RS), RS, 64, a, lane); }
#pragma unroll
            for (int ct = 0; ct < 8; ++ct) {
                const int s0 = 16 * (rt & 3) + (lane >> 4) * 4, tt = 16 * (ct & 3) + (lane & 15);
                f32x4 a = res[ct];
                if (ct < 4) {
#pragma unroll
                    for (int r = 0; r < 4; ++r) a[r] = (s0 + r < tt) ? a[r] : 0.f;
                    if (rt < 4) *(LAS f32x4*)(NfT + tt * 68 + s0) = a;
                    else { u32x2 wv; wv.x = pk2(a[0], a[1]); wv.y = pk2(a[2], a[3]); *(LAS u32x2*)(AakT + tt * RS + s0) = wv; }
                } else {
#pragma unroll
                    for (int r = 0; r < 4; ++r) a[r] = (s0 + r <= tt) ? a[r] : 0.f;
                    u32x2 wv; wv.x = pk2(a[0], a[1]); wv.y = pk2(a[2], a[3]);
                    if (rt < 4) *(LAS u32x2*)(AbrT + tt * RS + s0) = wv; else *(LAS u32x2*)(AkrT + tt * RS + s0) = wv;
                }
            }
        }
        __syncthreads();
        LAUNDER2();
        if (w == 0) {
            float M[64];
#pragma unroll
            for (int tt = 0; tt < 64; ++tt) {
                float a4[4] = {(lane == tt) ? 1.f : 0.f, 0.f, 0.f, 0.f};
#pragma unroll
                for (int p4 = 0; p4 < (tt + 3) / 4; ++p4) {
                    const f32x4 nv = *(const LAS f32x4*)(NfT + tt * 68 + 4 * p4);
#pragma unroll
                    for (int e = 0; e < 4; ++e) if (4 * p4 + e < tt) a4[e] += M[4 * p4 + e] * nv[e];
                }
                const float a = (a4[0] + a4[1]) + (a4[2] + a4[3]);
                M[tt] = a;
                MinvT[tt * RS + lane] = f2bf(a);
            }
        } else {
            for (int tl = w - 1; tl < 16; tl += 7) {
                const int ti = tl >> 2, tp = tl & 3; f32x4 a = {0.f, 0.f, 0.f, 0.f};
                a = mma_tile(VT + 16 * ti * RS, RS, AakT + 16 * tp * RS, RS, 64, a, lane);
#pragma unroll
                for (int r = 0; r < 4; ++r) XHm[(16 * ti + (lane >> 4) * 4 + r) * RS + 16 * tp + (lane & 15)] = f2bf(a[r]);
            }
        }
        __syncthreads();
        LAUNDER2();
#pragma unroll
        for (int k = 0; k < 4; ++k) {
            const int id = 4 * w + k, rtile = id >> 2, tt4 = id & 3; f32x4 a = {0.f, 0.f, 0.f, 0.f};
            a = mma_tile((rtile < 4 ? AtT + 16 * rtile * RS : XHm + 16 * (rtile - 4) * RS), RS, MinvT + 16 * tt4 * RS, RS, 64, a, lane);
            LAS bf16_t* dst = rtile < 4 ? UGm + 16 * rtile * RS : UHm + 16 * (rtile - 4) * RS;
#pragma unroll
            for (int r = 0; r < 4; ++r) dst[((lane >> 4) * 4 + r) * RS + 16 * tt4 + (lane & 15)] = f2bf(a[r]);
        }
        __syncthreads();
        LAUNDER2();
#pragma unroll
        for (int k = 0; k < 8; ++k) {
            const int mat = k >> 1, tile = w + 8 * (k & 1), ta = tile >> 2, tb = tile & 3, r0 = 16 * ta + (lane >> 4) * 4, cc = 16 * tb + (lane & 15);
            f32x4 a = {0.f, 0.f, 0.f, 0.f};
            if (mat == 0) {
                a = mma_tile(UGm + 16 * ta * RS, RS, BtT + 16 * tb * RS, RS, 64, a, lane);
                const float wl = WL[cc];
#pragma unroll
                for (int r = 0; r < 4; ++r) a[r] = (a[r] + ((r0 + r == cc) ? 1.f : 0.f)) * wl;
                u32x2 wv; wv.x = pk2(a[0], a[1]); wv.y = pk2(a[2], a[3]); *(LAS u32x2*)(GT + cc * RS + r0) = wv;
            } else if (mat == 1) {
                a = mma_tile(UHm + 16 * ta * RS, RS, BtT + 16 * tb * RS, RS, 64, a, lane);
                a = mma_tile(VT + 16 * ta * RS, RS, KtT + 16 * tb * RS, RS, 64, a, lane);
                const float wl = WL[cc];
#pragma unroll
                for (int r = 0; r < 4; ++r) Hm[(r0 + r) * RS + cc] = f2bf(a[r] * wl);
            } else if (mat == 2) {
                a = mma_tile(UGm + 16 * ta * RS, RS, AbrT + 16 * tb * RS, RS, 64, a, lane);
                const u32x2 rr = *(const LAS u32x2*)(Rt + cc * RS + r0);
                u32x2 wv; wv.x = pk2(a[0] + bflo(rr.x), a[1] + bfhi(rr.x)); wv.y = pk2(a[2] + bflo(rr.y), a[3] + bfhi(rr.y)); *(LAS u32x2*)(QT + cc * RS + r0) = wv;
            } else {
                a = mma_tile(UHm + 16 * ta * RS, RS, AbrT + 16 * tb * RS, RS, 64, a, lane);
                a = mma_tile(VT + 16 * ta * RS, RS, AkrT + 16 * tb * RS, RS, 64, a, lane);
                u32x2 wv; wv.x = pk2(a[0], a[1]); wv.y = pk2(a[2], a[3]); *(LAS u32x2*)(YHT + cc * RS + r0) = wv;
            }
        }
        __syncthreads();
        LAUNDER2();
        RA_PREFETCH(item + c.G - 64);
        if (!sample) {
            const int row = tid >> 3, pc = tid & 7; const size_t gr = (size_t)(rbase + row);
            *(u32x4*)(Z + gr * ZW + C_R + 64 * h + 8 * pc) = *(const LAS u32x4*)(GT + row * RS + 8 * pc);
            *(u32x4*)(Z + gr * ZW + C_RK + 64 * h + 8 * pc) = *(const LAS u32x4*)(QT + row * RS + 8 * pc);
            *(u32x4*)(T + gr * 3072 + 64 * h + 8 * pc) = *(const LAS u32x4*)(Hm + row * RS + 8 * pc);
            *(u32x4*)(T + gr * 3072 + 1024 + 64 * h + 8 * pc) = *(const LAS u32x4*)(YHT + row * RS + 8 * pc);
        } else {
            LAS bf16_t* S0b = AtT; LAS float* yT = (LAS float*)(L + RA_BtT);
            {
                const int i = tid >> 3, jq = tid & 7; float sf[8];
                const float* sp = inp(c, I_SRS) + ((((size_t)l * DB + sb) * 16 + h) * 64 + i) * 64 + 8 * jq;
#pragma unroll
                for (int e = 0; e < 8; ++e) sf[e] = sp[e];
                *(LAS u32x4*)(S0b + i * RS + 8 * jq) = pack8(sf);
            }
            __syncthreads();
            f32x4 sacc[4];
            rwkv_apply_tiles(w, lane, S0b, GT, QT, Hm, YHT, yT, sacc);
            if (w < 4) {
                float* os = outg(c) + O_SRS + (((size_t)l * DB + sb) * 16 + h) * 4096;
#pragma unroll
                for (int b = 0; b < 4; ++b)
#pragma unroll
                    for (int r = 0; r < 4; ++r) os[(size_t)(16 * w + (lane >> 4) * 4 + r) * 64 + 16 * b + (lane & 15)] = sacc[b][r];
            }
            __syncthreads();
            float lnw[8], lnb[8];
#pragma unroll
            for (int e = 0; e < 8; ++e) { lnw[e] = inp(c, I_LNW)[(size_t)l * D + 64 * h + 8 * (tid & 7) + e]; lnb[e] = inp(c, I_LNB)[(size_t)l * D + 64 * h + 8 * (tid & 7) + e]; }
            rwkv_post(tid, yT, vblk, gblk, bon, lnw, lnb, Z + (size_t)rbase * ZW + C_R + 64 * h, nvalid);
        }
        __syncthreads();
    }
}

constexpr int RB_S0 = 0, RB_YT = 9216, RB_BUF = 25856, RB_BUFSZ = 55552;
__device__ __forceinline__ void rwkv_rb_chain(const Ctx& c, unsigned& epoch, int p, int l, int q, int h) {
    bf16_t* Z = (bf16_t*)(wsg(c) + WS_Z); const bf16_t* T = (const bf16_t*)(wsg(c) + WS_T); const float* bonus_g = (const float*)(wsg(c) + WS_BONUS);
    const int tid = c.tid, lane = c.lane, w = c.wave; const Seq sq = seq_of(p, q);
    LAS unsigned char* L = c.lds; asm volatile("" : "+v"(L));
    LAS bf16_t* S0b = (LAS bf16_t*)(L + RB_S0); LAS float* yT = (LAS float*)(L + RB_YT);
    const int row = tid >> 3, pc = tid & 7, NCH = SEQ / 64;
    float lnw[8], lnb[8];
#pragma unroll
    for (int e = 0; e < 8; ++e) { lnw[e] = inp(c, I_LNW)[(size_t)l * D + 64 * h + 8 * pc + e]; lnb[e] = inp(c, I_LNB)[(size_t)l * D + 64 * h + 8 * pc + e]; }
    { unsigned zz = 0u; asm volatile("" : "+v"(zz)); const u32x4 z4 = {zz, zz, zz, zz}; *(LAS u32x4*)(S0b + row * RS + 8 * pc) = z4; }
    f32x4 sacc[4];
#pragma unroll
    for (int b = 0; b < 4; ++b) sacc[b] = (f32x4){0.f, 0.f, 0.f, 0.f};
    u32x4 pg, pq, ph, py, pv, pgb; float pbon = 0.f;
#define RB_LOAD(RB) do { const size_t gr = (size_t)((RB) + row); \
        pg = *(const u32x4*)(Z + gr * ZW + C_R + 64 * h + 8 * pc); pq = *(const u32x4*)(Z + gr * ZW + C_RK + 64 * h + 8 * pc); pv = *(const u32x4*)(Z + gr * ZW + C_RV + 64 * h + 8 * pc); \
        ph = *(const u32x4*)(T + gr * 3072 + 64 * h + 8 * pc); py = *(const u32x4*)(T + gr * 3072 + 1024 + 64 * h + 8 * pc); pgb = *(const u32x4*)(T + gr * 3072 + 2048 + 64 * h + 8 * pc); \
        if (tid < 64) pbon = bonus_g[(size_t)((RB) + tid) * 16 + h]; } while (0)
#define RB_PARK(BUF) do { LAS unsigned char* bb_ = L + RB_BUF + (BUF) * RB_BUFSZ; const int o_ = (row * RS + 8 * pc) * 2; \
        *(LAS u32x4*)(bb_ + o_) = pg; *(LAS u32x4*)(bb_ + 9216 + o_) = pq; *(LAS u32x4*)(bb_ + 18432 + o_) = ph; *(LAS u32x4*)(bb_ + 27648 + o_) = py; \
        *(LAS u32x4*)(bb_ + 36864 + o_) = pv; *(LAS u32x4*)(bb_ + 46080 + o_) = pgb; if (tid < 64) ((LAS float*)(bb_ + 55296))[tid] = pbon; } while (0)
    RB_LOAD(sq.row0); RB_PARK(0); RB_LOAD(sq.row0 + 64);
    __syncthreads();
    for (int ck = 0; ck < NCH; ++ck) {
        const int rbase = sq.row0 + ck * 64, cur = ck & 1;
        LAS unsigned char* bb = L + RB_BUF + cur * RB_BUFSZ;
        rwkv_apply_tiles(w, lane, S0b, (const LAS bf16_t*)bb, (const LAS bf16_t*)(bb + 9216), (const LAS bf16_t*)(bb + 18432), (const LAS bf16_t*)(bb + 27648), yT, sacc);
        __syncthreads();
        if (w < 4) {
#pragma unroll
            for (int b = 0; b < 4; ++b)
#pragma unroll
                for (int r = 0; r < 4; ++r) S0b[(16 * w + (lane >> 4) * 4 + r) * RS + 16 * b + (lane & 15)] = f2bf(sacc[b][r]);
        }
        rwkv_post(tid, yT, (const LAS bf16_t*)(bb + 36864), (const LAS bf16_t*)(bb + 46080), (const LAS float*)(bb + 55296), lnw, lnb, Z + (size_t)rbase * ZW + C_R + 64 * h, 64);
        if (ck + 1 < NCH) { RB_PARK(cur ^ 1); if (ck + 2 < NCH) RB_LOAD(rbase + 128); }
        __syncthreads();
        if (ck == 15 || ck == 79) grid_bar((unsigned*)(wsg(c) + WS_BAR), epoch, (unsigned)gridDim.x);
    }
#undef RB_LOAD
#undef RB_PARK
    if (w < 4) {
        float* os = outg(c) + O_PRS + (((size_t)l * NB + sq.b) * 16 + h) * 4096;
#pragma unroll
        for (int b = 0; b < 4; ++b)
#pragma unroll
            for (int r = 0; r < 4; ++r) os[(size_t)(16 * w + (lane >> 4) * 4 + r) * 64 + 16 * b + (lane & 15)] = sacc[b][r];
    }
}

__device__ __forceinline__ void phase_seqmix_a(const Ctx& c, int p, int l) {
    if (c.bid < 64) { const int q = c.bid >> 5, h = (c.bid >> 3) & 3, slab = c.bid & 7; mlstm_task(c, p, l, q, h, slab); }
    else {
        phase_rwkv_ra(c, p, l);
        if (p == 1) { const int nw = c.G - 64, wgi = c.bid - 64;
            for (int t = wgi; t < 512; t += nw) { const int q = 2 + (t >> 5), h = (t >> 3) & 3, slab = t & 7; mlstm_task(c, p, l, q, h, slab); } }
    }
}

__device__ __forceinline__ void phase_om(const Ctx& c, int p, int l) {
    bf16_t* Z = (bf16_t*)(wsg(c) + WS_Z); const int nrows = pass_rows(p), lane = c.lane, head = lane >> 4, part = lane & 15, col = 256 * head + 16 * part;
    float nm[16];
#pragma unroll
    for (int e = 0; e < 16; ++e) nm[e] = inp(c, I_MNORM)[(size_t)l * D + col + e];
    for (int r = c.bid * 8 + c.wave; r < nrows; r += c.G * 8) {
        float hv[16], zo[16];
        unpack8(*(const u32x4*)(Z + (size_t)r * ZW + C_V + col), *(float(*)[8])&hv[0]); unpack8(*(const u32x4*)(Z + (size_t)r * ZW + C_V + col + 8), *(float(*)[8])&hv[8]);
        unpack8(*(const u32x4*)(Z + (size_t)r * ZW + C_O + col), *(float(*)[8])&zo[0]); unpack8(*(const u32x4*)(Z + (size_t)r * ZW + C_O + col + 8), *(float(*)[8])&zo[8]);
        float s = 0.f;
#pragma unroll
        for (int e = 0; e < 16; ++e) s += hv[e];
        s += __shfl_xor(s, 1); s += __shfl_xor(s, 2); s += __shfl_xor(s, 4); s += __shfl_xor(s, 8);
        const float mean = s * (1.0f / 256.0f); float q = 0.f;
#pragma unroll
        for (int e = 0; e < 16; ++e) { hv[e] -= mean; q += hv[e] * hv[e]; }
        q += __shfl_xor(q, 1); q += __shfl_xor(q, 2); q += __shfl_xor(q, 4); q += __shfl_xor(q, 8);
        const float rstd = __builtin_amdgcn_rsqf(q * (1.0f / 256.0f) + 1e-6f);
        float o0[8], o1[8];
#pragma unroll
        for (int e = 0; e < 8; ++e) { o0[e] = sigmoidf_(zo[e]) * hv[e] * rstd * nm[e]; o1[e] = sigmoidf_(zo[8 + e]) * hv[8 + e] * rstd * nm[8 + e]; }
        *(u32x4*)(Z + (size_t)r * ZW + C_O + col) = pack8(o0); *(u32x4*)(Z + (size_t)r * ZW + C_O + col + 8) = pack8(o1);
    }
}

__global__ void __launch_bounds__(NTHREADS, 2) mega_fwd(Args args) {
    extern __shared__ __attribute__((aligned(16))) unsigned char lds_raw[];
    cg::grid_group grid = cg::this_grid();
    Ctx c; c.out = args.out; c.ws = args.ws; c.lds = (LAS unsigned char*)lds_raw;
    c.tid = threadIdx.x; c.lane = c.tid & 63; c.wave = __builtin_amdgcn_readfirstlane(c.tid >> 6); c.G = gridDim.x; c.bid = blockIdx.x; c.dry = 0;
    if (c.tid < N_IN) { const unsigned long long v = (unsigned long long)args.in[c.tid]; LAS unsigned* t = (LAS unsigned*)(c.lds + TAB_OFF); t[2 * c.tid] = (unsigned)v; t[2 * c.tid + 1] = (unsigned)(v >> 32); }
    __syncthreads();
    const int lo = args.ph_lo, hi = args.ph_hi; int ph = 0;
    unsigned epoch = 0u;
    grid.sync();
#define GSYNC() grid_bar((unsigned*)(wsg(c) + WS_BAR), epoch, (unsigned)gridDim.x)
#define W ((bf16_t*)wsg(c))
#define UP ((bf16_t*)(wsg(c) + WS_UP))
#define Zb ((bf16_t*)(wsg(c) + WS_Z))
#define Tb ((bf16_t*)(wsg(c) + WS_T))
#define X (outg(c))
#define PH(body) do { if (ph >= lo && ph < hi) { asm volatile("" : "+v"(c.tid), "+v"(c.lane), "+s"(c.bid), "+s"(c.wave), "+s"(c.G), "+s"(c.ws), "+s"(c.out), "+s"(c.lds)); body; if (ph + 1 < hi) GSYNC(); } ++ph; } while (0)
#define PHD(grp, body) PH(body)
    for (int l = 0; l < 2; ++l) {
        for (int st = 0; st < 3; ++st) {
            if (st != 1) {
                const int f = st >> 1;
                PH((f == 0 ? phase_cvt(c, l) : (void)0, phase_norm(c, (l == 0 && f == 0) ? inp(c, I_XP) : nullptr, inp(c, I_XS), X, 0, NTOK, inp(c, f ? I_F2N : I_F1N) + (size_t)l * D, Tb, nullptr, nullptr)));
                PHD(1, run_gemm(c, Tb, D, W + (f ? W_GU2 : W_GU1) / 2, D, NTOK, 2 * FF, D, 0, 0, EpiSwiglu{Zb}));
                PH((run_gemm(c, Zb, FF, W + (f ? W_D2 : W_D1) / 2, FF, NPROMPT, D, FF, 0, 0, EpiResAdd{X, 0.5f}),
                    run_gemm_splitk(c, Zb + (size_t)NPROMPT * FF, FF, W + (f ? W_D2 : W_D1) / 2, FF, FF, X + (size_t)NPROMPT * D, 0.5f)));
            } else {
                for (int p = 0; p < 2; ++p) {
                    const int Mp = pass_rows(p), g0 = p * 16384;
                    PH(phase_norm(c, nullptr, nullptr, X, g0, Mp, inp(c, I_MIXN) + (size_t)l * D, UP, (const float*)(wsg(c) + W_IF), (float*)(wsg(c) + WS_GIF)));
                    PHD(1, run_gemm(c, UP, D, W + W_IN / 2, D, Mp, ZW, D, 0, 0, EpiStore{Zb, ZW, 0}));
                    PH(phase_cv1(c, p, l));
                    PH(phase_cv2(c, p, l));
                    PH(run_gemm(c, Zb + C_LRU, ZW, W + W_LRU / 2, 256, Mp, 2048, 256, 4, 256, EpiStore{Tb, 2048, 0}));
                    PH((phase_lru<0>(c, p, l), phase_mlstm_s(c, p, l)));
                    PH(phase_lru<1>(c, p, l));
                    PH(run_gemm(c, Zb + C_WD, ZW, W + W_LORA / 2, 256, Mp, 3072, 256, 0, 0, EpiStore{Tb, 3072, 0}));
                    PHD(2, phase_seqmix_a(c, p, l));
                    {
                        asm volatile("" : "+v"(c.tid), "+v"(c.lane), "+s"(c.bid), "+s"(c.wave), "+s"(c.G), "+s"(c.ws), "+s"(c.out), "+s"(c.lds));
                        if (c.bid < 32) { rwkv_rb_chain(c, epoch, p, l, c.bid >> 4, c.bid & 15); GSYNC(); }
                        else {
                            Ctx c2 = c; c2.bid = c.bid - 32; c2.G = c.G - 32;
                            phase_om(c2, p, l); GSYNC();
                            asm volatile("" : "+v"(c2.tid), "+v"(c2.lane));
                            run_gemm(c2, (bf16_t*)(wsg(c2) + WS_UP), D, (bf16_t*)wsg(c2) + W_G / 2, D, Mp, 3072, D, 0, 0, EpiStore{(bf16_t*)(wsg(c2) + WS_Z), ZW, C_Q}); GSYNC();
                            for (int b = 0; b < 2; ++b) {
                                asm volatile("" : "+v"(c2.tid), "+v"(c2.lane));
                                run_gemm(c2, (bf16_t*)(wsg(c2) + WS_Z) + (b == 0 ? C_LRU : C_O), ZW, (bf16_t*)wsg(c2) + W_BR / 2 + (size_t)b * D * D, D, Mp, D, D, 0, 0, EpiMerge{(bf16_t*)(wsg(c2) + WS_UP), (const bf16_t*)(wsg(c2) + WS_Z), C_Q + 1024 * b, b == 0});
                            }
                            GSYNC();
                        }
                    }
                    PH(run_gemm(c, Zb + C_R, ZW, W + W_BR / 2 + (size_t)2 * D * D, D, Mp, D, D, 0, 0, EpiMerge{UP, Zb, C_Q + 2048, 0}));
                    PH(run_gemm(c, UP, D, W + W_OUT / 2, D, Mp, D, D, 0, 0, EpiResAdd{X + (size_t)g0 * D, 1.0f}));
                }
            }
        }
    }
    PH(phase_final_norm(c, X, inp(c, I_FN)));
#undef PH
#undef GSYNC
#undef PHD
#undef W
#undef UP
#undef Zb
#undef Tb
#undef X
}

extern "C" void kernel_launch(void* const* d_in, const int* in_sizes, int n_in, void* d_out, int out_size, void* d_ws, size_t ws_size, hipStream_t stream) {
    static int grid = 0;
    if (grid == 0) {
        if (n_in != N_IN || (size_t)out_size != O_END || ws_size < WS_END) { fprintf(stderr, "kernel_launch: unexpected shapes n_in %d out %d ws %zu\n", n_in, out_size, ws_size); grid = -1; return; }
        int dev = 0, cus = 0, per_cu = 0;
        hipGetDevice(&dev); hipDeviceGetAttribute(&cus, hipDeviceAttributeMultiprocessorCount, dev);
        if (hipFuncSetAttribute((const void*)mega_fwd, hipFuncAttributeMaxDynamicSharedMemorySize, LDS_BYTES) != hipSuccess) { fprintf(stderr, "hipFuncSetAttribute failed\n"); grid = -1; return; }
        hipOccupancyMaxActiveBlocksPerMultiprocessor(&per_cu, (const void*)mega_fwd, NTHREADS, LDS_BYTES);
        (void)hipGetLastError();
        if (per_cu < 1) per_cu = 1;
        grid = cus;
        if (grid > 256) grid = 256;
    }
    if (grid < 0) return;
    if (hipMemsetAsync((char*)d_ws + WS_BAR, 0, 4096, stream) != hipSuccess) { fprintf(stderr, "memset failed\n"); return; }
    Args a{};
    for (int i = 0; i < N_IN; ++i) a.in[i] = (const float*)d_in[i];
    a.out = (float*)d_out; a.ws = (unsigned char*)d_ws; a.ph_lo = 0; a.ph_hi = 1000;
    void* kargs[] = {&a};
    hipError_t e = hipLaunchCooperativeKernel((const void*)mega_fwd, dim3(grid), dim3(NTHREADS), kargs, LDS_BYTES, stream);
    if (e != hipSuccess) fprintf(stderr, "cooperative launch failed: %s (grid %d)\n", hipGetErrorString(e), grid);
}
```

```cpp
#include <hip/hip_runtime.h>
#include <hip/hip_cooperative_groups.h>
#include <cstdio>
namespace cg = cooperative_groups;
namespace pg8 {
#define PG8_LAS __attribute__((address_space(3)))
typedef unsigned short bf16_t;
typedef short bf16x8 __attribute__((ext_vector_type(8)));
typedef float f32x4 __attribute__((ext_vector_type(4)));
typedef unsigned u32x4 __attribute__((ext_vector_type(4)));
constexpr int BM = 256, BK = 64, HALF = 128, HTB = HALF * BK * 2  , STAGE_BYTES = 8 * HTB, NXCD = 8, WGM = 8;
__host__ __device__ __forceinline__ int lds_byte(int r, int c) { const int st = (r >> 4) * 2 + (c >> 5), rr = r & 15, cc = c & 31, ob = rr * 64 + cc * 2; return st * 1024 + (ob ^ (((ob >> 9) & 1) << 5)); }
__host__ __device__ __forceinline__ void stage_rc(int b, int& R, int& C) { const int st = b / 1024, sb = b % 1024, swz = sb ^ (((sb >> 9) & 1) << 5); R = (st >> 1) * 16 + swz / 64; C = (st & 1) * 32 + (swz % 64) / 2; }
__host__ __device__ __forceinline__ int perm32(int rho) { const int n = rho >> 4, i = rho & 15; return 8 * (i >> 2) + 4 * n + (i & 3); }
struct Unit { int pm, pn; };
struct Gemm { const bf16_t* A; int lda; const bf16_t* Bt; int ldb; int M, N, K; int amod, astride; int ksn, kchunk;
    __device__ __forceinline__ size_t acol(int pn) const { return (amod ? (size_t)((pn % amod) * astride) * 2 : (size_t)0) + (ksn ? (size_t)((pn / ksn) * kchunk) * 2 : (size_t)0); }
    __device__ __forceinline__ size_t boff(int pn, size_t tstepB) const { return ksn ? (size_t)(pn % ksn) * tstepB + (size_t)((pn / ksn) * kchunk) * 2 : (size_t)pn * tstepB; } };
struct StaticOrder {
    int nM, nN, nwg, G, c;
    __host__ __device__ void init(int M, int N, int G_, int c_) { nM = M / BM; nN = N / BM; nwg = nM * nN; G = G_; c = c_; }
    __host__ __device__ bool next(int i, Unit& u) const {
        const long L = (long)i * G + c; if (L >= nwg) return false;
        int wgid = (int)L; { const int q = nwg / NXCD, r = nwg % NXCD, xcd = wgid % NXCD, off = wgid / NXCD; wgid = (xcd < r ? xcd * (q + 1) : r * (q + 1) + (xcd - r) * q) + off; }
        const int nig = WGM * nN, gid = wgid / nig, fm = gid * WGM, gsz = (nM - fm) < WGM ? (nM - fm) : WGM;
        u.pm = fm + ((wgid % nig) % gsz); u.pn = (wgid % nig) / gsz; return true;
    }
    __device__ __forceinline__ void a_ready(const Unit&) const {}
    __device__ __forceinline__ void done(const Unit&) const {}
};
__device__ __forceinline__ unsigned cvt_pk_bf16(float lo, float hi) { unsigned r; asm volatile("v_cvt_pk_bf16_f32 %0, %1, %2" : "=v"(r) : "v"(lo), "v"(hi)); return r; }
template <class Epi, class Sched>
__device__ __forceinline__ void gemm_phase(PG8_LAS unsigned char* lds, const Gemm g, const Sched& S, const Epi& E, const int tid_in) {
    const int tid = tid_in, wid = __builtin_amdgcn_readfirstlane(tid >> 6), lane = tid & 63, wr = wid >> 2, wc = wid & 3, fr = lane & 15, fq = lane >> 4;
    const int K = g.K, nt = K / BK;
    unsigned voffA[2], voffB[2];
#pragma unroll
    for (int i = 0; i < 2; ++i) { int R, C; stage_rc(tid * 16 + i * 8192, R, C); const int Rb = Epi::PERM ? ((R & ~31) + perm32(R & 31)) : R;
        voffA[i] = (unsigned)(R * g.lda + C) * 2u; voffB[i] = (unsigned)(Rb * g.ldb + C) * 2u; }
    const size_t kstep = (size_t)(BK * 2);
    const size_t hstepA = (size_t)HALF * g.lda * 2, hstepB = (size_t)HALF * g.ldb * 2;
    const size_t tstepA = 2 * hstepA, tstepB = 2 * hstepB;
    const unsigned ldsw = (unsigned)wid * 1024u;
    const int aoff = lds_byte(wr * 64 + fr, fq * 8), boff = lds_byte(wc * 32 + fr, fq * 8);
#define PG8_SA(b, h) (((b) * 2 + (h)) * HTB)
#define PG8_SB(b, h) ((4 + (b) * 2 + (h)) * HTB)
#define PG8_STAGE(bufoff, gbase, voff) do { _Pragma("unroll") for (int _i = 0; _i < 2; ++_i) \
        __builtin_amdgcn_global_load_lds((const unsigned*)((const char*)(gbase) + (voff)[_i]), (PG8_LAS unsigned*)(lds + (bufoff) + ldsw + _i * 8192), 16, 0, 0); } while (0)
#define PG8_LDA(dst, b, h) do { _Pragma("unroll") for (int m = 0; m < 4; ++m) _Pragma("unroll") for (int k = 0; k < 2; ++k) dst[m][k] = *(const PG8_LAS bf16x8*)(lds + PG8_SA(b, h) + aoff + m * 2048 + k * 1024); } while (0)
#define PG8_LDB(dst, b, h) do { _Pragma("unroll") for (int n = 0; n < 2; ++n) _Pragma("unroll") for (int k = 0; k < 2; ++k) dst[n][k] = *(const PG8_LAS bf16x8*)(lds + PG8_SB(b, h) + boff + n * 2048 + k * 1024); } while (0)
#define PG8_MMA(ai, bj, At, Bt) do { __builtin_amdgcn_s_setprio(1); _Pragma("unroll") for (int m = 0; m < 4; ++m) _Pragma("unroll") for (int n = 0; n < 2; ++n) _Pragma("unroll") for (int k = 0; k < 2; ++k) \
        acc[ai][bj][m][n] = __builtin_amdgcn_mfma_f32_16x16x32_bf16(Bt[n][k], At[m][k], acc[ai][bj][m][n], 0, 0, 0); __builtin_amdgcn_s_setprio(0); } while (0)
#define PG8_WAIT_V(n) asm volatile("s_waitcnt vmcnt(" #n ")" ::: "memory")
#define PG8_WAIT_L(n) asm volatile("s_waitcnt lgkmcnt(" #n ")" ::: "memory")
#define PG8_BAR __builtin_amdgcn_s_barrier()
#define PG8_SCHED __builtin_amdgcn_sched_barrier(0)
    Unit cur, nxt; int ui = 0;
    if (!S.next(0, cur)) return;
    f32x4 acc[2][2][4][2];
#pragma unroll
    for (int a = 0; a < 2; ++a)
#pragma unroll
        for (int b = 0; b < 2; ++b)
#pragma unroll
            for (int m = 0; m < 4; ++m)
#pragma unroll
                for (int n = 0; n < 2; ++n) acc[a][b][m][n] = (f32x4){0.f, 0.f, 0.f, 0.f};
    bf16x8 At[4][2], B0[2][2], B1[2][2];
    const char* cA = (const char*)g.A + (size_t)cur.pm * tstepA + g.acol(cur.pn); const char* cB = (const char*)g.Bt + g.boff(cur.pn, tstepB);
    S.a_ready(cur);
    PG8_STAGE(PG8_SB(0, 0), cB, voffB); PG8_STAGE(PG8_SA(0, 0), cA, voffA); PG8_STAGE(PG8_SB(0, 1), cB + hstepB, voffB); PG8_STAGE(PG8_SA(0, 1), cA + hstepA, voffA);
    if (wr == 1) PG8_BAR;
    PG8_WAIT_V(4); PG8_BAR;
    PG8_STAGE(PG8_SB(1, 0), cB + kstep, voffB); PG8_STAGE(PG8_SA(1, 0), cA + kstep, voffA); PG8_STAGE(PG8_SB(1, 1), cB + hstepB + kstep, voffB);
    PG8_WAIT_V(6); PG8_BAR;
    for (;;) {
        const bool has_next = S.next(ui + 1, nxt);
        const char* nA = has_next ? (const char*)g.A + (size_t)nxt.pm * tstepA + g.acol(nxt.pn) : cA; const char* nB = has_next ? (const char*)g.Bt + g.boff(nxt.pn, tstepB) : cB;
        for (int t = 0; t < nt; t += 2) {
            const bool last = (t == nt - 2);
            const char* a1 = cA + (size_t)(t + 1) * kstep;
            const char* a2 = last ? nA : cA + (size_t)(t + 2) * kstep; const char* b2 = last ? nB : cB + (size_t)(t + 2) * kstep;
            const char* a3 = a2 + kstep; const char* b3 = b2 + kstep;
            if (last && has_next) S.a_ready(nxt);
            PG8_LDB(B0, 0, 0); PG8_SCHED; PG8_LDA(At, 0, 0); PG8_STAGE(PG8_SA(1, 1), a1 + hstepA, voffA);
            PG8_WAIT_L(8); PG8_BAR; PG8_WAIT_L(0); PG8_MMA(0, 0, At, B0); PG8_BAR; PG8_SCHED;
            PG8_LDB(B1, 0, 1); PG8_STAGE(PG8_SB(0, 0), b2, voffB);
            PG8_BAR; PG8_WAIT_L(0); PG8_MMA(0, 1, At, B1); PG8_BAR;
            PG8_LDA(At, 0, 1); PG8_STAGE(PG8_SA(0, 0), a2, voffA);
            PG8_BAR; PG8_WAIT_L(0); PG8_MMA(1, 0, At, B0); PG8_BAR; PG8_SCHED;
            PG8_STAGE(PG8_SB(0, 1), b2 + hstepB, voffB);
            PG8_WAIT_V(6); PG8_BAR; PG8_MMA(1, 1, At, B1); PG8_BAR;
            PG8_LDB(B0, 1, 0); PG8_SCHED; PG8_LDA(At, 1, 0); PG8_STAGE(PG8_SA(0, 1), a2 + hstepA, voffA);
            PG8_WAIT_L(8); PG8_BAR; PG8_WAIT_L(0); PG8_MMA(0, 0, At, B0); PG8_BAR; PG8_SCHED;
            PG8_LDB(B1, 1, 1); PG8_STAGE(PG8_SB(1, 0), b3, voffB);
            PG8_BAR; PG8_WAIT_L(0); PG8_MMA(0, 1, At, B1); PG8_BAR;
            PG8_LDA(At, 1, 1); PG8_STAGE(PG8_SA(1, 0), a3, voffA);
            PG8_BAR; PG8_WAIT_L(0); PG8_MMA(1, 0, At, B0); PG8_BAR; PG8_SCHED;
            PG8_STAGE(PG8_SB(1, 1), b3 + hstepB, voffB);
            PG8_WAIT_V(6); PG8_BAR; PG8_MMA(1, 1, At, B1); PG8_BAR;
        }
        if constexpr (!Epi::AFTER_DRAIN) { E(acc, cur, wr, wc, fr, fq); S.done(cur); }
        if (!has_next) break;
#pragma unroll
        for (int a = 0; a < 2; ++a)
#pragma unroll
            for (int b = 0; b < 2; ++b)
#pragma unroll
                for (int m = 0; m < 4; ++m)
#pragma unroll
                    for (int n = 0; n < 2; ++n) acc[a][b][m][n] = (f32x4){0.f, 0.f, 0.f, 0.f};
        cur = nxt; cA = nA; cB = nB; ++ui;
    }
    PG8_WAIT_V(0);
    if (wr == 0) PG8_BAR;
    PG8_BAR;
    if constexpr (Epi::AFTER_DRAIN) { E.fused(acc, cur, wr, wc, fr, fq, lds, wid, lane); S.done(cur); }
#undef PG8_SA
#undef PG8_SB
#undef PG8_STAGE
#undef PG8_LDA
#undef PG8_LDB
#undef PG8_MMA
#undef PG8_WAIT_V
#undef PG8_WAIT_L
#undef PG8_BAR
#undef PG8_SCHED
}

}

#define LAS __attribute__((address_space(3)))
typedef unsigned short bf16_t;
typedef short bf16x8 __attribute__((ext_vector_type(8)));
typedef float f32x4 __attribute__((ext_vector_type(4)));
typedef unsigned u32x4 __attribute__((ext_vector_type(4)));
typedef unsigned u32x2 __attribute__((ext_vector_type(2)));

constexpr int D = 1024, FF = 2816, NTOK = 33024, NPROMPT = 32768, SEQ = 8192, DSEQ = 16, NB = 4, DB = 16;
constexpr int ZW = 8448, C_LRU = 0, C_Q = 1024, C_K = 2048, C_V = 3072, C_O = 4096, C_R = 5120, C_RK = 6144, C_RV = 7168, C_WD = 8192;
constexpr int INW = 11528, CONVCH = 3072, RIN = 3328;
constexpr int NTHREADS = 512;
constexpr int LDS_BYTES = 147456;

constexpr size_t W_GU1 = 0, W_D1 = 11534336, W_GU2 = 17301504, W_D2 = 28835840, W_IN = 34603008, W_G = 51904512, W_LRU = 58195968, W_LORA = 59244544,
                 W_BR = 60817408, W_OUT = 67108864, W_IF = 69206016;
constexpr size_t WS_BAR = 513229056, WS_SL = 504316160;
constexpr size_t WS_UP = 69238784, WS_Z = 103317504, WS_T = 384466944, WS_HALO = 486703104, WS_GIF = 500490240, WS_CAR = 501022720, WS_BONUS = 503250944, WS_END = 513229056 + 4096;

constexpr size_t O_Y = 0, O_PCONV = 33816576, O_PLRU = O_PCONV + 73728, O_PMC = O_PLRU + 8192, O_PMN = O_PMC + 2097152, O_PMM = O_PMN + 8192, O_PSH = O_PMM + 32,
                 O_PRS = O_PSH + 26624, O_SCONV = O_PRS + 524288, O_SLRU = O_SCONV + 294912, O_SMC = O_SLRU + 32768, O_SMN = O_SMC + 8388608, O_SMM = O_SMN + 32768,
                 O_SSH = O_SMM + 128, O_SRS = O_SSH + 106496, O_END = O_SRS + 2097152;

enum { I_XP = 0, I_XS, I_SCONV, I_SLRU, I_SMC, I_SMN, I_SMM, I_SSH, I_SRS, I_F1N, I_F1G, I_F1U, I_F1D, I_MIXN, I_WIN, I_CONVW, I_CONVB, I_LWA, I_LBA, I_LWX, I_LBX,
       I_LLAM, I_IFB, I_MNORM, I_MU, I_W0, I_W2, I_A0, I_A2, I_G2, I_KK, I_KA, I_RK, I_LNW, I_LNB, I_WBR, I_WOUT, I_F2N, I_F2G, I_F2U, I_F2D, I_FN, N_IN };

struct Args { const float* in[N_IN]; float* out; unsigned char* ws; int ph_lo, ph_hi; };

constexpr int TAB_OFF = LDS_BYTES - 512;
struct Ctx {
    float* out; unsigned char* ws; LAS unsigned char* lds;
    int tid, lane, wave, G, bid, dry;
};

__device__ __forceinline__ const float* inp(const Ctx& c, int i) {
    const LAS unsigned* t = (const LAS unsigned*)(c.lds + TAB_OFF);
    const unsigned lo = __builtin_amdgcn_readfirstlane(t[2 * i]), hi = __builtin_amdgcn_readfirstlane(t[2 * i + 1]);
    typedef const float __attribute__((address_space(1)))* gptr_t;
    return (const float*)(gptr_t)(((unsigned long long)hi << 32) | (unsigned long long)lo);
}
#define GAS __attribute__((address_space(1)))
__device__ __forceinline__ unsigned char* wsg(const Ctx& c) { return (unsigned char*)(GAS unsigned char*)(unsigned long long)c.ws; }
__device__ __forceinline__ float* outg(const Ctx& c) { return (float*)(GAS float*)(unsigned long long)c.out; }
__device__ __forceinline__ float bf2f(bf16_t b) { return __uint_as_float(((unsigned)b) << 16); }
__device__ __forceinline__ float bflo(unsigned w) { return __uint_as_float(w << 16); }
__device__ __forceinline__ float bfhi(unsigned w) { return __uint_as_float(w & 0xffff0000u); }
__device__ __forceinline__ bf16_t f2bf(float f) { unsigned u = __float_as_uint(f); u += 0x7FFFu + ((u >> 16) & 1u); return (bf16_t)(u >> 16); }
typedef __bf16 bf16v2_t __attribute__((ext_vector_type(2)));
typedef float f32v2_t __attribute__((ext_vector_type(2)));
__device__ __forceinline__ unsigned pk2(float lo, float hi) {
    const f32v2_t f = {lo, hi}; const bf16v2_t b = __builtin_convertvector(f, bf16v2_t); return __builtin_bit_cast(unsigned, b);
}
__device__ __forceinline__ void unpack8(const u32x4 w, float (&f)[8]) { f[0] = bflo(w.x); f[1] = bfhi(w.x); f[2] = bflo(w.y); f[3] = bfhi(w.y); f[4] = bflo(w.z); f[5] = bfhi(w.z); f[6] = bflo(w.w); f[7] = bfhi(w.w); }
__device__ __forceinline__ u32x4 pack8(const float (&f)[8]) { u32x4 w; w.x = pk2(f[0], f[1]); w.y = pk2(f[2], f[3]); w.z = pk2(f[4], f[5]); w.w = pk2(f[6], f[7]); return w; }
__device__ __forceinline__ float sigmoidf_(float x) { return __builtin_amdgcn_rcpf(1.0f + __expf(-x)); }
__device__ __forceinline__ float siluf_(float x) { return x * __builtin_amdgcn_rcpf(1.0f + __expf(-x)); }
__device__ __forceinline__ float softplusf_(float x) { return fmaxf(x, 0.f) + __logf(1.0f + __expf(-fabsf(x))); }
__device__ __forceinline__ float tanhf_(float x) { return 1.0f - 2.0f * __builtin_amdgcn_rcpf(__expf(2.0f * x) + 1.0f); }
__device__ __forceinline__ float wsum(float v) {
#pragma unroll
    for (int o = 32; o >= 1; o >>= 1) v += __shfl_xor(v, o);
    return v;
}

__device__ __forceinline__ int pass_rows(int p) { return p ? 16640 : 16384; }
__device__ __forceinline__ int pass_nseg(int p) { return p ? 272 : 256; }
__device__ __forceinline__ int pass_nseq(int p) { return p ? 18 : 2; }
struct Seq { int row0, T, sample, b; };
__device__ __forceinline__ Seq seq_of(int p, int q) { Seq s; if (q < 2) { s.row0 = q * SEQ; s.T = SEQ; s.sample = 0; s.b = 2 * p + q; } else { s.row0 = 16384 + (q - 2) * DSEQ; s.T = DSEQ; s.sample = 1; s.b = q - 2; } return s; }
struct Seg { int q, c, row0, n, nch; };
__device__ __forceinline__ Seg seg_of(int s) { Seg g; if (s < 256) { g.q = s >> 7; g.c = s & 127; g.row0 = g.q * SEQ + g.c * 64; g.n = 64; g.nch = 128; } else { g.q = 2 + (s - 256); g.c = 0; g.row0 = 16384 + (s - 256) * DSEQ; g.n = DSEQ; g.nch = 1; } return g; }

__device__ __forceinline__ void grid_bar(unsigned* bar, unsigned& epoch, unsigned G) {
    __syncthreads();
    epoch += 1u;
    if (threadIdx.x == 0) {
        const unsigned ng = (G & 7u) ? 1u : 8u, grp = blockIdx.x % ng, per = G / ng;
        unsigned* xc = bar + 64 + 64 * grp;
        const unsigned old = __hip_atomic_fetch_add(xc, 1u, __ATOMIC_ACQ_REL, __HIP_MEMORY_SCOPE_AGENT);
        if (old + 1u == epoch * per) __hip_atomic_fetch_add(bar, 1u, __ATOMIC_RELEASE, __HIP_MEMORY_SCOPE_AGENT);
        const unsigned target = epoch * ng;
        while (__hip_atomic_load(bar, __ATOMIC_RELAXED, __HIP_MEMORY_SCOPE_AGENT) < target) __builtin_amdgcn_s_sleep(1);
        __builtin_amdgcn_fence(__ATOMIC_ACQUIRE, "agent");
        asm volatile("s_waitcnt vmcnt(0)" ::: "memory");
    }
    __syncthreads();
}

struct EpiSwiglu {
    static constexpr bool PERM = true, AFTER_DRAIN = false;
    bf16_t* H;
    __device__ __forceinline__ void operator()(const f32x4 (&acc)[2][2][4][2], const pg8::Unit& u, int wr, int wc, int fr, int fq) const {
        const int row0 = u.pm * 256 + wr * 64 + fr, col0 = u.pn * 128 + wc * 32 + 8 * fq;
#pragma unroll
        for (int ai = 0; ai < 2; ++ai)
#pragma unroll
            for (int m = 0; m < 4; ++m) {
                float o[8];
#pragma unroll
                for (int n = 0; n < 2; ++n)
#pragma unroll
                    for (int j = 0; j < 4; ++j) o[4 * n + j] = siluf_(acc[ai][0][m][n][j]) * acc[ai][1][m][n][j];
                *(u32x4*)(H + (size_t)(row0 + ai * 128 + m * 16) * FF + col0) = pack8(o);
            }
    }
};
struct EpiResAdd {
    static constexpr bool PERM = false, AFTER_DRAIN = false;
    float* X; const float* Xin; float s;
    __device__ __forceinline__ void operator()(const f32x4 (&acc)[2][2][4][2], const pg8::Unit& u, int wr, int wc, int fr, int fq) const {
        const int row0 = u.pm * 256 + wr * 64 + fr, col0 = u.pn * 256 + wc * 32 + 4 * fq;
#pragma unroll
        for (int ai = 0; ai < 2; ++ai)
#pragma unroll
            for (int m = 0; m < 4; ++m) {
                const size_t off = (size_t)(row0 + ai * 128 + m * 16) * D + col0;
#pragma unroll
                for (int bj = 0; bj < 2; ++bj)
#pragma unroll
                    for (int n = 0; n < 2; ++n) { const f32x4 r = *(const f32x4*)(Xin + off + bj * 128 + n * 16); *(f32x4*)(X + off + bj * 128 + n * 16) = r + acc[ai][bj][m][n] * s; }
            }
    }
};
struct EpiResAddAtomic {
    static constexpr bool PERM = false, AFTER_DRAIN = false;
    float* X; float s;
    __device__ __forceinline__ void operator()(const f32x4 (&acc)[2][2][4][2], const pg8::Unit& u, int wr, int wc, int fr, int fq) const {
        const int row0 = u.pm * 256 + wr * 64 + fr, col0 = (u.pn & 3) * 256 + wc * 32 + 4 * fq;
#pragma unroll
        for (int ai = 0; ai < 2; ++ai)
#pragma unroll
            for (int m = 0; m < 4; ++m) {
                float* rowp = X + (size_t)(row0 + ai * 128 + m * 16) * D + col0;
#pragma unroll
                for (int bj = 0; bj < 2; ++bj)
#pragma unroll
                    for (int n = 0; n < 2; ++n)
#pragma unroll
                        for (int j = 0; j < 4; ++j) __hip_atomic_fetch_add(rowp + bj * 128 + n * 16 + j, acc[ai][bj][m][n][j] * s, __ATOMIC_RELAXED, __HIP_MEMORY_SCOPE_AGENT);
            }
    }
};
struct EpiStore {
    static constexpr bool PERM = true, AFTER_DRAIN = false;
    bf16_t* O; int ldc, coff;
    __device__ __forceinline__ void operator()(const f32x4 (&acc)[2][2][4][2], const pg8::Unit& u, int wr, int wc, int fr, int fq) const {
        const int row0 = u.pm * 256 + wr * 64 + fr, col0 = coff + u.pn * 256 + wc * 32 + 8 * fq;
#pragma unroll
        for (int ai = 0; ai < 2; ++ai)
#pragma unroll
            for (int m = 0; m < 4; ++m) {
                bf16_t* rowp = O + (size_t)(row0 + ai * 128 + m * 16) * ldc + col0;
#pragma unroll
                for (int bj = 0; bj < 2; ++bj) {
                    u32x4 w; w.x = pk2(acc[ai][bj][m][0][0], acc[ai][bj][m][0][1]); w.y = pk2(acc[ai][bj][m][0][2], acc[ai][bj][m][0][3]);
                    w.z = pk2(acc[ai][bj][m][1][0], acc[ai][bj][m][1][1]); w.w = pk2(acc[ai][bj][m][1][2], acc[ai][bj][m][1][3]);
                    *(u32x4*)(rowp + bj * 128) = w;
                }
            }
    }
};
struct EpiMerge {
    static constexpr bool PERM = true, AFTER_DRAIN = false;
    bf16_t* Mb; const bf16_t* Z; int goff, first;
    __device__ __forceinline__ void operator()(const f32x4 (&acc)[2][2][4][2], const pg8::Unit& u, int wr, int wc, int fr, int fq) const {
        const int row0 = u.pm * 256 + wr * 64 + fr, col0 = u.pn * 256 + wc * 32 + 8 * fq;
#pragma unroll
        for (int ai = 0; ai < 2; ++ai)
#pragma unroll
            for (int m = 0; m < 4; ++m) {
                const size_t row = (size_t)(row0 + ai * 128 + m * 16);
#pragma unroll
                for (int bj = 0; bj < 2; ++bj) {
                    float gt[8], mv[8], o[8];
                    unpack8(*(const u32x4*)(Z + row * ZW + goff + col0 + bj * 128), gt);
                    if (!first) unpack8(*(const u32x4*)(Mb + row * D + col0 + bj * 128), mv);
#pragma unroll
                    for (int n = 0; n < 2; ++n)
#pragma unroll
                        for (int j = 0; j < 4; ++j) o[4 * n + j] = (first ? 0.f : mv[4 * n + j]) + sigmoidf_(gt[4 * n + j]) * acc[ai][bj][m][n][j];
                    *(u32x4*)(Mb + row * D + col0 + bj * 128) = pack8(o);
                }
            }
    }
};

template <class Epi>
__device__ __forceinline__ void run_gemm(const Ctx& c, const bf16_t* A, int lda, const bf16_t* Bt, int ldb, int M, int N, int K, int amod, int astride, const Epi& E) {
    pg8::Gemm g{A, lda, Bt, ldb, M, N, K, amod, astride, 0, 0};
    pg8::StaticOrder S; S.init(M, N, c.G, c.bid);
    pg8::gemm_phase<Epi, pg8::StaticOrder>(c.lds, g, S, E, c.tid);
    __syncthreads();
}

__device__ __forceinline__ void run_gemm_splitk(const Ctx& c, const bf16_t* A, int lda, const bf16_t* Bt, int ldb, int K, float* X, float sc) {
    pg8::Gemm g{A, lda, Bt, ldb, 256, 1024 * (K / 256), 256, 0, 0, 4, 256};
    pg8::StaticOrder S; S.init(256, 1024 * (K / 256), c.G, (c.bid + 128) % c.G);
    pg8::gemm_phase<EpiResAddAtomic, pg8::StaticOrder>(c.lds, g, S, EpiResAddAtomic{X, sc}, c.tid);
    __syncthreads();
}

__device__ __forceinline__ void phase_cvt(const Ctx& c, int l) {
    bf16_t* W = (bf16_t*)wsg(c);
    const int cum[11] = {0, 1408, 2112, 3520, 4224, 6336, 7104, 7232, 7424, 8192, 8448};
    const int tid = c.tid;
    for (int t0 = c.bid * 4; t0 < 8448; t0 += c.G * 4) {
        bf16_t* dsts[4]; int ldds[4]; bool nz[4];
#pragma unroll
        for (int u = 0; u < 4; ++u) {
            const int t = t0 + u;
            int job = 0, base = 0;
#pragma unroll
            for (int j = 1; j < 10; ++j) if (t >= cum[j]) { job = j; base = cum[j]; }
            const int tt = t - base;
            const float* src = nullptr; int ld = 0; bf16_t* dst = nullptr; int ldd = 0;
            if (job == 0 || job == 2) {
                const int tn = tt >> 4, tk = tt & 15, n0 = tn * 64, k0 = tk * 64, pn = n0 >> 8, bj = (n0 >> 7) & 1, cc = n0 & 127;
                const float* g = inp(c, job == 0 ? I_F1G : I_F2G); const float* up = inp(c, job == 0 ? I_F1U : I_F2U);
                src = (bj ? up : g) + (size_t)l * D * FF + (size_t)k0 * FF + 128 * pn + cc; ld = FF;
                dst = W + (job == 0 ? W_GU1 : W_GU2) / 2 + (size_t)n0 * D + k0; ldd = D;
            } else if (job == 1 || job == 3) {
                const int tn = tt / 44, tk = tt % 44, n0 = tn * 64, k0 = tk * 64;
                src = inp(c, job == 1 ? I_F1D : I_F2D) + (size_t)l * FF * D + (size_t)k0 * D + n0; ld = D;
                dst = W + (job == 1 ? W_D1 : W_D2) / 2 + (size_t)n0 * FF + k0; ldd = FF;
            } else if (job == 4) {
                const int tn = tt >> 4, tk = tt & 15, n0 = tn * 64, k0 = tk * 64, col = n0 < 5120 ? n0 : n0 + 8;
                src = inp(c, I_WIN) + (size_t)l * D * INW + (size_t)k0 * INW + col; ld = INW;
                dst = W + W_IN / 2 + (size_t)n0 * D + k0; ldd = D;
            } else if (job == 5) {
                const int tn = tt >> 4, tk = tt & 15, n0 = tn * 64, k0 = tk * 64;
                src = inp(c, I_WIN) + (size_t)l * D * INW + (size_t)k0 * INW + 8456 + n0; ld = INW;
                dst = W + W_G / 2 + (size_t)n0 * D + k0; ldd = D;
            } else if (job == 6) {
                const int tn = tt >> 2, tk = tt & 3, n0 = tn * 64, k0 = tk * 64, which = n0 >> 10, nn = n0 & 1023, blk = nn >> 7, j0 = nn & 127, kblk = k0 >> 7, i0 = k0 & 127;
                if (kblk == (blk & 1)) { src = inp(c, which ? I_LWX : I_LWA) + (size_t)l * 8 * 128 * 128 + (size_t)blk * 128 * 128 + (size_t)i0 * 128 + j0; ld = 128; }
                dst = W + W_LRU / 2 + (size_t)n0 * 256 + k0; ldd = 256;
            } else if (job == 7) {
                const int tn = tt >> 2, tk = tt & 3, n0 = tn * 64, k0 = tk * 64;
                if (n0 < 1024) { if (tk == 0) { src = inp(c, I_W2) + (size_t)l * 64 * D + n0; ld = D; } }
                else if (n0 < 2048) { if (tk == 1) { src = inp(c, I_A2) + (size_t)l * 64 * D + (n0 - 1024); ld = D; } }
                else { if (tk >= 2) { src = inp(c, I_G2) + (size_t)l * 128 * D + (size_t)(k0 - 128) * D + (n0 - 2048); ld = D; } }
                dst = W + W_LORA / 2 + (size_t)n0 * 256 + k0; ldd = 256;
            } else if (job == 8) {
                const int tn = tt >> 4, tk = tt & 15, n0 = tn * 64, k0 = tk * 64, b = n0 >> 10, nn = n0 & 1023;
                src = inp(c, I_WBR) + (size_t)l * 3 * D * D + (size_t)b * D * D + (size_t)k0 * D + nn; ld = D;
                dst = W + W_BR / 2 + (size_t)n0 * D + k0; ldd = D;
            } else {
                const int tn = tt >> 4, tk = tt & 15, n0 = tn * 64, k0 = tk * 64;
                src = inp(c, I_WOUT) + (size_t)l * D * D + (size_t)k0 * D + n0; ld = D;
                dst = W + W_OUT / 2 + (size_t)n0 * D + k0; ldd = D;
            }

            dsts[u] = dst; ldds[u] = ldd; nz[u] = (src != nullptr);
            LAS float* tile = (LAS float*)c.lds + u * (64 * 65);
            if (src) {
                const int i = tid >> 4, j4 = tid & 15;
#pragma unroll
                for (int r = 0; r < 2; ++r) { const int k = i + 32 * r; const f32x4 v = *(const f32x4*)(src + (size_t)k * ld + 4 * j4);
                    tile[k * 65 + 4 * j4 + 0] = v[0]; tile[k * 65 + 4 * j4 + 1] = v[1]; tile[k * 65 + 4 * j4 + 2] = v[2]; tile[k * 65 + 4 * j4 + 3] = v[3]; }
            }
        }
        __syncthreads();
#pragma unroll
        for (int u = 0; u < 4; ++u) {
            const LAS float* tile = (const LAS float*)c.lds + u * (64 * 65);
            const int n = tid >> 3, kq = tid & 7; float f[8];
#pragma unroll
            for (int e = 0; e < 8; ++e) f[e] = nz[u] ? tile[(8 * kq + e) * 65 + n] : 0.f;
            *(u32x4*)(dsts[u] + (size_t)n * ldds[u] + 8 * kq) = pack8(f);
        }
        __syncthreads();
    }
    float* wif = (float*)(wsg(c) + W_IF);
    for (int i = c.bid * NTHREADS + c.tid; i < D * 8; i += c.G * NTHREADS) wif[i] = inp(c, I_WIN)[(size_t)l * D * INW + (size_t)(i >> 3) * INW + 5120 + (i & 7)];
}

__device__ __forceinline__ void phase_norm(const Ctx& c, const float* xin_p, const float* xin_s, float* X, int grow0, int nrows, const float* gamma, bf16_t* dst, const float* wif, float* gif) {
    const int lane = c.lane;
    f32x4 gm[4];
#pragma unroll
    for (int i = 0; i < 4; ++i) gm[i] = *(const f32x4*)(gamma + 256 * i + 4 * lane);
    for (int r = c.bid * 8 + c.wave; r < nrows; r += c.G * 8) {
        const int gr = grow0 + r;
        const float* src = xin_p ? (gr < NPROMPT ? xin_p + (size_t)gr * D : xin_s + (size_t)(gr - NPROMPT) * D) : X + (size_t)gr * D;
        f32x4 v[4]; float ss = 0.f;
#pragma unroll
        for (int i = 0; i < 4; ++i) { v[i] = *(const f32x4*)(src + 256 * i + 4 * lane); ss += v[i][0] * v[i][0] + v[i][1] * v[i][1] + v[i][2] * v[i][2] + v[i][3] * v[i][3]; }
        if (xin_p && gr >= NPROMPT) {
#pragma unroll
            for (int i = 0; i < 4; ++i) *(f32x4*)(X + (size_t)gr * D + 256 * i + 4 * lane) = v[i];
        }
        ss = wsum(ss);
        const float rstd = __builtin_amdgcn_rsqf(ss * (1.0f / D) + 1e-6f);
#pragma unroll
        for (int i = 0; i < 4; ++i) {
            v[i] = v[i] * rstd * gm[i];
            u32x2 w; w.x = pk2(v[i][0], v[i][1]); w.y = pk2(v[i][2], v[i][3]);
            *(u32x2*)(dst + (size_t)r * D + 256 * i + 4 * lane) = w;
        }
        if (gif) {
            float a8[8];
#pragma unroll
            for (int j = 0; j < 8; ++j) a8[j] = 0.f;
#pragma unroll
            for (int i = 0; i < 4; ++i)
#pragma unroll
                for (int e = 0; e < 4; ++e) {
                    const float* wp = wif + (size_t)(256 * i + 4 * lane + e) * 8; const f32x4 w0 = *(const f32x4*)wp, w1 = *(const f32x4*)(wp + 4);
                    a8[0] += v[i][e] * w0[0]; a8[1] += v[i][e] * w0[1]; a8[2] += v[i][e] * w0[2]; a8[3] += v[i][e] * w0[3];
                    a8[4] += v[i][e] * w1[0]; a8[5] += v[i][e] * w1[1]; a8[6] += v[i][e] * w1[2]; a8[7] += v[i][e] * w1[3];
                }
#pragma unroll
            for (int j = 0; j < 8; ++j) a8[j] = wsum(a8[j]);
            if (lane == 0) {
#pragma unroll
                for (int j = 0; j < 8; ++j) gif[(size_t)r * 8 + j] = a8[j];
            }
        }
    }
}
__device__ __forceinline__ void phase_final_norm(const Ctx& c, float* X, const float* gamma) {
    const int lane = c.lane;
    f32x4 gm[4];
#pragma unroll
    for (int i = 0; i < 4; ++i) gm[i] = *(const f32x4*)(gamma + 256 * i + 4 * lane);
    for (int r = c.bid * 8 + c.wave; r < NTOK; r += c.G * 8) {
        f32x4 v[4]; float ss = 0.f;
#pragma unroll
        for (int i = 0; i < 4; ++i) { v[i] = *(const f32x4*)(X + (size_t)r * D + 256 * i + 4 * lane); ss += v[i][0] * v[i][0] + v[i][1] * v[i][1] + v[i][2] * v[i][2] + v[i][3] * v[i][3]; }
        ss = wsum(ss);
        const float rstd = __builtin_amdgcn_rsqf(ss * (1.0f / D) + 1e-6f);
#pragma unroll
        for (int i = 0; i < 4; ++i) *(f32x4*)(X + (size_t)r * D + 256 * i + 4 * lane) = v[i] * rstd * gm[i];
    }
}

__device__ __forceinline__ void phase_cv1(const Ctx& c, int p, int l) {
    const bf16_t* Z = (const bf16_t*)(wsg(c) + WS_Z); bf16_t* H = (bf16_t*)(wsg(c) + WS_HALO);
    const int nseg = pass_nseg(p), gt = c.bid * NTHREADS + c.tid, gs = c.G * NTHREADS;
    for (int i = gt; i < nseg * 3168; i += gs) {
        const int s = i / 3168, pc = i % 3168, r = pc / 1056, cc = pc % 1056; const Seg g = seg_of(s);
        *(u32x4*)(H + ((size_t)s * 3 + r) * ZW + 8 * cc) = *(const u32x4*)(Z + (size_t)(g.row0 + g.n - 3 + r) * ZW + 8 * cc);
    }
    const int nseq = pass_nseq(p);
    for (int i = gt; i < nseq * 12544; i += gs) {
        const int q = i / 12544, e = i % 12544; const Seq sq = seq_of(p, q);
        if (e < 9216) { const int r = e / 3072, ch = e % 3072;
            float* o = outg(c) + (sq.sample ? O_SCONV + ((size_t)l * DB + sq.b) * 9216 : O_PCONV + ((size_t)l * NB + sq.b) * 9216);
            o[e] = bf2f(Z[(size_t)(sq.row0 + sq.T - 3 + r) * ZW + ch]);
        } else { const int j = e - 9216;
            float* o = outg(c) + (sq.sample ? O_SSH + ((size_t)l * DB + sq.b) * RIN : O_PSH + ((size_t)l * NB + sq.b) * RIN);
            o[j] = bf2f(Z[(size_t)(sq.row0 + sq.T - 1) * ZW + C_R + j]);
        }
    }
}
__device__ __forceinline__ void phase_cv2(const Ctx& c, int p, int l) {
    bf16_t* Z = (bf16_t*)(wsg(c) + WS_Z); const bf16_t* H = (const bf16_t*)(wsg(c) + WS_HALO);
    const int nseg = pass_nseg(p), gt = c.bid * NTHREADS + c.tid, gs = c.G * NTHREADS;
    for (int i = gt; i < nseg * 800; i += gs) {
        const int s = i / 800, cgp = i % 800; const Seg g = seg_of(s); const Seq sq = seq_of(p, g.q);
        if (cgp < 384) {
            const int col = 8 * cgp;
            float p0[8], p1[8], p2[8], w0[8], w1[8], w2[8], w3[8], bb[8];
            const float* cw = inp(c, I_CONVW) + (size_t)l * 4 * CONVCH + col; const float* cb = inp(c, I_CONVB) + (size_t)l * CONVCH + col;
#pragma unroll
            for (int j = 0; j < 8; ++j) { w0[j] = cw[j]; w1[j] = cw[CONVCH + j]; w2[j] = cw[2 * CONVCH + j]; w3[j] = cw[3 * CONVCH + j]; bb[j] = cb[j]; }
            if (g.c > 0) { unpack8(*(const u32x4*)(H + ((size_t)(s - 1) * 3 + 0) * ZW + col), p0); unpack8(*(const u32x4*)(H + ((size_t)(s - 1) * 3 + 1) * ZW + col), p1); unpack8(*(const u32x4*)(H + ((size_t)(s - 1) * 3 + 2) * ZW + col), p2); }
            else if (sq.sample) { const float* st = inp(c, I_SCONV) + ((size_t)l * DB + sq.b) * 3 * CONVCH + col;
#pragma unroll
                for (int j = 0; j < 8; ++j) { p0[j] = st[j]; p1[j] = st[CONVCH + j]; p2[j] = st[2 * CONVCH + j]; } }
            else {
#pragma unroll
                for (int j = 0; j < 8; ++j) { p0[j] = 0.f; p1[j] = 0.f; p2[j] = 0.f; } }
            const int mode = col < 1024 ? 0 : (col < 2048 ? 1 : 2);
            for (int t4 = 0; t4 < g.n; t4 += 4) {
                u32x4 raw[4];
#pragma unroll
                for (int u = 0; u < 4; ++u) raw[u] = *(const u32x4*)(Z + (size_t)(g.row0 + t4 + u) * ZW + col);
#pragma unroll
                for (int u = 0; u < 4; ++u) {
                    bf16_t* zp = Z + (size_t)(g.row0 + t4 + u) * ZW + col; float x[8], y[8];
                    unpack8(raw[u], x);
#pragma unroll
                    for (int j = 0; j < 8; ++j) { float v = bb[j] + p0[j] * w0[j]; v += p1[j] * w1[j]; v += p2[j] * w2[j]; v += x[j] * w3[j];
                        if (mode == 1) v = siluf_(v); else if (mode == 2) v = siluf_(v) * 0.0625f;
                        y[j] = v; p0[j] = p1[j]; p1[j] = p2[j]; p2[j] = x[j]; }
                    *(u32x4*)zp = pack8(y);
                }
            }
        } else {
            const int j0 = 8 * (cgp - 384), col = C_R + j0;
            float pv[8], mu[8];
            const float* mp = inp(c, I_MU) + (size_t)l * RIN + j0;
#pragma unroll
            for (int j = 0; j < 8; ++j) mu[j] = mp[j];
            if (g.c > 0) unpack8(*(const u32x4*)(H + ((size_t)(s - 1) * 3 + 2) * ZW + col), pv);
            else if (sq.sample) { const float* st = inp(c, I_SSH) + ((size_t)l * DB + sq.b) * RIN + j0;
#pragma unroll
                for (int j = 0; j < 8; ++j) pv[j] = st[j]; }
            else {
#pragma unroll
                for (int j = 0; j < 8; ++j) pv[j] = 0.f; }
            const int mode = (j0 >= 3072 && j0 < 3136) ? 1 : (j0 >= 3200 ? 2 : 0);
            for (int t4 = 0; t4 < g.n; t4 += 4) {
                u32x4 raw[4];
#pragma unroll
                for (int u = 0; u < 4; ++u) raw[u] = *(const u32x4*)(Z + (size_t)(g.row0 + t4 + u) * ZW + col);
#pragma unroll
                for (int u = 0; u < 4; ++u) {
                    bf16_t* zp = Z + (size_t)(g.row0 + t4 + u) * ZW + col; float x[8], y[8];
                    unpack8(raw[u], x);
#pragma unroll
                    for (int j = 0; j < 8; ++j) { float v = x[j] + (pv[j] - x[j]) * mu[j];
                        if (mode == 1) v = tanhf_(v); else if (mode == 2) v = sigmoidf_(v);
                        y[j] = v; pv[j] = x[j]; }
                    *(u32x4*)zp = pack8(y);
                }
            }
        }
    }
}

template <int FINAL>
__device__ __forceinline__ void phase_lru(const Ctx& c, int p, int l) {
    bf16_t* Z = (bf16_t*)(wsg(c) + WS_Z); const bf16_t* T = (const bf16_t*)(wsg(c) + WS_T); float* car = (float*)(wsg(c) + WS_CAR);
    const int nseg = pass_nseg(p), gt = c.bid * NTHREADS + c.tid, gs = c.G * NTHREADS;
    for (int i = gt; i < nseg * 128; i += gs) {
        const int s = i >> 7, ch = 8 * (i & 127); const Seg g = seg_of(s); const Seq sq = seq_of(p, g.q);
        float ba[8], bx[8], c1[8], A[8], B[8];
#pragma unroll
        for (int j = 0; j < 8; ++j) { ba[j] = inp(c, I_LBA)[(size_t)l * D + ch + j]; bx[j] = inp(c, I_LBX)[(size_t)l * D + ch + j]; c1[j] = -8.0f * softplusf_(-inp(c, I_LLAM)[(size_t)l * D + ch + j]); A[j] = 1.f; B[j] = 0.f; }
        if (FINAL) {
            if (sq.sample) {
#pragma unroll
                for (int j = 0; j < 8; ++j) B[j] = inp(c, I_SLRU)[((size_t)l * DB + sq.b) * D + ch + j]; }
            for (int cp = 0; cp < g.c; ++cp) { const float* ca = car + (size_t)(s - g.c + cp) * 2048 + ch;
#pragma unroll
                for (int j = 0; j < 8; ++j) B[j] = ca[j] * B[j] + ca[1024 + j]; }
        }
        for (int t4 = 0; t4 < g.n; t4 += 4) {
          u32x4 rx[4], rr[4], ri[4];
#pragma unroll
          for (int u = 0; u < 4; ++u) { const size_t row = (size_t)(g.row0 + t4 + u); rx[u] = *(const u32x4*)(Z + row * ZW + C_LRU + ch); rr[u] = *(const u32x4*)(T + row * 2048 + ch); ri[u] = *(const u32x4*)(T + row * 2048 + 1024 + ch); }
#pragma unroll
          for (int u = 0; u < 4; ++u) {
            const size_t row = (size_t)(g.row0 + t4 + u); float x[8], rp[8], ip[8];
            unpack8(rx[u], x); unpack8(rr[u], rp); unpack8(ri[u], ip);
#pragma unroll
            for (int j = 0; j < 8; ++j) { const float la = c1[j] * sigmoidf_(rp[j] + ba[j]), a = __expf(la), bt = __builtin_amdgcn_sqrtf(fmaxf(1.0f - __expf(2.0f * la), 0.f)) * sigmoidf_(ip[j] + bx[j]) * x[j];
                B[j] = a * B[j] + bt; A[j] *= a; x[j] = B[j]; }
            if (FINAL) *(u32x4*)(Z + row * ZW + C_LRU + ch) = pack8(x);
          }
        }
        if (!FINAL) { float* ca = car + (size_t)s * 2048 + ch;
#pragma unroll
            for (int j = 0; j < 8; ++j) { ca[j] = A[j]; ca[1024 + j] = B[j]; } }
        else if (g.c == g.nch - 1) { float* o = outg(c) + (sq.sample ? O_SLRU + ((size_t)l * DB + sq.b) * D : O_PLRU + ((size_t)l * NB + sq.b) * D) + ch;
#pragma unroll
            for (int j = 0; j < 8; ++j) o[j] = B[j]; }
    }
}

__device__ __forceinline__ f32x4 mma_tile(const LAS bf16_t* A, int lda, const LAS bf16_t* Bt, int ldb, int K, f32x4 acc, int lane) {
    const LAS bf16_t* pa = A + (lane & 15) * lda + (lane >> 4) * 8; const LAS bf16_t* pb = Bt + (lane & 15) * ldb + (lane >> 4) * 8;
    for (int k = 0; k < K; k += 32) { const bf16x8 a = *(const LAS bf16x8*)(pa + k); const bf16x8 b = *(const LAS bf16x8*)(pb + k); acc = __builtin_amdgcn_mfma_f32_16x16x32_bf16(a, b, acc, 0, 0, 0); }
    return acc;
}

__device__ __forceinline__ void phase_mlstm_s(const Ctx& c, int p, int l) {
    const bf16_t* Z = (const bf16_t*)(wsg(c) + WS_Z); const float* gif = (const float*)(wsg(c) + WS_GIF); bf16_t* SL = (bf16_t*)(wsg(c) + WS_SL);
    int tid = c.tid, lane = c.lane; const int w = c.wave;
    const int nitems = p ? 1088 : 1024;
    for (int item = c.bid; item < nitems; item += c.G) {
        asm volatile("" : "+v"(tid), "+v"(lane));
        LAS unsigned char* L = c.lds; asm volatile("" : "+v"(L));
        LAS bf16_t* Qs = (LAS bf16_t*)(L); LAS bf16_t* Ks = (LAS bf16_t*)(L + 33792); LAS bf16_t* St = (LAS bf16_t*)(L + 67584);
        LAS float* bcum = (LAS float*)(L + 76800); LAS float* igs = bcum + 64; LAS float* mloc = bcum + 128;
        int q, h, rbase, nvalid;
        if (item < 1024) { q = item >> 9; h = (item >> 7) & 3; rbase = q * SEQ + (item & 127) * 64; nvalid = 64; }
        else { const int sid = item - 1024; q = 2 + (sid >> 2); h = sid & 3; rbase = 16384 + (sid >> 2) * DSEQ; nvalid = DSEQ; }
        const float bi = inp(c, I_IFB)[l * 8 + h], bf = inp(c, I_IFB)[l * 8 + 4 + h];
#pragma unroll
        for (int i = 0; i < 4; ++i) {
            const int piece = tid + 512 * i, t = piece >> 5, pc = piece & 31; u32x4 qv = {0u, 0u, 0u, 0u}, kv = {0u, 0u, 0u, 0u};
            if (t < nvalid) { qv = *(const u32x4*)(Z + (size_t)(rbase + t) * ZW + C_Q + 256 * h + 8 * pc); kv = *(const u32x4*)(Z + (size_t)(rbase + t) * ZW + C_K + 256 * h + 8 * pc); }
            *(LAS u32x4*)(Qs + t * 264 + 8 * pc) = qv; *(LAS u32x4*)(Ks + t * 264 + 8 * pc) = kv;
        }
        if (w == 0) {
            const int t = lane; float ig = -1e30f, lf = 0.f;
            if (t < nvalid) { ig = gif[(size_t)(rbase + t) * 8 + h] + bi; const float gf = gif[(size_t)(rbase + t) * 8 + 4 + h] + bf; lf = fminf(gf, 0.f) - __logf(1.0f + __expf(-fabsf(gf))); }
            float bc = lf;
#pragma unroll
            for (int o = 1; o < 64; o <<= 1) { const float u = __shfl_up(bc, o); if (lane >= o) bc += u; }
            float cm = ig - bc;
#pragma unroll
            for (int o = 1; o < 64; o <<= 1) { const float u = __shfl_up(cm, o); if (lane >= o) cm = fmaxf(cm, u); }
            bcum[t] = bc; igs[t] = ig; mloc[t] = bc + cm;
        }
        __syncthreads();
        const int ti = w >> 1;
#pragma unroll
        for (int e = 0; e < 2; ++e) {
            const int sj = (w & 1) * 2 + e;
            f32x4 a = {0.f, 0.f, 0.f, 0.f};
            a = mma_tile(Qs + 16 * ti * 264, 264, Ks + 16 * sj * 264, 264, 256, a, lane);
#pragma unroll
            for (int r = 0; r < 4; ++r) {
                const int t = 16 * ti + (lane >> 4) * 4 + r, s2 = 16 * sj + (lane & 15);
                const float wg = (s2 <= t && t < nvalid) ? __expf(bcum[t] - bcum[s2] + igs[s2] - mloc[t]) : 0.f;
                St[t * 72 + s2] = f2bf(a[r] * wg);
            }
        }
        __syncthreads();
        { const int row = tid >> 3, pc = tid & 7; *(u32x4*)(SL + (size_t)item * 4096 + row * 64 + 8 * pc) = *(const LAS u32x4*)(St + row * 72 + 8 * pc); }
        __syncthreads();
    }
}

__device__ __forceinline__ void mlstm_task(const Ctx& c, int p, int l, int q, int h, int slab) {
    bf16_t* Z = (bf16_t*)(wsg(c) + WS_Z); const float* gif = (const float*)(wsg(c) + WS_GIF);
    const bf16_t* SLp = (const bf16_t*)(wsg(c) + WS_SL) + (size_t)(q < 2 ? q * 512 + h * 128 : 1024 + (q - 2) * 4 + h) * 4096 + (c.tid >> 3) * 64 + 8 * (c.tid & 7);
    const Seq sq = seq_of(p, q); const int tid = c.tid, lane = c.lane, w = c.wave;
    LAS bf16_t* Qs = (LAS bf16_t*)(c.lds); LAS bf16_t* Ks = (LAS bf16_t*)(c.lds + 33792); LAS bf16_t* KT = (LAS bf16_t*)(c.lds + 67584); LAS bf16_t* VT = (LAS bf16_t*)(c.lds + 104448);
    LAS bf16_t* VgT = (LAS bf16_t*)(c.lds + 109200); LAS bf16_t* Cs = (LAS bf16_t*)(c.lds + 113952); LAS bf16_t* St = (LAS bf16_t*)(c.lds + 131376);
    LAS float* sc = (LAS float*)(c.lds + 140592);
    LAS float* bcum = sc; LAS float* igs = sc + 64; LAS float* mts = sc + 128; LAS float* wint = sc + 192; LAS float* gsrc = sc + 256; LAS float* dd = sc + 320; LAS float* misc = sc + 384; LAS float* esc = sc + 392;
    const int nvalid = sq.sample ? DSEQ : 64, nch = sq.sample ? 1 : SEQ / 64;
    const float bi = inp(c, I_IFB)[l * 8 + h], bf = inp(c, I_IFB)[l * 8 + 4 + h];
    f32x4 cacc[3][2];
#pragma unroll
    for (int vi = 0; vi < 3; ++vi)
#pragma unroll
        for (int e = 0; e < 2; ++e)
#pragma unroll
            for (int r = 0; r < 4; ++r) {
                const int vloc = 16 * vi + (lane >> 4) * 4 + r, d = 16 * (2 * w + e) + (lane & 15); float v0 = 0.f;
                if (sq.sample) { if (vloc < 32) v0 = inp(c, I_SMC)[(((size_t)l * DB + sq.b) * 4 + h) * 65536 + (size_t)(slab * 32 + vloc) * 256 + d];
                                 else if (vloc == 32) v0 = inp(c, I_SMN)[(((size_t)l * DB + sq.b) * 4 + h) * 256 + d]; }
                cacc[vi][e][r] = v0;
            }
    if (tid < 64) VT[32 * 72 + tid] = (bf16_t)0x3f80u;
    if (tid == 0) misc[0] = sq.sample ? inp(c, I_SMM)[((size_t)l * DB + sq.b) * 4 + h] : 0.f;
    unsigned zz = 0u; asm volatile("" : "+v"(zz)); const u32x4 zv = {zz, zz, zz, zz};
    u32x4 pq[4], pk[4], pvv = zv, psl = zv; float pgi = 0.f, pgf = 0.f; int pfc = 0;
#define ML_PREFETCH(RB) do { psl = *(const u32x4*)(SLp + (size_t)pfc * 4096); ++pfc; \
        _Pragma("unroll") for (int i = 0; i < 4; ++i) { const int piece = tid + 512 * i, t = piece >> 5, pc = piece & 31; pq[i] = zv; pk[i] = zv; \
            if (t < nvalid) { pq[i] = *(const u32x4*)(Z + (size_t)((RB) + t) * ZW + C_Q + 256 * h + 8 * pc); pk[i] = *(const u32x4*)(Z + (size_t)((RB) + t) * ZW + C_K + 256 * h + 8 * pc); } } \
        if (tid < 256) { const int t = tid >> 2, pc = tid & 3; pvv = zv; if (t < nvalid) pvv = *(const u32x4*)(Z + (size_t)((RB) + t) * ZW + C_V + 256 * h + slab * 32 + 8 * pc); } \
        if (w == 0 && lane < nvalid) { pgi = gif[(size_t)((RB) + lane) * 8 + h]; pgf = gif[(size_t)((RB) + lane) * 8 + 4 + h]; } } while (0)
    ML_PREFETCH(sq.row0);
    __syncthreads();
    for (int ck = 0; ck < nch; ++ck) {
        const int rbase = sq.row0 + ck * 64;
#pragma unroll
        for (int i = 0; i < 4; ++i) {
            const int piece = tid + 512 * i, t = piece >> 5, pc = piece & 31;
            *(LAS u32x4*)(Qs + t * 264 + 8 * pc) = pq[i]; *(LAS u32x4*)(Ks + t * 264 + 8 * pc) = pk[i];
        }
        *(LAS u32x4*)(St + (tid >> 3) * 72 + 8 * (tid & 7)) = psl;
        if (tid < 256) {
            const int t = tid >> 2, pc = tid & 3; const u32x4 vv = pvv;
            const unsigned vw[4] = {vv.x, vv.y, vv.z, vv.w};
#pragma unroll
            for (int e = 0; e < 4; ++e) { VT[(8 * pc + 2 * e) * 72 + t] = (bf16_t)(vw[e] & 0xffffu); VT[(8 * pc + 2 * e + 1) * 72 + t] = (bf16_t)(vw[e] >> 16); }
        }
        if (w == 0) {
            const int t = lane; float ig = -1e30f, lf = 0.f;
            if (t < nvalid) { ig = pgi + bi; const float gf = pgf + bf; lf = fminf(gf, 0.f) - __logf(1.0f + __expf(-fabsf(gf))); }
            float bc = lf;
#pragma unroll
            for (int o = 1; o < 64; o <<= 1) { const float u = __shfl_up(bc, o); if (lane >= o) bc += u; }
            float cm = ig - bc;
#pragma unroll
            for (int o = 1; o < 64; o <<= 1) { const float u = __shfl_up(cm, o); if (lane >= o) cm = fmaxf(cm, u); }
            const float mprev = misc[0];
            const float mt = bc + fmaxf(mprev, cm);
            const float wi = __expf(bc + mprev - mt);
            const float bL = __shfl(bc, 63), mnew = __shfl(mt, 63);
            const float gs_ = __expf(bL - bc + ig - mnew);
            mts[t] = mt; wint[t] = wi; gsrc[t] = gs_; VgT[32 * 72 + t] = f2bf(gs_); esc[t] = __expf(cm - fmaxf(mprev, cm));
            if (lane == 0) { misc[1] = __expf(bL + mprev - mnew); misc[2] = mnew; }
        }
#pragma unroll
        for (int vi = 0; vi < 3; ++vi)
#pragma unroll
            for (int e = 0; e < 2; ++e)
#pragma unroll
                for (int r = 0; r < 4; ++r) { const int vloc = 16 * vi + (lane >> 4) * 4 + r; if (vloc <= 32) Cs[vloc * 264 + 16 * (2 * w + e) + (lane & 15)] = f2bf(cacc[vi][e][r]); }
        __syncthreads();
        if (ck + 1 < nch) ML_PREFETCH(rbase + 64);
#pragma unroll
        for (int i = 0; i < 2; ++i) {
            const int idx = tid + 512 * i, dp = idx & 127, so = idx >> 7; unsigned wv[8];
#pragma unroll
            for (int e = 0; e < 8; ++e) wv[e] = *(const LAS unsigned*)(Ks + (8 * so + e) * 264 + 2 * dp);
            u32x4 lo, hi;
            lo.x = (wv[0] & 0xffffu) | (wv[1] << 16); lo.y = (wv[2] & 0xffffu) | (wv[3] << 16); lo.z = (wv[4] & 0xffffu) | (wv[5] << 16); lo.w = (wv[6] & 0xffffu) | (wv[7] << 16);
            hi.x = (wv[0] >> 16) | (wv[1] & 0xffff0000u); hi.y = (wv[2] >> 16) | (wv[3] & 0xffff0000u); hi.z = (wv[4] >> 16) | (wv[5] & 0xffff0000u); hi.w = (wv[6] >> 16) | (wv[7] & 0xffff0000u);
            *(LAS u32x4*)(KT + (2 * dp) * 72 + 8 * so) = lo; *(LAS u32x4*)(KT + (2 * dp + 1) * 72 + 8 * so) = hi;
        }
#pragma unroll
        for (int i = 0; i < 4; ++i) { const int idx = tid + 512 * i, v = idx >> 6, s2 = idx & 63; VgT[v * 72 + s2] = f2bf(bf2f(VT[v * 72 + s2]) * gsrc[s2]); }
        const int ti = w >> 1;
        const int vj = w & 1;
        f32x4 qc = {0.f, 0.f, 0.f, 0.f}, qc2 = {0.f, 0.f, 0.f, 0.f};
        qc = mma_tile(Qs + 16 * ti * 264, 264, Cs + 16 * vj * 264, 264, 256, qc, lane);
        if (w < 4) qc2 = mma_tile(Qs + 16 * w * 264, 264, Cs + 32 * 264, 264, 256, qc2, lane);
        __syncthreads();
        f32x4 num = {0.f, 0.f, 0.f, 0.f};
        num = mma_tile(St + 16 * ti * 72, 72, VT + 16 * vj * 72, 72, 64, num, lane);
#pragma unroll
        for (int r = 0; r < 4; ++r) { const int t = 16 * ti + (lane >> 4) * 4 + r; num[r] = qc[r] * wint[t] + esc[t] * num[r]; }
        if (w < 4) {
            f32x4 sv2 = {0.f, 0.f, 0.f, 0.f};
            sv2 = mma_tile(St + 16 * w * 72, 72, VT + 32 * 72, 72, 64, sv2, lane);
#pragma unroll
            for (int r = 0; r < 4; ++r) { const int t = 16 * w + (lane >> 4) * 4 + r; qc2[r] = qc2[r] * wint[t] + esc[t] * sv2[r]; }
            if ((lane & 15) == 0) {
#pragma unroll
                for (int r = 0; r < 4; ++r) { const int t = 16 * w + (lane >> 4) * 4 + r; dd[t] = fmaxf(fabsf(qc2[r]), __expf(-mts[t])); }
            }
        }
        __syncthreads();
#pragma unroll
        for (int r = 0; r < 4; ++r) {
            const int t = 16 * ti + (lane >> 4) * 4 + r;
            if (t < nvalid) Z[(size_t)(rbase + t) * ZW + C_V + 256 * h + slab * 32 + 16 * vj + (lane & 15)] = f2bf(num[r] * __builtin_amdgcn_rcpf(dd[t]));
        }
        const float gs = misc[1];
#pragma unroll
        for (int vi = 0; vi < 3; ++vi)
#pragma unroll
            for (int e = 0; e < 2; ++e) { cacc[vi][e] = cacc[vi][e] * gs; cacc[vi][e] = mma_tile(VgT + 16 * vi * 72, 72, KT + 16 * (2 * w + e) * 72, 72, 64, cacc[vi][e], lane); }
        if (tid == 0) misc[0] = misc[2];
        __syncthreads();
    }
#undef ML_PREFETCH
    float* oc = outg(c) + (sq.sample ? O_SMC + (((size_t)l * DB + sq.b) * 4 + h) * 65536 : O_PMC + (((size_t)l * NB + sq.b) * 4 + h) * 65536);
#pragma unroll
    for (int vi = 0; vi < 2; ++vi)
#pragma unroll
        for (int e = 0; e < 2; ++e)
#pragma unroll
            for (int r = 0; r < 4; ++r) oc[(size_t)(slab * 32 + 16 * vi + (lane >> 4) * 4 + r) * 256 + 16 * (2 * w + e) + (lane & 15)] = cacc[vi][e][r];
    if (slab == 0) {
        if (lane < 16) {
            float* on = outg(c) + (sq.sample ? O_SMN + (((size_t)l * DB + sq.b) * 4 + h) * 256 : O_PMN + (((size_t)l * NB + sq.b) * 4 + h) * 256);
#pragma unroll
            for (int e = 0; e < 2; ++e) on[16 * (2 * w + e) + lane] = cacc[2][e][0];
        }
        if (tid == 0) outg(c)[(sq.sample ? O_SMM + ((size_t)l * DB + sq.b) * 4 + h : O_PMM + ((size_t)l * NB + sq.b) * 4 + h)] = misc[0];
    }
    __syncthreads();
}

constexpr int RS = 72;
__device__ __forceinline__ void rwkv_apply_tiles(int w, int lane, const LAS bf16_t* S0b, const LAS bf16_t* GTs, const LAS bf16_t* QTs, const LAS bf16_t* Hs, const LAS bf16_t* YHTs, LAS float* yT, f32x4 (&sacc)[4]) {
    if (w < 4) {
#pragma unroll
        for (int b = 0; b < 4; ++b) {
            f32x4 a = {0.f, 0.f, 0.f, 0.f};
            a = mma_tile(S0b + 16 * w * RS, RS, GTs + 16 * b * RS, RS, 64, a, lane);
#pragma unroll
            for (int r = 0; r < 4; ++r) a[r] += bf2f(Hs[(16 * w + (lane >> 4) * 4 + r) * RS + 16 * b + (lane & 15)]);
            sacc[b] = a;
        }
    } else {
        const int wi = w - 4;
#pragma unroll
        for (int b = 0; b < 4; ++b) {
            f32x4 a = {0.f, 0.f, 0.f, 0.f};
            a = mma_tile(S0b + 16 * wi * RS, RS, QTs + 16 * b * RS, RS, 64, a, lane);
            const int t = 16 * b + (lane & 15), i0 = 16 * wi + (lane >> 4) * 4;
            const u32x2 yh = *(const LAS u32x2*)(YHTs + t * RS + i0);
            yT[t * 65 + i0 + 0] = a[0] + bflo(yh.x); yT[t * 65 + i0 + 1] = a[1] + bfhi(yh.x); yT[t * 65 + i0 + 2] = a[2] + bflo(yh.y); yT[t * 65 + i0 + 3] = a[3] + bfhi(yh.y);
        }
    }
}
__device__ __forceinline__ void rwkv_post(int tid, const LAS float* yT, const LAS bf16_t* vblk, const LAS bf16_t* gblk, const LAS float* bon, const float (&lnw)[8], const float (&lnb)[8], bf16_t* zr, int nvalid) {
    const int t = tid >> 3, i0 = 8 * (tid & 7);
    float y[8], s = 0.f;
#pragma unroll
    for (int e = 0; e < 8; ++e) { y[e] = yT[t * 65 + i0 + e]; s += y[e]; }
    s += __shfl_xor(s, 1); s += __shfl_xor(s, 2); s += __shfl_xor(s, 4);
    const float mean = s * (1.0f / 64.0f); float qv = 0.f;
#pragma unroll
    for (int e = 0; e < 8; ++e) { y[e] -= mean; qv += y[e] * y[e]; }
    qv += __shfl_xor(qv, 1); qv += __shfl_xor(qv, 2); qv += __shfl_xor(qv, 4);
    const float rstd = __builtin_amdgcn_rsqf(qv * (1.0f / 64.0f) + 64e-5f), bo = bon[t];
    float vf[8], gf[8], o[8];
    unpack8(*(const LAS u32x4*)(vblk + t * RS + i0), vf); unpack8(*(const LAS u32x4*)(gblk + t * RS + i0), gf);
#pragma unroll
    for (int e = 0; e < 8; ++e) o[e] = (y[e] * rstd * lnw[e] + lnb[e] + bo * vf[e]) * gf[e];
    if (t < nvalid) *(u32x4*)(zr + (size_t)t * ZW + i0) = pack8(o);
}

constexpr int RA_At = 0, RA_Rt = 9216, RA_Bt = 18432, RA_Kt = 27648, RA_AtT = 36864, RA_BtT = 46080, RA_KtT = 55296, RA_VT = 64512, RA_Nf = 73728, RA_MinvT = 92160, RA_AakT = 101376,
              RA_AbrT = 110592, RA_AkrT = 119808, RA_WL = 129024, RA_SEG = 129280, RA_BON = 131328, RA_GB = 131584, RA_VB = 133888  ;
__device__ __forceinline__ void phase_rwkv_ra(const Ctx& c, int p, int l) {
    bf16_t* Z = (bf16_t*)(wsg(c) + WS_Z); bf16_t* T = (bf16_t*)(wsg(c) + WS_T); float* bonus_g = (float*)(wsg(c) + WS_BONUS);
    int tid = c.tid, lane = c.lane; const int w = c.wave;
#define LAUNDER2() asm volatile("" : "+v"(tid), "+v"(lane))
    const int nitems = p ? 4352 : 4096;
    u32x4 nx0, nx1, nx2, nx3, nx4; int have_pf = 0;
#define RA_PREFETCH(IT) do { have_pf = 0; if ((IT) < 4096 && (IT) < nitems && (IT) >= 0) { const int q_ = (IT) >> 11, rem_ = (IT) & 2047, h_ = rem_ & 15; \
        const size_t row_ = (size_t)(q_ * SEQ + (rem_ >> 4) * 64 + (tid >> 3)); const int col_ = 64 * h_ + 8 * (tid & 7); \
        nx0 = *(const u32x4*)(Z + row_ * ZW + C_R + col_); nx1 = *(const u32x4*)(Z + row_ * ZW + C_RK + col_); nx2 = *(const u32x4*)(Z + row_ * ZW + C_RV + col_); \
        nx3 = *(const u32x4*)(T + row_ * 3072 + col_); nx4 = *(const u32x4*)(T + row_ * 3072 + 1024 + col_); have_pf = 1; } } while (0)
    RA_PREFETCH(c.bid - 64);
    for (int item = c.bid - 64; item < nitems; item += c.G - 64) {
        LAUNDER2();
        LAS unsigned char* L = c.lds; asm volatile("" : "+v"(L));
    LAS bf16_t* At = (LAS bf16_t*)(L + RA_At); LAS bf16_t* Rt = (LAS bf16_t*)(L + RA_Rt); LAS bf16_t* Bt_ = (LAS bf16_t*)(L + RA_Bt); LAS bf16_t* Kt = (LAS bf16_t*)(L + RA_Kt);
    LAS bf16_t* AtT = (LAS bf16_t*)(L + RA_AtT); LAS bf16_t* BtT = (LAS bf16_t*)(L + RA_BtT); LAS bf16_t* KtT = (LAS bf16_t*)(L + RA_KtT); LAS bf16_t* VT = (LAS bf16_t*)(L + RA_VT);
    LAS float* cumb = (LAS float*)(L + RA_Nf); LAS float* NfT = (LAS float*)(L + RA_Nf);
    LAS bf16_t* MinvT = (LAS bf16_t*)(L + RA_MinvT); LAS bf16_t* AakT = (LAS bf16_t*)(L + RA_AakT); LAS bf16_t* AbrT = (LAS bf16_t*)(L + RA_AbrT); LAS bf16_t* AkrT = (LAS bf16_t*)(L + RA_AkrT);
    LAS bf16_t* XHm = At; LAS bf16_t* UGm = Kt; LAS bf16_t* UHm = Bt_;
    LAS bf16_t* GT = (LAS bf16_t*)(L + RA_Nf); LAS bf16_t* QT = (LAS bf16_t*)(L + RA_Nf + 9216); LAS bf16_t* Hm = MinvT; LAS bf16_t* YHT = AakT;
    LAS float* WL = (LAS float*)(L + RA_WL); LAS float* seg = (LAS float*)(L + RA_SEG); LAS float* bon = (LAS float*)(L + RA_BON); LAS bf16_t* gblk = (LAS bf16_t*)(L + RA_GB); LAS bf16_t* vblk = (LAS bf16_t*)(L + RA_VB);
        int h, rbase, nvalid, sample, sb = 0;
        if (item < 4096) { const int q = item >> 11, rem = item & 2047; h = rem & 15; rbase = q * SEQ + (rem >> 4) * 64; nvalid = 64; sample = 0; }
        else { const int sid = item - 4096; sb = sid >> 4; h = sid & 15; rbase = 16384 + sb * DSEQ; nvalid = DSEQ; sample = 1; }
        const int t = tid >> 3, jp = tid & 7, j0 = 8 * jp, col = 64 * h + j0; const bool valid = t < nvalid;
        float rf[8], kf[8], vf[8], wpf[8], apf[8], lw[8], av[8], bv[8], kp[8];
        u32x4 vraw = {0u, 0u, 0u, 0u};
        if (have_pf) { unpack8(nx0, rf); unpack8(nx1, kf); vraw = nx2; unpack8(nx3, wpf); unpack8(nx4, apf); }
        else if (valid) {
            const size_t row = (size_t)(rbase + t);
            unpack8(*(const u32x4*)(Z + row * ZW + C_R + col), rf); unpack8(*(const u32x4*)(Z + row * ZW + C_RK + col), kf); vraw = *(const u32x4*)(Z + row * ZW + C_RV + col);
            unpack8(*(const u32x4*)(T + row * 3072 + col), wpf); unpack8(*(const u32x4*)(T + row * 3072 + 1024 + col), apf);
            if (sample) { *(LAS u32x4*)(gblk + t * RS + j0) = *(const u32x4*)(T + row * 3072 + 2048 + col); *(LAS u32x4*)(vblk + t * RS + j0) = vraw; }
        }
        unpack8(vraw, vf);
        {
            const float* pw0 = inp(c, I_W0) + (size_t)l * D + col; const float* pa0 = inp(c, I_A0) + (size_t)l * D + col; const float* pkk = inp(c, I_KK) + (size_t)l * D + col;
            const float* pka = inp(c, I_KA) + (size_t)l * D + col; const float* prk = inp(c, I_RK) + (size_t)l * D + col;
            float ssq = 0.f, bsum = 0.f;
#pragma unroll
            for (int e = 0; e < 8; ++e) {
                if (valid) {
                    const float wlog = -softplusf_(-(pw0[e] + wpf[e])) - 0.5f; lw[e] = -__expf(wlog);
                    const float a = sigmoidf_(pa0[e] + apf[e]); const float kk = kf[e] * pkk[e]; ssq += kk * kk;
                    kp[e] = kf[e] * (1.0f + (a - 1.0f) * pka[e]); bsum += rf[e] * kp[e] * prk[e]; av[e] = kk; bv[e] = a;
                } else { lw[e] = 0.f; rf[e] = 0.f; kp[e] = 0.f; av[e] = 0.f; bv[e] = 0.f; }
            }
            ssq += __shfl_xor(ssq, 1); ssq += __shfl_xor(ssq, 2); ssq += __shfl_xor(ssq, 4);
            bsum += __shfl_xor(bsum, 1); bsum += __shfl_xor(bsum, 2); bsum += __shfl_xor(bsum, 4);
            const float inv = __builtin_amdgcn_rsqf(fmaxf(ssq, 1e-24f));
#pragma unroll
            for (int e = 0; e < 8; ++e) { const float kk = av[e] * inv; av[e] = -kk; bv[e] = kk * bv[e]; }
            if (jp == 0) { bon[t] = bsum; if (!sample) bonus_g[(size_t)(rbase + t) * 16 + h] = bsum; }
        }
#pragma unroll
        for (int e = 0; e < 8; ++e) cumb[t * 64 + j0 + e] = lw[e];
        __syncthreads();
        {
            const int j = tid & 63, sg = tid >> 6; float cs[8], run = 0.f;
#pragma unroll
            for (int e = 0; e < 8; ++e) { run += cumb[(8 * sg + e) * 64 + j]; cs[e] = run; }
            seg[sg * 64 + j] = run;
            __syncthreads();
            float off = 0.f;
#pragma unroll
            for (int s2 = 0; s2 < 8; ++s2) if (s2 < sg) off += seg[s2 * 64 + j];
#pragma unroll
            for (int e = 0; e < 8; ++e) cumb[(8 * sg + e) * 64 + j] = cs[e] + off;
        }
        __syncthreads();
        {
            float cu[8], cp[8], a8[8], r8[8], b8[8], k8[8];
#pragma unroll
            for (int e = 0; e < 8; ++e) { cu[e] = cumb[t * 64 + j0 + e]; cp[e] = t > 0 ? cumb[(t - 1) * 64 + j0 + e] : 0.f; }
#pragma unroll
            for (int e = 0; e < 8; ++e) { const float E = __expf(cu[e]), Em = __expf(-cu[e]), Ep = __expf(cp[e]);
                a8[e] = av[e] * Ep; r8[e] = rf[e] * E; b8[e] = bv[e] * Em; k8[e] = kp[e] * Em; if (t == 63) WL[j0 + e] = E; }
            const u32x4 aw = pack8(a8), rw = pack8(r8), bw = pack8(b8), kw = pack8(k8);
            *(LAS u32x4*)(At + t * RS + j0) = aw; *(LAS u32x4*)(Rt + t * RS + j0) = rw; *(LAS u32x4*)(Bt_ + t * RS + j0) = bw; *(LAS u32x4*)(Kt + t * RS + j0) = kw;
            *(LAS u32x4*)(MinvT + t * RS + j0) = vraw;
        }
        __syncthreads();
        LAUNDER2();
        {
            const int dp = tid & 31, so = (tid >> 5) & 7, which = tid >> 8;
#pragma unroll
            for (int a2 = 0; a2 < 2; ++a2) {
                const int arr = which + 2 * a2;
                const LAS bf16_t* src = arr == 0 ? At : (arr == 1 ? Bt_ : (arr == 2 ? Kt : MinvT));
                LAS bf16_t* dst = arr == 0 ? AtT : (arr == 1 ? BtT : (arr == 2 ? KtT : VT));
                unsigned wv[8];
#pragma unroll
                for (int e = 0; e < 8; ++e) wv[e] = *(const LAS unsigned*)(src + (8 * so + e) * RS + 2 * dp);
                u32x4 lo, hi;
                lo.x = (wv[0] & 0xffffu) | (wv[1] << 16); lo.y = (wv[2] & 0xffffu) | (wv[3] << 16); lo.z = (wv[4] & 0xffffu) | (wv[5] << 16); lo.w = (wv[6] & 0xffffu) | (wv[7] << 16);
                hi.x = (wv[0] >> 16) | (wv[1] & 0xffff0000u); hi.y = (wv[2] >> 16) | (wv[3] & 0xffff0000u); hi.z = (wv[4] >> 16) | (wv[5] & 0xffff0000u); hi.w = (wv[6] >> 16) | (wv[7] & 0xffff0000u);
                *(LAS u32x4*)(dst + (2 * dp) * RS + 8 * so) = lo; *(LAS u32x4*)(dst + (2 * dp + 1) * RS + 8 * so) = hi;
            }
        }
        {
            const int rt = w; const LAS bf16_t* Arow = (rt < 4 ? Bt_ + 16 * rt * RS : Kt + 16 * (rt - 4) * RS);
            f32x4 res[8];
#pragma unroll
            for (int ct = 0; ct < 8; ++ct) { f32x4 a = {0.f, 0.f, 0.f, 0.f}; res[ct] = mma_tile(Arow, RS, (ct < 4 ? At + 16 * ct * RS : Rt + 16 * (ct - 4) * RS), RS, 64, a, lane); }
#pragma unroll
            for (int ct = 0; ct < 8; ++ct) {
                const int s0 = 16 * (rt & 3) + (lane >> 4) * 4, tt = 16 * (ct & 3) + (lane & 15);
                f32x4 a = res[ct];
                if (ct < 4) {
#pragma unroll
                    for (int r = 0; r < 4; ++r) a[r] = (s0 + r < tt) ? a[r] : 0.f;
                    if (rt < 4) *(LAS f32x4*)(NfT + tt * 68 + s0) = a;
                    else { u32x2 wv; wv.x = pk2(a[0], a[1]); wv.y = pk2(a[2], a[3]); *(LAS u32x2*)(AakT + tt * RS + s0) = wv; }
                } else {
#pragma unroll
                    for (int r = 0; r < 4; ++r) a[r] = (s0 + r <= tt) ? a[r] : 0.f;
                    u32x2 wv; wv.x = pk2(a[0], a[1]); wv.y = pk2(a[2], a[3]);
                    if (rt < 4) *(LAS u32x2*)(AbrT + tt * RS + s0) = wv; else *(LAS u32x2*)(AkrT + tt * RS + s0) = wv;
                }
            }
        }
        __syncthreads();
        LAUNDER2();
        if (w == 0) {
            float M[64];
#pragma unroll
            for (int tt = 0; tt < 64; ++tt) {
                float a4[4] = {(lane == tt) ? 1.f : 0.f, 0.f, 0.f, 0.f};
#pragma unroll
                for (int p4 = 0; p4 < (tt + 3) / 4; ++p4) {
                    const f32x4 nv = *(const LAS f32x4*)(NfT + tt * 68 + 4 * p4);
#pragma unroll
                    for (int e = 0; e < 4; ++e) if (4 * p4 + e < tt) a4[e] += M[4 * p4 + e] * nv[e];
                }
                const float a = (a4[0] + a4[1]) + (a4[2] + a4[3]);
                M[tt] = a;
                MinvT[tt * RS + lane] = f2bf(a);
            }
        } else {
            for (int tl = w - 1; tl < 16; tl += 7) {
                const int ti = tl >> 2, tp = tl & 3; f32x4 a = {0.f, 0.f, 0.f, 0.f};
                a = mma_tile(VT + 16 * ti * RS, RS, AakT + 16 * tp * RS, RS, 64, a, lane);
#pragma unroll
                for (int r = 0; r < 4; ++r) XHm[(16 * ti + (lane >> 4) * 4 + r) * RS + 16 * tp + (lane & 15)] = f2bf(a[r]);
            }
        }
        __syncthreads();
        LAUNDER2();
#pragma unroll
        for (int k = 0; k < 4; ++k) {
            const int id = 4 * w + k, rtile = id >> 2, tt4 = id & 3; f32x4 a = {0.f, 0.f, 0.f, 0.f};
            a = mma_tile((rtile < 4 ? AtT + 16 * rtile * RS : XHm + 16 * (rtile - 4) * RS), RS, MinvT + 16 * tt4 * RS, RS, 64, a, lane);
            LAS bf16_t* dst = rtile < 4 ? UGm + 16 * rtile * RS : UHm + 16 * (rtile - 4) * RS;
#pragma unroll
            for (int r = 0; r < 4; ++r) dst[((lane >> 4) * 4 + r) * RS + 16 * tt4 + (lane & 15)] = f2bf(a[r]);
        }
        __syncthreads();
        LAUNDER2();
#pragma unroll
        for (int k = 0; k < 8; ++k) {
            const int mat = k >> 1, tile = w + 8 * (k & 1), ta = tile >> 2, tb = tile & 3, r0 = 16 * ta + (lane >> 4) * 4, cc = 16 * tb + (lane & 15);
            f32x4 a = {0.f, 0.f, 0.f, 0.f};
            if (mat == 0) {
                a = mma_tile(UGm + 16 * ta * RS, RS, BtT + 16 * tb * RS, RS, 64, a, lane);
                const float wl = WL[cc];
#pragma unroll
                for (int r = 0; r < 4; ++r) a[r] = (a[r] + ((r0 + r == cc) ? 1.f : 0.f)) * wl;
                u32x2 wv; wv.x = pk2(a[0], a[1]); wv.y = pk2(a[2], a[3]); *(LAS u32x2*)(GT + cc * RS + r0) = wv;
            } else if (mat == 1) {
                a = mma_tile(UHm + 16 * ta * RS, RS, BtT + 16 * tb * RS, RS, 64, a, lane);
                a = mma_tile(VT + 16 * ta * RS, RS, KtT + 16 * tb * RS, RS, 64, a, lane);
                const float wl = WL[cc];
#pragma unroll
                for (int r = 0; r < 4; ++r) Hm[(r0 + r) * RS + cc] = f2bf(a[r] * wl);
            } else if (mat == 2) {
                a = mma_tile(UGm + 16 * ta * RS, RS, AbrT + 16 * tb * RS, RS, 64, a, lane);
                const u32x2 rr = *(const LAS u32x2*)(Rt + cc * RS + r0);
                u32x2 wv; wv.x = pk2(a[0] + bflo(rr.x), a[1] + bfhi(rr.x)); wv.y = pk2(a[2] + bflo(rr.y), a[3] + bfhi(rr.y)); *(LAS u32x2*)(QT + cc * RS + r0) = wv;
            } else {
                a = mma_tile(UHm + 16 * ta * RS, RS, AbrT + 16 * tb * RS, RS, 64, a, lane);
                a = mma_tile(VT + 16 * ta * RS, RS, AkrT + 16 * tb * RS, RS, 64, a, lane);
                u32x2 wv; wv.x = pk2(a[0], a[1]); wv.y = pk2(a[2], a[3]); *(LAS u32x2*)(YHT + cc * RS + r0) = wv;
            }
        }
        __syncthreads();
        LAUNDER2();
        RA_PREFETCH(item + c.G - 64);
        if (!sample) {
            const int row = tid >> 3, pc = tid & 7; const size_t gr = (size_t)(rbase + row);
            *(u32x4*)(Z + gr * ZW + C_R + 64 * h + 8 * pc) = *(const LAS u32x4*)(GT + row * RS + 8 * pc);
            *(u32x4*)(Z + gr * ZW + C_RK + 64 * h + 8 * pc) = *(const LAS u32x4*)(QT + row * RS + 8 * pc);
            *(u32x4*)(T + gr * 3072 + 64 * h + 8 * pc) = *(const LAS u32x4*)(Hm + row * RS + 8 * pc);
            *(u32x4*)(T + gr * 3072 + 1024 + 64 * h + 8 * pc) = *(const LAS u32x4*)(YHT + row * RS + 8 * pc);
        } else {
            LAS bf16_t* S0b = AtT; LAS float* yT = (LAS float*)(L + RA_BtT);
            {
                const int i = tid >> 3, jq = tid & 7; float sf[8];
                const float* sp = inp(c, I_SRS) + ((((size_t)l * DB + sb) * 16 + h) * 64 + i) * 64 + 8 * jq;
#pragma unroll
                for (int e = 0; e < 8; ++e) sf[e] = sp[e];
                *(LAS u32x4*)(S0b + i * RS + 8 * jq) = pack8(sf);
            }
            __syncthreads();
            f32x4 sacc[4];
            rwkv_apply_tiles(w, lane, S0b, GT, QT, Hm, YHT, yT, sacc);
            if (w < 4) {
                float* os = outg(c) + O_SRS + (((size_t)l * DB + sb) * 16 + h) * 4096;
#pragma unroll
                for (int b = 0; b < 4; ++b)
#pragma unroll
                    for (int r = 0; r < 4; ++r) os[(size_t)(16 * w + (lane >> 4) * 4 + r) * 64 + 16 * b + (lane & 15)] = sacc[b][r];
            }
            __syncthreads();
            float lnw[8], lnb[8];
#pragma unroll
            for (int e = 0; e < 8; ++e) { lnw[e] = inp(c, I_LNW)[(size_t)l * D + 64 * h + 8 * (tid & 7) + e]; lnb[e] = inp(c, I_LNB)[(size_t)l * D + 64 * h + 8 * (tid & 7) + e]; }
            rwkv_post(tid, yT, vblk, gblk, bon, lnw, lnb, Z + (size_t)rbase * ZW + C_R + 64 * h, nvalid);
        }
        __syncthreads();
    }
}

constexpr int RB_S0 = 0, RB_YT = 9216, RB_BUF = 25856, RB_BUFSZ = 55552;
__device__ __forceinline__ void rwkv_rb_chain(const Ctx& c, unsigned& epoch, int p, int l, int q, int h) {
    bf16_t* Z = (bf16_t*)(wsg(c) + WS_Z); const bf16_t* T = (const bf16_t*)(wsg(c) + WS_T); const float* bonus_g = (const float*)(wsg(c) + WS_BONUS);
    const int tid = c.tid, lane = c.lane, w = c.wave; const Seq sq = seq_of(p, q);
    LAS unsigned char* L = c.lds; asm volatile("" : "+v"(L));
    LAS bf16_t* S0b = (LAS bf16_t*)(L + RB_S0); LAS float* yT = (LAS float*)(L + RB_YT);
    const int row = tid >> 3, pc = tid & 7, NCH = SEQ / 64;
    float lnw[8], lnb[8];
#pragma unroll
    for (int e = 0; e < 8; ++e) { lnw[e] = inp(c, I_LNW)[(size_t)l * D + 64 * h + 8 * pc + e]; lnb[e] = inp(c, I_LNB)[(size_t)l * D + 64 * h + 8 * pc + e]; }
    { unsigned zz = 0u; asm volatile("" : "+v"(zz)); const u32x4 z4 = {zz, zz, zz, zz}; *(LAS u32x4*)(S0b + row * RS + 8 * pc) = z4; }
    f32x4 sacc[4];
#pragma unroll
    for (int b = 0; b < 4; ++b) sacc[b] = (f32x4){0.f, 0.f, 0.f, 0.f};
    u32x4 pg, pq, ph, py, pv, pgb; float pbon = 0.f;
#define RB_LOAD(RB) do { const size_t gr = (size_t)((RB) + row); \
        pg = *(const u32x4*)(Z + gr * ZW + C_R + 64 * h + 8 * pc); pq = *(const u32x4*)(Z + gr * ZW + C_RK + 64 * h + 8 * pc); pv = *(const u32x4*)(Z + gr * ZW + C_RV + 64 * h + 8 * pc); \
        ph = *(const u32x4*)(T + gr * 3072 + 64 * h + 8 * pc); py = *(const u32x4*)(T + gr * 3072 + 1024 + 64 * h + 8 * pc); pgb = *(const u32x4*)(T + gr * 3072 + 2048 + 64 * h + 8 * pc); \
        if (tid < 64) pbon = bonus_g[(size_t)((RB) + tid) * 16 + h]; } while (0)
#define RB_PARK(BUF) do { LAS unsigned char* bb_ = L + RB_BUF + (BUF) * RB_BUFSZ; const int o_ = (row * RS + 8 * pc) * 2; \
        *(LAS u32x4*)(bb_ + o_) = pg; *(LAS u32x4*)(bb_ + 9216 + o_) = pq; *(LAS u32x4*)(bb_ + 18432 + o_) = ph; *(LAS u32x4*)(bb_ + 27648 + o_) = py; \
        *(LAS u32x4*)(bb_ + 36864 + o_) = pv; *(LAS u32x4*)(bb_ + 46080 + o_) = pgb; if (tid < 64) ((LAS float*)(bb_ + 55296))[tid] = pbon; } while (0)
    RB_LOAD(sq.row0); RB_PARK(0); RB_LOAD(sq.row0 + 64);
    __syncthreads();
    for (int ck = 0; ck < NCH; ++ck) {
        const int rbase = sq.row0 + ck * 64, cur = ck & 1;
        LAS unsigned char* bb = L + RB_BUF + cur * RB_BUFSZ;
        rwkv_apply_tiles(w, lane, S0b, (const LAS bf16_t*)bb, (const LAS bf16_t*)(bb + 9216), (const LAS bf16_t*)(bb + 18432), (const LAS bf16_t*)(bb + 27648), yT, sacc);
        __syncthreads();
        if (w < 4) {
#pragma unroll
            for (int b = 0; b < 4; ++b)
#pragma unroll
                for (int r = 0; r < 4; ++r) S0b[(16 * w + (lane >> 4) * 4 + r) * RS + 16 * b + (lane & 15)] = f2bf(sacc[b][r]);
        }
        rwkv_post(tid, yT, (const LAS bf16_t*)(bb + 36864), (const LAS bf16_t*)(bb + 46080), (const LAS float*)(bb + 55296), lnw, lnb, Z + (size_t)rbase * ZW + C_R + 64 * h, 64);
        if (ck + 1 < NCH) { RB_PARK(cur ^ 1); if (ck + 2 < NCH) RB_LOAD(rbase + 128); }
        __syncthreads();
        if (ck == 15 || ck == 79) grid_bar((unsigned*)(wsg(c) + WS_BAR), epoch, (unsigned)gridDim.x);
    }
#undef RB_LOAD
#undef RB_PARK
    if (w < 4) {
        float* os = outg(c) + O_PRS + (((size_t)l * NB + sq.b) * 16 + h) * 4096;
#pragma unroll
        for (int b = 0; b < 4; ++b)
#pragma unroll
            for (int r = 0; r < 4; ++r) os[(size_t)(16 * w + (lane >> 4) * 4 + r) * 64 + 16 * b + (lane & 15)] = sacc[b][r];
    }
}

__device__ __forceinline__ void phase_seqmix_a(const Ctx& c, int p, int l) {
    if (c.bid < 64) { const int q = c.bid >> 5, h = (c.bid >> 3) & 3, slab = c.bid & 7; mlstm_task(c, p, l, q, h, slab); }
    else {
        phase_rwkv_ra(c, p, l);
        if (p == 1) { const int nw = c.G - 64, wgi = c.bid - 64;
            for (int t = wgi; t < 512; t += nw) { const int q = 2 + (t >> 5), h = (t >> 3) & 3, slab = t & 7; mlstm_task(c, p, l, q, h, slab); } }
    }
}

__device__ __forceinline__ void phase_om(const Ctx& c, int p, int l) {
    bf16_t* Z = (bf16_t*)(wsg(c) + WS_Z); const int nrows = pass_rows(p), lane = c.lane, head = lane >> 4, part = lane & 15, col = 256 * head + 16 * part;
    float nm[16];
#pragma unroll
    for (int e = 0; e < 16; ++e) nm[e] = inp(c, I_MNORM)[(size_t)l * D + col + e];
    for (int r = c.bid * 8 + c.wave; r < nrows; r += c.G * 8) {
        float hv[16], zo[16];
        unpack8(*(const u32x4*)(Z + (size_t)r * ZW + C_V + col), *(float(*)[8])&hv[0]); unpack8(*(const u32x4*)(Z + (size_t)r * ZW + C_V + col + 8), *(float(*)[8])&hv[8]);
        unpack8(*(const u32x4*)(Z + (size_t)r * ZW + C_O + col), *(float(*)[8])&zo[0]); unpack8(*(const u32x4*)(Z + (size_t)r * ZW + C_O + col + 8), *(float(*)[8])&zo[8]);
        float s = 0.f;
#pragma unroll
        for (int e = 0; e < 16; ++e) s += hv[e];
        s += __shfl_xor(s, 1); s += __shfl_xor(s, 2); s += __shfl_xor(s, 4); s += __shfl_xor(s, 8);
        const float mean = s * (1.0f / 256.0f); float q = 0.f;
#pragma unroll
        for (int e = 0; e < 16; ++e) { hv[e] -= mean; q += hv[e] * hv[e]; }
        q += __shfl_xor(q, 1); q += __shfl_xor(q, 2); q += __shfl_xor(q, 4); q += __shfl_xor(q, 8);
        const float rstd = __builtin_amdgcn_rsqf(q * (1.0f / 256.0f) + 1e-6f);
        float o0[8], o1[8];
#pragma unroll
        for (int e = 0; e < 8; ++e) { o0[e] = sigmoidf_(zo[e]) * hv[e] * rstd * nm[e]; o1[e] = sigmoidf_(zo[8 + e]) * hv[8 + e] * rstd * nm[8 + e]; }
        *(u32x4*)(Z + (size_t)r * ZW + C_O + col) = pack8(o0); *(u32x4*)(Z + (size_t)r * ZW + C_O + col + 8) = pack8(o1);
    }
}

__global__ void __launch_bounds__(NTHREADS, 2) mega_fwd(Args args) {
    extern __shared__ __attribute__((aligned(16))) unsigned char lds_raw[];
    cg::grid_group grid = cg::this_grid();
    Ctx c; c.out = args.out; c.ws = args.ws; c.lds = (LAS unsigned char*)lds_raw;
    c.tid = threadIdx.x; c.lane = c.tid & 63; c.wave = __builtin_amdgcn_readfirstlane(c.tid >> 6); c.G = gridDim.x; c.bid = blockIdx.x; c.dry = 0;
    if (c.tid < N_IN) { const unsigned long long v = (unsigned long long)args.in[c.tid]; LAS unsigned* t = (LAS unsigned*)(c.lds + TAB_OFF); t[2 * c.tid] = (unsigned)v; t[2 * c.tid + 1] = (unsigned)(v >> 32); }
    __syncthreads();
    const int lo = args.ph_lo, hi = args.ph_hi; int ph = 0;
    unsigned epoch = 0u;
    grid.sync();
#define GSYNC() grid_bar((unsigned*)(wsg(c) + WS_BAR), epoch, (unsigned)gridDim.x)
#define W ((bf16_t*)wsg(c))
#define UP ((bf16_t*)(wsg(c) + WS_UP))
#define Zb ((bf16_t*)(wsg(c) + WS_Z))
#define Tb ((bf16_t*)(wsg(c) + WS_T))
#define X (outg(c))
#define PH(body) do { if (ph >= lo && ph < hi) { asm volatile("" : "+v"(c.tid), "+v"(c.lane), "+s"(c.bid), "+s"(c.wave), "+s"(c.G), "+s"(c.ws), "+s"(c.out), "+s"(c.lds)); body; if (ph + 1 < hi) GSYNC(); } ++ph; } while (0)
#define PHD(grp, body) PH(body)
    for (int l = 0; l < 2; ++l) {
        for (int st = 0; st < 3; ++st) {
            if (st != 1) {
                const int f = st >> 1;
                PH((f == 0 ? phase_cvt(c, l) : (void)0, phase_norm(c, (l == 0 && f == 0) ? inp(c, I_XP) : nullptr, inp(c, I_XS), X, 0, NTOK, inp(c, f ? I_F2N : I_F1N) + (size_t)l * D, Tb, nullptr, nullptr)));
                PHD(1, run_gemm(c, Tb, D, W + (f ? W_GU2 : W_GU1) / 2, D, NTOK, 2 * FF, D, 0, 0, EpiSwiglu{Zb}));
                PH((run_gemm(c, Zb, FF, W + (f ? W_D2 : W_D1) / 2, FF, NPROMPT, D, FF, 0, 0, EpiResAdd{X, (l == 0 && f == 0) ? inp(c, I_XP) : (const float*)X, 0.5f}),
                    run_gemm_splitk(c, Zb + (size_t)NPROMPT * FF, FF, W + (f ? W_D2 : W_D1) / 2, FF, FF, X + (size_t)NPROMPT * D, 0.5f)));
            } else {
                for (int p = 0; p < 2; ++p) {
                    const int Mp = pass_rows(p), g0 = p * 16384;
                    PH(phase_norm(c, nullptr, nullptr, X, g0, Mp, inp(c, I_MIXN) + (size_t)l * D, UP, (const float*)(wsg(c) + W_IF), (float*)(wsg(c) + WS_GIF)));
                    PHD(1, run_gemm(c, UP, D, W + W_IN / 2, D, Mp, ZW, D, 0, 0, EpiStore{Zb, ZW, 0}));
                    PH(phase_cv1(c, p, l));
                    PH(phase_cv2(c, p, l));
                    PH(run_gemm(c, Zb + C_LRU, ZW, W + W_LRU / 2, 256, Mp, 2048, 256, 4, 256, EpiStore{Tb, 2048, 0}));
                    PH((phase_lru<0>(c, p, l), phase_mlstm_s(c, p, l)));
                    PH(phase_lru<1>(c, p, l));
                    PH(run_gemm(c, Zb + C_WD, ZW, W + W_LORA / 2, 256, Mp, 3072, 256, 0, 0, EpiStore{Tb, 3072, 0}));
                    PHD(2, phase_seqmix_a(c, p, l));
                    {
                        asm volatile("" : "+v"(c.tid), "+v"(c.lane), "+s"(c.bid), "+s"(c.wave), "+s"(c.G), "+s"(c.ws), "+s"(c.out), "+s"(c.lds));
                        if (c.bid < 32) { rwkv_rb_chain(c, epoch, p, l, c.bid >> 4, c.bid & 15); GSYNC(); }
                        else {
                            Ctx c2 = c; c2.bid = c.bid - 32; c2.G = c.G - 32;
                            phase_om(c2, p, l); GSYNC();
                            asm volatile("" : "+v"(c2.tid), "+v"(c2.lane));
                            run_gemm(c2, (bf16_t*)(wsg(c2) + WS_UP), D, (bf16_t*)wsg(c2) + W_G / 2, D, Mp, 3072, D, 0, 0, EpiStore{(bf16_t*)(wsg(c2) + WS_Z), ZW, C_Q}); GSYNC();
                            for (int b = 0; b < 2; ++b) {
                                asm volatile("" : "+v"(c2.tid), "+v"(c2.lane));
                                run_gemm(c2, (bf16_t*)(wsg(c2) + WS_Z) + (b == 0 ? C_LRU : C_O), ZW, (bf16_t*)wsg(c2) + W_BR / 2 + (size_t)b * D * D, D, Mp, D, D, 0, 0, EpiMerge{(bf16_t*)(wsg(c2) + WS_UP), (const bf16_t*)(wsg(c2) + WS_Z), C_Q + 1024 * b, b == 0});
                            }
                            GSYNC();
                        }
                    }
                    PH(run_gemm(c, Zb + C_R, ZW, W + W_BR / 2 + (size_t)2 * D * D, D, Mp, D, D, 0, 0, EpiMerge{UP, Zb, C_Q + 2048, 0}));
                    PH(run_gemm(c, UP, D, W + W_OUT / 2, D, Mp, D, D, 0, 0, EpiResAdd{X + (size_t)g0 * D, X + (size_t)g0 * D, 1.0f}));
                }
            }
        }
    }
    PH(phase_final_norm(c, X, inp(c, I_FN)));
#undef PH
#undef GSYNC
#undef PHD
#undef W
#undef UP
#undef Zb
#undef Tb
#undef X
}

extern "C" void kernel_launch(void* const* d_in, const int* in_sizes, int n_in, void* d_out, int out_size, void* d_ws, size_t ws_size, hipStream_t stream) {
    static int grid = 0;
    if (grid == 0) {
        if (n_in != N_IN || (size_t)out_size != O_END || ws_size < WS_END) { fprintf(stderr, "kernel_launch: unexpected shapes n_in %d out %d ws %zu\n", n_in, out_size, ws_size); grid = -1; return; }
        int dev = 0, cus = 0, per_cu = 0;
        hipGetDevice(&dev); hipDeviceGetAttribute(&cus, hipDeviceAttributeMultiprocessorCount, dev);
        if (hipFuncSetAttribute((const void*)mega_fwd, hipFuncAttributeMaxDynamicSharedMemorySize, LDS_BYTES) != hipSuccess) { fprintf(stderr, "hipFuncSetAttribute failed\n"); grid = -1; return; }
        hipOccupancyMaxActiveBlocksPerMultiprocessor(&per_cu, (const void*)mega_fwd, NTHREADS, LDS_BYTES);
        (void)hipGetLastError();
        if (per_cu < 1) per_cu = 1;
        grid = cus;
        if (grid > 256) grid = 256;
    }
    if (grid < 0) return;
    if (hipMemsetAsync((char*)d_ws + WS_BAR, 0, 4096, stream) != hipSuccess) { fprintf(stderr, "memset failed\n"); return; }
    Args a{};
    for (int i = 0; i < N_IN; ++i) a.in[i] = (const float*)d_in[i];
    a.out = (float*)d_out; a.ws = (unsigned char*)d_ws; a.ph_lo = 0; a.ph_hi = 1000;
    void* kargs[] = {&a};
    hipError_t e = hipLaunchCooperativeKernel((const void*)mega_fwd, dim3(grid), dim3(NTHREADS), kargs, LDS_BYTES, stream);
    if (e != hipSuccess) fprintf(stderr, "cooperative launch failed: %s (grid %d)\n", hipGetErrorString(e), grid);
}
```

```cpp
#include <hip/hip_runtime.h>
#include <hip/hip_cooperative_groups.h>
#include <cstdio>
namespace cg = cooperative_groups;
namespace pg8 {
#define PG8_LAS __attribute__((address_space(3)))
typedef unsigned short bf16_t;
typedef short bf16x8 __attribute__((ext_vector_type(8)));
typedef float f32x4 __attribute__((ext_vector_type(4)));
typedef unsigned u32x4 __attribute__((ext_vector_type(4)));
constexpr int BM = 256, BK = 64, HALF = 128, HTB = HALF * BK * 2  , STAGE_BYTES = 8 * HTB, NXCD = 8, WGM = 8;
__host__ __device__ __forceinline__ int lds_byte(int r, int c) { const int st = (r >> 4) * 2 + (c >> 5), rr = r & 15, cc = c & 31, ob = rr * 64 + cc * 2; return st * 1024 + (ob ^ (((ob >> 9) & 1) << 5)); }
__host__ __device__ __forceinline__ void stage_rc(int b, int& R, int& C) { const int st = b / 1024, sb = b % 1024, swz = sb ^ (((sb >> 9) & 1) << 5); R = (st >> 1) * 16 + swz / 64; C = (st & 1) * 32 + (swz % 64) / 2; }
__host__ __device__ __forceinline__ int perm32(int rho) { const int n = rho >> 4, i = rho & 15; return 8 * (i >> 2) + 4 * n + (i & 3); }
struct Unit { int pm, pn; };
struct Gemm { const bf16_t* A; int lda; const bf16_t* Bt; int ldb; int M, N, K; int amod, astride; int ksn, kchunk;
    __device__ __forceinline__ size_t acol(int pn) const { return (amod ? (size_t)((pn % amod) * astride) * 2 : (size_t)0) + (ksn ? (size_t)((pn / ksn) * kchunk) * 2 : (size_t)0); }
    __device__ __forceinline__ size_t boff(int pn, size_t tstepB) const { return ksn ? (size_t)(pn % ksn) * tstepB + (size_t)((pn / ksn) * kchunk) * 2 : (size_t)pn * tstepB; } };
struct StaticOrder {
    int nM, nN, nwg, G, c;
    __host__ __device__ void init(int M, int N, int G_, int c_) { nM = M / BM; nN = N / BM; nwg = nM * nN; G = G_; c = c_; }
    __host__ __device__ bool next(int i, Unit& u) const {
        const long L = (long)i * G + c; if (L >= nwg) return false;
        int wgid = (int)L; { const int q = nwg / NXCD, r = nwg % NXCD, xcd = wgid % NXCD, off = wgid / NXCD; wgid = (xcd < r ? xcd * (q + 1) : r * (q + 1) + (xcd - r) * q) + off; }
        const int nig = WGM * nN, gid = wgid / nig, fm = gid * WGM, gsz = (nM - fm) < WGM ? (nM - fm) : WGM;
        u.pm = fm + ((wgid % nig) % gsz); u.pn = (wgid % nig) / gsz; return true;
    }
    __device__ __forceinline__ void a_ready(const Unit&) const {}
    __device__ __forceinline__ void done(const Unit&) const {}
};
__device__ __forceinline__ unsigned cvt_pk_bf16(float lo, float hi) { unsigned r; asm volatile("v_cvt_pk_bf16_f32 %0, %1, %2" : "=v"(r) : "v"(lo), "v"(hi)); return r; }
template <class Epi, class Sched>
__device__ __forceinline__ void gemm_phase(PG8_LAS unsigned char* lds, const Gemm g, const Sched& S, const Epi& E, const int tid_in) {
    const int tid = tid_in, wid = __builtin_amdgcn_readfirstlane(tid >> 6), lane = tid & 63, wr = wid >> 2, wc = wid & 3, fr = lane & 15, fq = lane >> 4;
    const int K = g.K, nt = K / BK;
    unsigned voffA[2], voffB[2];
#pragma unroll
    for (int i = 0; i < 2; ++i) { int R, C; stage_rc(tid * 16 + i * 8192, R, C); const int Rb = Epi::PERM ? ((R & ~31) + perm32(R & 31)) : R;
        voffA[i] = (unsigned)(R * g.lda + C) * 2u; voffB[i] = (unsigned)(Rb * g.ldb + C) * 2u; }
    const size_t kstep = (size_t)(BK * 2);
    const size_t hstepA = (size_t)HALF * g.lda * 2, hstepB = (size_t)HALF * g.ldb * 2;
    const size_t tstepA = 2 * hstepA, tstepB = 2 * hstepB;
    const unsigned ldsw = (unsigned)wid * 1024u;
    const int aoff = lds_byte(wr * 64 + fr, fq * 8), boff = lds_byte(wc * 32 + fr, fq * 8);
#define PG8_SA(b, h) (((b) * 2 + (h)) * HTB)
#define PG8_SB(b, h) ((4 + (b) * 2 + (h)) * HTB)
#define PG8_STAGE(bufoff, gbase, voff) do { _Pragma("unroll") for (int _i = 0; _i < 2; ++_i) \
        __builtin_amdgcn_global_load_lds((const unsigned*)((const char*)(gbase) + (voff)[_i]), (PG8_LAS unsigned*)(lds + (bufoff) + ldsw + _i * 8192), 16, 0, 0); } while (0)
#define PG8_LDA(dst, b, h) do { _Pragma("unroll") for (int m = 0; m < 4; ++m) _Pragma("unroll") for (int k = 0; k < 2; ++k) dst[m][k] = *(const PG8_LAS bf16x8*)(lds + PG8_SA(b, h) + aoff + m * 2048 + k * 1024); } while (0)
#define PG8_LDB(dst, b, h) do { _Pragma("unroll") for (int n = 0; n < 2; ++n) _Pragma("unroll") for (int k = 0; k < 2; ++k) dst[n][k] = *(const PG8_LAS bf16x8*)(lds + PG8_SB(b, h) + boff + n * 2048 + k * 1024); } while (0)
#define PG8_MMA(ai, bj, At, Bt) do { __builtin_amdgcn_s_setprio(1); _Pragma("unroll") for (int m = 0; m < 4; ++m) _Pragma("unroll") for (int n = 0; n < 2; ++n) _Pragma("unroll") for (int k = 0; k < 2; ++k) \
        acc[ai][bj][m][n] = __builtin_amdgcn_mfma_f32_16x16x32_bf16(Bt[n][k], At[m][k], acc[ai][bj][m][n], 0, 0, 0); __builtin_amdgcn_s_setprio(0); } while (0)
#define PG8_WAIT_V(n) asm volatile("s_waitcnt vmcnt(" #n ")" ::: "memory")
#define PG8_WAIT_L(n) asm volatile("s_waitcnt lgkmcnt(" #n ")" ::: "memory")
#define PG8_BAR __builtin_amdgcn_s_barrier()
#define PG8_SCHED __builtin_amdgcn_sched_barrier(0)
    Unit cur, nxt; int ui = 0;
    if (!S.next(0, cur)) return;
    f32x4 acc[2][2][4][2];
#pragma unroll
    for (int a = 0; a < 2; ++a)
#pragma unroll
        for (int b = 0; b < 2; ++b)
#pragma unroll
            for (int m = 0; m < 4; ++m)
#pragma unroll
                for (int n = 0; n < 2; ++n) acc[a][b][m][n] = (f32x4){0.f, 0.f, 0.f, 0.f};
    bf16x8 At[4][2], B0[2][2], B1[2][2];
    const char* cA = (const char*)g.A + (size_t)cur.pm * tstepA + g.acol(cur.pn); const char* cB = (const char*)g.Bt + g.boff(cur.pn, tstepB);
    S.a_ready(cur);
    PG8_STAGE(PG8_SB(0, 0), cB, voffB); PG8_STAGE(PG8_SA(0, 0), cA, voffA); PG8_STAGE(PG8_SB(0, 1), cB + hstepB, voffB); PG8_STAGE(PG8_SA(0, 1), cA + hstepA, voffA);
    if (wr == 1) PG8_BAR;
    PG8_WAIT_V(4); PG8_BAR;
    PG8_STAGE(PG8_SB(1, 0), cB + kstep, voffB); PG8_STAGE(PG8_SA(1, 0), cA + kstep, voffA); PG8_STAGE(PG8_SB(1, 1), cB + hstepB + kstep, voffB);
    PG8_WAIT_V(6); PG8_BAR;
    for (;;) {
        const bool has_next = S.next(ui + 1, nxt);
        const char* nA = has_next ? (const char*)g.A + (size_t)nxt.pm * tstepA + g.acol(nxt.pn) : cA; const char* nB = has_next ? (const char*)g.Bt + g.boff(nxt.pn, tstepB) : cB;
        for (int t = 0; t < nt; t += 2) {
            const bool last = (t == nt - 2);
            const char* a1 = cA + (size_t)(t + 1) * kstep;
            const char* a2 = last ? nA : cA + (size_t)(t + 2) * kstep; const char* b2 = last ? nB : cB + (size_t)(t + 2) * kstep;
            const char* a3 = a2 + kstep; const char* b3 = b2 + kstep;
            if (last && has_next) S.a_ready(nxt);
            PG8_LDB(B0, 0, 0); PG8_SCHED; PG8_LDA(At, 0, 0); PG8_STAGE(PG8_SA(1, 1), a1 + hstepA, voffA);
            PG8_WAIT_L(8); PG8_BAR; PG8_WAIT_L(0); PG8_MMA(0, 0, At, B0); PG8_BAR; PG8_SCHED;
            PG8_LDB(B1, 0, 1); PG8_STAGE(PG8_SB(0, 0), b2, voffB);
            PG8_BAR; PG8_WAIT_L(0); PG8_MMA(0, 1, At, B1); PG8_BAR;
            PG8_LDA(At, 0, 1); PG8_STAGE(PG8_SA(0, 0), a2, voffA);
            PG8_BAR; PG8_WAIT_L(0); PG8_MMA(1, 0, At, B0); PG8_BAR; PG8_SCHED;
            PG8_STAGE(PG8_SB(0, 1), b2 + hstepB, voffB);
            PG8_WAIT_V(6); PG8_BAR; PG8_MMA(1, 1, At, B1); PG8_BAR;
            PG8_LDB(B0, 1, 0); PG8_SCHED; PG8_LDA(At, 1, 0); PG8_STAGE(PG8_SA(0, 1), a2 + hstepA, voffA);
            PG8_WAIT_L(8); PG8_BAR; PG8_WAIT_L(0); PG8_MMA(0, 0, At, B0); PG8_BAR; PG8_SCHED;
            PG8_LDB(B1, 1, 1); PG8_STAGE(PG8_SB(1, 0), b3, voffB);
            PG8_BAR; PG8_WAIT_L(0); PG8_MMA(0, 1, At, B1); PG8_BAR;
            PG8_LDA(At, 1, 1); PG8_STAGE(PG8_SA(1, 0), a3, voffA);
            PG8_BAR; PG8_WAIT_L(0); PG8_MMA(1, 0, At, B0); PG8_BAR; PG8_SCHED;
            PG8_STAGE(PG8_SB(1, 1), b3 + hstepB, voffB);
            PG8_WAIT_V(6); PG8_BAR; PG8_MMA(1, 1, At, B1); PG8_BAR;
        }
        if constexpr (!Epi::AFTER_DRAIN) { E(acc, cur, wr, wc, fr, fq); S.done(cur); }
        if (!has_next) break;
#pragma unroll
        for (int a = 0; a < 2; ++a)
#pragma unroll
            for (int b = 0; b < 2; ++b)
#pragma unroll
                for (int m = 0; m < 4; ++m)
#pragma unroll
                    for (int n = 0; n < 2; ++n) acc[a][b][m][n] = (f32x4){0.f, 0.f, 0.f, 0.f};
        cur = nxt; cA = nA; cB = nB; ++ui;
    }
    PG8_WAIT_V(0);
    if (wr == 0) PG8_BAR;
    PG8_BAR;
    if constexpr (Epi::AFTER_DRAIN) { E.fused(acc, cur, wr, wc, fr, fq, lds, wid, lane); S.done(cur); }
#undef PG8_SA
#undef PG8_SB
#undef PG8_STAGE
#undef PG8_LDA
#undef PG8_LDB
#undef PG8_MMA
#undef PG8_WAIT_V
#undef PG8_WAIT_L
#undef PG8_BAR
#undef PG8_SCHED
}

}

#define LAS __attribute__((address_space(3)))
typedef unsigned short bf16_t;
typedef short bf16x8 __attribute__((ext_vector_type(8)));
typedef float f32x4 __attribute__((ext_vector_type(4)));
typedef unsigned u32x4 __attribute__((ext_vector_type(4)));
typedef unsigned u32x2 __attribute__((ext_vector_type(2)));

constexpr int D = 1024, FF = 2816, NTOK = 33024, NPROMPT = 32768, SEQ = 8192, DSEQ = 16, NB = 4, DB = 16;
constexpr int ZW = 8448, C_LRU = 0, C_Q = 1024, C_K = 2048, C_V = 3072, C_O = 4096, C_R = 5120, C_RK = 6144, C_RV = 7168, C_WD = 8192;
constexpr int INW = 11528, CONVCH = 3072, RIN = 3328;
constexpr int NTHREADS = 512;
constexpr int LDS_BYTES = 147456;

constexpr size_t W_GU1 = 0, W_D1 = 11534336, W_GU2 = 17301504, W_D2 = 28835840, W_IN = 34603008, W_G = 51904512, W_LRU = 58195968, W_LORA = 59244544,
                 W_BR = 60817408, W_OUT = 67108864, W_IF = 69206016;
constexpr size_t WS_BAR = 513229056, WS_SL = 504316160;
constexpr size_t WS_UP = 69238784, WS_Z = 103317504, WS_T = 384466944, WS_HALO = 486703104, WS_GIF = 500490240, WS_CAR = 501022720, WS_BONUS = 503250944, WS_END = 513229056 + 4096;

constexpr size_t O_Y = 0, O_PCONV = 33816576, O_PLRU = O_PCONV + 73728, O_PMC = O_PLRU + 8192, O_PMN = O_PMC + 2097152, O_PMM = O_PMN + 8192, O_PSH = O_PMM + 32,
                 O_PRS = O_PSH + 26624, O_SCONV = O_PRS + 524288, O_SLRU = O_SCONV + 294912, O_SMC = O_SLRU + 32768, O_SMN = O_SMC + 8388608, O_SMM = O_SMN + 32768,
                 O_SSH = O_SMM + 128, O_SRS = O_SSH + 106496, O_END = O_SRS + 2097152;

enum { I_XP = 0, I_XS, I_SCONV, I_SLRU, I_SMC, I_SMN, I_SMM, I_SSH, I_SRS, I_F1N, I_F1G, I_F1U, I_F1D, I_MIXN, I_WIN, I_CONVW, I_CONVB, I_LWA, I_LBA, I_LWX, I_LBX,
       I_LLAM, I_IFB, I_MNORM, I_MU, I_W0, I_W2, I_A0, I_A2, I_G2, I_KK, I_KA, I_RK, I_LNW, I_LNB, I_WBR, I_WOUT, I_F2N, I_F2G, I_F2U, I_F2D, I_FN, N_IN };

struct Args { const float* in[N_IN]; float* out; unsigned char* ws; int ph_lo, ph_hi; };

constexpr int TAB_OFF = LDS_BYTES - 512;
struct Ctx {
    float* out; unsigned char* ws; LAS unsigned char* lds;
    int tid, lane, wave, G, bid, dry;
};

__device__ __forceinline__ const float* inp(const Ctx& c, int i) {
    const LAS unsigned* t = (const LAS unsigned*)(c.lds + TAB_OFF);
    const unsigned lo = __builtin_amdgcn_readfirstlane(t[2 * i]), hi = __builtin_amdgcn_readfirstlane(t[2 * i + 1]);
    typedef const float __attribute__((address_space(1)))* gptr_t;
    return (const float*)(gptr_t)(((unsigned long long)hi << 32) | (unsigned long long)lo);
}
#define GAS __attribute__((address_space(1)))
__device__ __forceinline__ unsigned char* wsg(const Ctx& c) { return (unsigned char*)(GAS unsigned char*)(unsigned long long)c.ws; }
__device__ __forceinline__ float* outg(const Ctx& c) { return (float*)(GAS float*)(unsigned long long)c.out; }
__device__ __forceinline__ float bf2f(bf16_t b) { return __uint_as_float(((unsigned)b) << 16); }
__device__ __forceinline__ float bflo(unsigned w) { return __uint_as_float(w << 16); }
__device__ __forceinline__ float bfhi(unsigned w) { return __uint_as_float(w & 0xffff0000u); }
__device__ __forceinline__ bf16_t f2bf(float f) { unsigned u = __float_as_uint(f); u += 0x7FFFu + ((u >> 16) & 1u); return (bf16_t)(u >> 16); }
typedef __bf16 bf16v2_t __attribute__((ext_vector_type(2)));
typedef float f32v2_t __attribute__((ext_vector_type(2)));
__device__ __forceinline__ unsigned pk2(float lo, float hi) {
    const f32v2_t f = {lo, hi}; const bf16v2_t b = __builtin_convertvector(f, bf16v2_t); return __builtin_bit_cast(unsigned, b);
}
__device__ __forceinline__ void unpack8(const u32x4 w, float (&f)[8]) { f[0] = bflo(w.x); f[1] = bfhi(w.x); f[2] = bflo(w.y); f[3] = bfhi(w.y); f[4] = bflo(w.z); f[5] = bfhi(w.z); f[6] = bflo(w.w); f[7] = bfhi(w.w); }
__device__ __forceinline__ u32x4 pack8(const float (&f)[8]) { u32x4 w; w.x = pk2(f[0], f[1]); w.y = pk2(f[2], f[3]); w.z = pk2(f[4], f[5]); w.w = pk2(f[6], f[7]); return w; }
__device__ __forceinline__ float sigmoidf_(float x) { return __builtin_amdgcn_rcpf(1.0f + __expf(-x)); }
__device__ __forceinline__ float siluf_(float x) { return x * __builtin_amdgcn_rcpf(1.0f + __expf(-x)); }
__device__ __forceinline__ float softplusf_(float x) { return fmaxf(x, 0.f) + __logf(1.0f + __expf(-fabsf(x))); }
__device__ __forceinline__ float tanhf_(float x) { return 1.0f - 2.0f * __builtin_amdgcn_rcpf(__expf(2.0f * x) + 1.0f); }
__device__ __forceinline__ float wsum(float v) {
#pragma unroll
    for (int o = 32; o >= 1; o >>= 1) v += __shfl_xor(v, o);
    return v;
}

__device__ __forceinline__ int pass_rows(int p) { return p ? 16640 : 16384; }
__device__ __forceinline__ int pass_nseg(int p) { return p ? 272 : 256; }
__device__ __forceinline__ int pass_nseq(int p) { return p ? 18 : 2; }
struct Seq { int row0, T, sample, b; };
__device__ __forceinline__ Seq seq_of(int p, int q) { Seq s; if (q < 2) { s.row0 = q * SEQ; s.T = SEQ; s.sample = 0; s.b = 2 * p + q; } else { s.row0 = 16384 + (q - 2) * DSEQ; s.T = DSEQ; s.sample = 1; s.b = q - 2; } return s; }
struct Seg { int q, c, row0, n, nch; };
__device__ __forceinline__ Seg seg_of(int s) { Seg g; if (s < 256) { g.q = s >> 7; g.c = s & 127; g.row0 = g.q * SEQ + g.c * 64; g.n = 64; g.nch = 128; } else { g.q = 2 + (s - 256); g.c = 0; g.row0 = 16384 + (s - 256) * DSEQ; g.n = DSEQ; g.nch = 1; } return g; }

__device__ __forceinline__ void grid_bar(unsigned* bar, unsigned& epoch, unsigned G) {
    __syncthreads();
    epoch += 1u;
    if (threadIdx.x == 0) {
        const unsigned ng = (G & 7u) ? 1u : 8u, grp = blockIdx.x % ng, per = G / ng;
        unsigned* xc = bar + 64 + 64 * grp;
        const unsigned old = __hip_atomic_fetch_add(xc, 1u, __ATOMIC_RELEASE, __HIP_MEMORY_SCOPE_AGENT);
        if (old + 1u == epoch * per) __hip_atomic_fetch_add(bar, 1u, __ATOMIC_RELEASE, __HIP_MEMORY_SCOPE_AGENT);
        const unsigned target = epoch * ng;
        while (__hip_atomic_load(bar, __ATOMIC_RELAXED, __HIP_MEMORY_SCOPE_AGENT) < target) __builtin_amdgcn_s_sleep(1);
        __builtin_amdgcn_fence(__ATOMIC_ACQUIRE, "agent");
        asm volatile("s_waitcnt vmcnt(0)" ::: "memory");
    }
    __syncthreads();
}

struct EpiSwiglu {
    static constexpr bool PERM = true, AFTER_DRAIN = false;
    bf16_t* H;
    __device__ __forceinline__ void operator()(const f32x4 (&acc)[2][2][4][2], const pg8::Unit& u, int wr, int wc, int fr, int fq) const {
        const int row0 = u.pm * 256 + wr * 64 + fr, col0 = u.pn * 128 + wc * 32 + 8 * fq;
#pragma unroll
        for (int ai = 0; ai < 2; ++ai)
#pragma unroll
            for (int m = 0; m < 4; ++m) {
                float o[8];
#pragma unroll
                for (int n = 0; n < 2; ++n)
#pragma unroll
                    for (int j = 0; j < 4; ++j) o[4 * n + j] = siluf_(acc[ai][0][m][n][j]) * acc[ai][1][m][n][j];
                *(u32x4*)(H + (size_t)(row0 + ai * 128 + m * 16) * FF + col0) = pack8(o);
            }
    }
};
struct EpiResAdd {
    static constexpr bool PERM = false, AFTER_DRAIN = false;
    float* X; const float* Xin; float s;
    __device__ __forceinline__ void operator()(const f32x4 (&acc)[2][2][4][2], const pg8::Unit& u, int wr, int wc, int fr, int fq) const {
        const int row0 = u.pm * 256 + wr * 64 + fr, col0 = u.pn * 256 + wc * 32 + 4 * fq;
#pragma unroll
        for (int ai = 0; ai < 2; ++ai)
#pragma unroll
            for (int m = 0; m < 4; ++m) {
                const size_t off = (size_t)(row0 + ai * 128 + m * 16) * D + col0;
#pragma unroll
                for (int bj = 0; bj < 2; ++bj)
#pragma unroll
                    for (int n = 0; n < 2; ++n) { const f32x4 r = *(const f32x4*)(Xin + off + bj * 128 + n * 16); *(f32x4*)(X + off + bj * 128 + n * 16) = r + acc[ai][bj][m][n] * s; }
            }
    }
};
struct EpiResAddAtomic {
    static constexpr bool PERM = false, AFTER_DRAIN = false;
    float* X; float s;
    __device__ __forceinline__ void operator()(const f32x4 (&acc)[2][2][4][2], const pg8::Unit& u, int wr, int wc, int fr, int fq) const {
        const int row0 = u.pm * 256 + wr * 64 + fr, col0 = (u.pn & 3) * 256 + wc * 32 + 4 * fq;
#pragma unroll
        for (int ai = 0; ai < 2; ++ai)
#pragma unroll
            for (int m = 0; m < 4; ++m) {
                float* rowp = X + (size_t)(row0 + ai * 128 + m * 16) * D + col0;
#pragma unroll
                for (int bj = 0; bj < 2; ++bj)
#pragma unroll
                    for (int n = 0; n < 2; ++n)
#pragma unroll
                        for (int j = 0; j < 4; ++j) __hip_atomic_fetch_add(rowp + bj * 128 + n * 16 + j, acc[ai][bj][m][n][j] * s, __ATOMIC_RELAXED, __HIP_MEMORY_SCOPE_AGENT);
            }
    }
};
struct EpiStore {
    static constexpr bool PERM = true, AFTER_DRAIN = false;
    bf16_t* O; int ldc, coff;
    __device__ __forceinline__ void operator()(const f32x4 (&acc)[2][2][4][2], const pg8::Unit& u, int wr, int wc, int fr, int fq) const {
        const int row0 = u.pm * 256 + wr * 64 + fr, col0 = coff + u.pn * 256 + wc * 32 + 8 * fq;
#pragma unroll
        for (int ai = 0; ai < 2; ++ai)
#pragma unroll
            for (int m = 0; m < 4; ++m) {
                bf16_t* rowp = O + (size_t)(row0 + ai * 128 + m * 16) * ldc + col0;
#pragma unroll
                for (int bj = 0; bj < 2; ++bj) {
                    u32x4 w; w.x = pk2(acc[ai][bj][m][0][0], acc[ai][bj][m][0][1]); w.y = pk2(acc[ai][bj][m][0][2], acc[ai][bj][m][0][3]);
                    w.z = pk2(acc[ai][bj][m][1][0], acc[ai][bj][m][1][1]); w.w = pk2(acc[ai][bj][m][1][2], acc[ai][bj][m][1][3]);
                    *(u32x4*)(rowp + bj * 128) = w;
                }
            }
    }
};
struct EpiMerge {
    static constexpr bool PERM = true, AFTER_DRAIN = false;
    bf16_t* Mb; const bf16_t* Z; int goff, first;
    __device__ __forceinline__ void operator()(const f32x4 (&acc)[2][2][4][2], const pg8::Unit& u, int wr, int wc, int fr, int fq) const {
        const int row0 = u.pm * 256 + wr * 64 + fr, col0 = u.pn * 256 + wc * 32 + 8 * fq;
#pragma unroll
        for (int ai = 0; ai < 2; ++ai)
#pragma unroll
            for (int m = 0; m < 4; ++m) {
                const size_t row = (size_t)(row0 + ai * 128 + m * 16);
#pragma unroll
                for (int bj = 0; bj < 2; ++bj) {
                    float gt[8], mv[8], o[8];
                    unpack8(*(const u32x4*)(Z + row * ZW + goff + col0 + bj * 128), gt);
                    if (!first) unpack8(*(const u32x4*)(Mb + row * D + col0 + bj * 128), mv);
#pragma unroll
                    for (int n = 0; n < 2; ++n)
#pragma unroll
                        for (int j = 0; j < 4; ++j) o[4 * n + j] = (first ? 0.f : mv[4 * n + j]) + sigmoidf_(gt[4 * n + j]) * acc[ai][bj][m][n][j];
                    *(u32x4*)(Mb + row * D + col0 + bj * 128) = pack8(o);
                }
            }
    }
};

template <class Epi>
__device__ __forceinline__ void run_gemm(const Ctx& c, const bf16_t* A, int lda, const bf16_t* Bt, int ldb, int M, int N, int K, int amod, int astride, const Epi& E) {
    pg8::Gemm g{A, lda, Bt, ldb, M, N, K, amod, astride, 0, 0};
    pg8::StaticOrder S; S.init(M, N, c.G, c.bid);
    pg8::gemm_phase<Epi, pg8::StaticOrder>(c.lds, g, S, E, c.tid);
    __syncthreads();
}

__device__ __forceinline__ void run_gemm_splitk(const Ctx& c, const bf16_t* A, int lda, const bf16_t* Bt, int ldb, int K, float* X, float sc) {
    pg8::Gemm g{A, lda, Bt, ldb, 256, 1024 * (K / 256), 256, 0, 0, 4, 256};
    pg8::StaticOrder S; S.init(256, 1024 * (K / 256), c.G, (c.bid + 128) % c.G);
    pg8::gemm_phase<EpiResAddAtomic, pg8::StaticOrder>(c.lds, g, S, EpiResAddAtomic{X, sc}, c.tid);
    __syncthreads();
}

__device__ __forceinline__ void phase_cvt(const Ctx& c, int l) {
    bf16_t* W = (bf16_t*)wsg(c);
    const int cum[11] = {0, 1408, 2112, 3520, 4224, 6336, 7104, 7232, 7424, 8192, 8448};
    const int tid = c.tid;
    for (int t0 = c.bid * 4; t0 < 8448; t0 += c.G * 4) {
        bf16_t* dsts[4]; int ldds[4]; bool nz[4];
#pragma unroll
        for (int u = 0; u < 4; ++u) {
            const int t = t0 + u;
            int job = 0, base = 0;
#pragma unroll
            for (int j = 1; j < 10; ++j) if (t >= cum[j]) { job = j; base = cum[j]; }
            const int tt = t - base;
            const float* src = nullptr; int ld = 0; bf16_t* dst = nullptr; int ldd = 0;
            if (job == 0 || job == 2) {
                const int tn = tt >> 4, tk = tt & 15, n0 = tn * 64, k0 = tk * 64, pn = n0 >> 8, bj = (n0 >> 7) & 1, cc = n0 & 127;
                const float* g = inp(c, job == 0 ? I_F1G : I_F2G); const float* up = inp(c, job == 0 ? I_F1U : I_F2U);
                src = (bj ? up : g) + (size_t)l * D * FF + (size_t)k0 * FF + 128 * pn + cc; ld = FF;
                dst = W + (job == 0 ? W_GU1 : W_GU2) / 2 + (size_t)n0 * D + k0; ldd = D;
            } else if (job == 1 || job == 3) {
                const int tn = tt / 44, tk = tt % 44, n0 = tn * 64, k0 = tk * 64;
                src = inp(c, job == 1 ? I_F1D : I_F2D) + (size_t)l * FF * D + (size_t)k0 * D + n0; ld = D;
                dst = W + (job == 1 ? W_D1 : W_D2) / 2 + (size_t)n0 * FF + k0; ldd = FF;
            } else if (job == 4) {
                const int tn = tt >> 4, tk = tt & 15, n0 = tn * 64, k0 = tk * 64, col = n0 < 5120 ? n0 : n0 + 8;
                src = inp(c, I_WIN) + (size_t)l * D * INW + (size_t)k0 * INW + col; ld = INW;
                dst = W + W_IN / 2 + (size_t)n0 * D + k0; ldd = D;
            } else if (job == 5) {
                const int tn = tt >> 4, tk = tt & 15, n0 = tn * 64, k0 = tk * 64;
                src = inp(c, I_WIN) + (size_t)l * D * INW + (size_t)k0 * INW + 8456 + n0; ld = INW;
                dst = W + W_G / 2 + (size_t)n0 * D + k0; ldd = D;
            } else if (job == 6) {
                const int tn = tt >> 2, tk = tt & 3, n0 = tn * 64, k0 = tk * 64, which = n0 >> 10, nn = n0 & 1023, blk = nn >> 7, j0 = nn & 127, kblk = k0 >> 7, i0 = k0 & 127;
                if (kblk == (blk & 1)) { src = inp(c, which ? I_LWX : I_LWA) + (size_t)l * 8 * 128 * 128 + (size_t)blk * 128 * 128 + (size_t)i0 * 128 + j0; ld = 128; }
                dst = W + W_LRU / 2 + (size_t)n0 * 256 + k0; ldd = 256;
            } else if (job == 7) {
                const int tn = tt >> 2, tk = tt & 3, n0 = tn * 64, k0 = tk * 64;
                if (n0 < 1024) { if (tk == 0) { src = inp(c, I_W2) + (size_t)l * 64 * D + n0; ld = D; } }
                else if (n0 < 2048) { if (tk == 1) { src = inp(c, I_A2) + (size_t)l * 64 * D + (n0 - 1024); ld = D; } }
                else { if (tk >= 2) { src = inp(c, I_G2) + (size_t)l * 128 * D + (size_t)(k0 - 128) * D + (n0 - 2048); ld = D; } }
                dst = W + W_LORA / 2 + (size_t)n0 * 256 + k0; ldd = 256;
            } else if (job == 8) {
                const int tn = tt >> 4, tk = tt & 15, n0 = tn * 64, k0 = tk * 64, b = n0 >> 10, nn = n0 & 1023;
                src = inp(c, I_WBR) + (size_t)l * 3 * D * D + (size_t)b * D * D + (size_t)k0 * D + nn; ld = D;
                dst = W + W_BR / 2 + (size_t)n0 * D + k0; ldd = D;
            } else {
                const int tn = tt >> 4, tk = tt & 15, n0 = tn * 64, k0 = tk * 64;
                src = inp(c, I_WOUT) + (size_t)l * D * D + (size_t)k0 * D + n0; ld = D;
                dst = W + W_OUT / 2 + (size_t)n0 * D + k0; ldd = D;
            }

            dsts[u] = dst; ldds[u] = ldd; nz[u] = (src != nullptr);
            LAS float* tile = (LAS float*)c.lds + u * (64 * 65);
            if (src) {
                const int i = tid >> 4, j4 = tid & 15;
#pragma unroll
                for (int r = 0; r < 2; ++r) { const int k = i + 32 * r; const f32x4 v = *(const f32x4*)(src + (size_t)k * ld + 4 * j4);
                    tile[k * 65 + 4 * j4 + 0] = v[0]; tile[k * 65 + 4 * j4 + 1] = v[1]; tile[k * 65 + 4 * j4 + 2] = v[2]; tile[k * 65 + 4 * j4 + 3] = v[3]; }
            }
        }
        __syncthreads();
#pragma unroll
        for (int u = 0; u < 4; ++u) {
            const LAS float* tile = (const LAS float*)c.lds + u * (64 * 65);
            const int n = tid >> 3, kq = tid & 7; float f[8];
#pragma unroll
            for (int e = 0; e < 8; ++e) f[e] = nz[u] ? tile[(8 * kq + e) * 65 + n] : 0.f;
            *(u32x4*)(dsts[u] + (size_t)n * ldds[u] + 8 * kq) = pack8(f);
        }
        __syncthreads();
    }
    float* wif = (float*)(wsg(c) + W_IF);
    for (int i = c.bid * NTHREADS + c.tid; i < D * 8; i += c.G * NTHREADS) wif[i] = inp(c, I_WIN)[(size_t)l * D * INW + (size_t)(i >> 3) * INW + 5120 + (i & 7)];
}

__device__ __forceinline__ void phase_norm(const Ctx& c, const float* xin_p, const float* xin_s, float* X, int grow0, int nrows, const float* gamma, bf16_t* dst, const float* wif, float* gif) {
    const int lane = c.lane;
    f32x4 gm[4];
#pragma unroll
    for (int i = 0; i < 4; ++i) gm[i] = *(const f32x4*)(gamma + 256 * i + 4 * lane);
    for (int r = c.bid * 8 + c.wave; r < nrows; r += c.G * 8) {
        const int gr = grow0 + r;
        const float* src = xin_p ? (gr < NPROMPT ? xin_p + (size_t)gr * D : xin_s + (size_t)(gr - NPROMPT) * D) : X + (size_t)gr * D;
        f32x4 v[4]; float ss = 0.f;
#pragma unroll
        for (int i = 0; i < 4; ++i) { v[i] = *(const f32x4*)(src + 256 * i + 4 * lane); ss += v[i][0] * v[i][0] + v[i][1] * v[i][1] + v[i][2] * v[i][2] + v[i][3] * v[i][3]; }
        if (xin_p && gr >= NPROMPT) {
#pragma unroll
            for (int i = 0; i < 4; ++i) *(f32x4*)(X + (size_t)gr * D + 256 * i + 4 * lane) = v[i];
        }
        ss = wsum(ss);
        const float rstd = __builtin_amdgcn_rsqf(ss * (1.0f / D) + 1e-6f);
#pragma unroll
        for (int i = 0; i < 4; ++i) {
            v[i] = v[i] * rstd * gm[i];
            u32x2 w; w.x = pk2(v[i][0], v[i][1]); w.y = pk2(v[i][2], v[i][3]);
            *(u32x2*)(dst + (size_t)r * D + 256 * i + 4 * lane) = w;
        }
        if (gif) {
            float a8[8];
#pragma unroll
            for (int j = 0; j < 8; ++j) a8[j] = 0.f;
#pragma unroll
            for (int i = 0; i < 4; ++i)
#pragma unroll
                for (int e = 0; e < 4; ++e) {
                    const float* wp = wif + (size_t)(256 * i + 4 * lane + e) * 8; const f32x4 w0 = *(const f32x4*)wp, w1 = *(const f32x4*)(wp + 4);
                    a8[0] += v[i][e] * w0[0]; a8[1] += v[i][e] * w0[1]; a8[2] += v[i][e] * w0[2]; a8[3] += v[i][e] * w0[3];
                    a8[4] += v[i][e] * w1[0]; a8[5] += v[i][e] * w1[1]; a8[6] += v[i][e] * w1[2]; a8[7] += v[i][e] * w1[3];
                }
#pragma unroll
            for (int j = 0; j < 8; ++j) a8[j] = wsum(a8[j]);
            if (lane == 0) {
#pragma unroll
                for (int j = 0; j < 8; ++j) gif[(size_t)r * 8 + j] = a8[j];
            }
        }
    }
}
__device__ __forceinline__ void phase_final_norm(const Ctx& c, float* X, const float* gamma) {
    const int lane = c.lane;
    f32x4 gm[4];
#pragma unroll
    for (int i = 0; i < 4; ++i) gm[i] = *(const f32x4*)(gamma + 256 * i + 4 * lane);
    for (int r = c.bid * 8 + c.wave; r < NTOK; r += c.G * 8) {
        f32x4 v[4]; float ss = 0.f;
#pragma unroll
        for (int i = 0; i < 4; ++i) { v[i] = *(const f32x4*)(X + (size_t)r * D + 256 * i + 4 * lane); ss += v[i][0] * v[i][0] + v[i][1] * v[i][1] + v[i][2] * v[i][2] + v[i][3] * v[i][3]; }
        ss = wsum(ss);
        const float rstd = __builtin_amdgcn_rsqf(ss * (1.0f / D) + 1e-6f);
#pragma unroll
        for (int i = 0; i < 4; ++i) *(f32x4*)(X + (size_t)r * D + 256 * i + 4 * lane) = v[i] * rstd * gm[i];
    }
}

__device__ __forceinline__ void phase_cv1(const Ctx& c, int p, int l) {
    const bf16_t* Z = (const bf16_t*)(wsg(c) + WS_Z); bf16_t* H = (bf16_t*)(wsg(c) + WS_HALO);
    const int nseg = pass_nseg(p), gt = c.bid * NTHREADS + c.tid, gs = c.G * NTHREADS;
    for (int i = gt; i < nseg * 3168; i += gs) {
        const int s = i / 3168, pc = i % 3168, r = pc / 1056, cc = pc % 1056; const Seg g = seg_of(s);
        *(u32x4*)(H + ((size_t)s * 3 + r) * ZW + 8 * cc) = *(const u32x4*)(Z + (size_t)(g.row0 + g.n - 3 + r) * ZW + 8 * cc);
    }
    const int nseq = pass_nseq(p);
    for (int i = gt; i < nseq * 12544; i += gs) {
        const int q = i / 12544, e = i % 12544; const Seq sq = seq_of(p, q);
        if (e < 9216) { const int r = e / 3072, ch = e % 3072;
            float* o = outg(c) + (sq.sample ? O_SCONV + ((size_t)l * DB + sq.b) * 9216 : O_PCONV + ((size_t)l * NB + sq.b) * 9216);
            o[e] = bf2f(Z[(size_t)(sq.row0 + sq.T - 3 + r) * ZW + ch]);
        } else { const int j = e - 9216;
            float* o = outg(c) + (sq.sample ? O_SSH + ((size_t)l * DB + sq.b) * RIN : O_PSH + ((size_t)l * NB + sq.b) * RIN);
            o[j] = bf2f(Z[(size_t)(sq.row0 + sq.T - 1) * ZW + C_R + j]);
        }
    }
}
__device__ __forceinline__ void phase_cv2(const Ctx& c, int p, int l) {
    bf16_t* Z = (bf16_t*)(wsg(c) + WS_Z); const bf16_t* H = (const bf16_t*)(wsg(c) + WS_HALO);
    const int nseg = pass_nseg(p), gt = c.bid * NTHREADS + c.tid, gs = c.G * NTHREADS;
    for (int i = gt; i < nseg * 800; i += gs) {
        const int s = i / 800, cgp = i % 800; const Seg g = seg_of(s); const Seq sq = seq_of(p, g.q);
        if (cgp < 384) {
            const int col = 8 * cgp;
            float p0[8], p1[8], p2[8], w0[8], w1[8], w2[8], w3[8], bb[8];
            const float* cw = inp(c, I_CONVW) + (size_t)l * 4 * CONVCH + col; const float* cb = inp(c, I_CONVB) + (size_t)l * CONVCH + col;
#pragma unroll
            for (int j = 0; j < 8; ++j) { w0[j] = cw[j]; w1[j] = cw[CONVCH + j]; w2[j] = cw[2 * CONVCH + j]; w3[j] = cw[3 * CONVCH + j]; bb[j] = cb[j]; }
            if (g.c > 0) { unpack8(*(const u32x4*)(H + ((size_t)(s - 1) * 3 + 0) * ZW + col), p0); unpack8(*(const u32x4*)(H + ((size_t)(s - 1) * 3 + 1) * ZW + col), p1); unpack8(*(const u32x4*)(H + ((size_t)(s - 1) * 3 + 2) * ZW + col), p2); }
            else if (sq.sample) { const float* st = inp(c, I_SCONV) + ((size_t)l * DB + sq.b) * 3 * CONVCH + col;
#pragma unroll
                for (int j = 0; j < 8; ++j) { p0[j] = st[j]; p1[j] = st[CONVCH + j]; p2[j] = st[2 * CONVCH + j]; } }
            else {
#pragma unroll
                for (int j = 0; j < 8; ++j) { p0[j] = 0.f; p1[j] = 0.f; p2[j] = 0.f; } }
            const int mode = col < 1024 ? 0 : (col < 2048 ? 1 : 2);
            for (int t4 = 0; t4 < g.n; t4 += 4) {
                u32x4 raw[4];
#pragma unroll
                for (int u = 0; u < 4; ++u) raw[u] = *(const u32x4*)(Z + (size_t)(g.row0 + t4 + u) * ZW + col);
#pragma unroll
                for (int u = 0; u < 4; ++u) {
                    bf16_t* zp = Z + (size_t)(g.row0 + t4 + u) * ZW + col; float x[8], y[8];
                    unpack8(raw[u], x);
#pragma unroll
                    for (int j = 0; j < 8; ++j) { float v = bb[j] + p0[j] * w0[j]; v += p1[j] * w1[j]; v += p2[j] * w2[j]; v += x[j] * w3[j];
                        if (mode == 1) v = siluf_(v); else if (mode == 2) v = siluf_(v) * 0.0625f;
                        y[j] = v; p0[j] = p1[j]; p1[j] = p2[j]; p2[j] = x[j]; }
                    *(u32x4*)zp = pack8(y);
                }
            }
        } else {
            const int j0 = 8 * (cgp - 384), col = C_R + j0;
            float pv[8], mu[8];
            const float* mp = inp(c, I_MU) + (size_t)l * RIN + j0;
#pragma unroll
            for (int j = 0; j < 8; ++j) mu[j] = mp[j];
            if (g.c > 0) unpack8(*(const u32x4*)(H + ((size_t)(s - 1) * 3 + 2) * ZW + col), pv);
            else if (sq.sample) { const float* st = inp(c, I_SSH) + ((size_t)l * DB + sq.b) * RIN + j0;
#pragma unroll
                for (int j = 0; j < 8; ++j) pv[j] = st[j]; }
            else {
#pragma unroll
                for (int j = 0; j < 8; ++j) pv[j] = 0.f; }
            const int mode = (j0 >= 3072 && j0 < 3136) ? 1 : (j0 >= 3200 ? 2 : 0);
            for (int t4 = 0; t4 < g.n; t4 += 4) {
                u32x4 raw[4];
#pragma unroll
                for (int u = 0; u < 4; ++u) raw[u] = *(const u32x4*)(Z + (size_t)(g.row0 + t4 + u) * ZW + col);
#pragma unroll
                for (int u = 0; u < 4; ++u) {
                    bf16_t* zp = Z + (size_t)(g.row0 + t4 + u) * ZW + col; float x[8], y[8];
                    unpack8(raw[u], x);
#pragma unroll
                    for (int j = 0; j < 8; ++j) { float v = x[j] + (pv[j] - x[j]) * mu[j];
                        if (mode == 1) v = tanhf_(v); else if (mode == 2) v = sigmoidf_(v);
                        y[j] = v; pv[j] = x[j]; }
                    *(u32x4*)zp = pack8(y);
                }
            }
        }
    }
}

template <int FINAL>
__device__ __forceinline__ void phase_lru(const Ctx& c, int p, int l) {
    bf16_t* Z = (bf16_t*)(wsg(c) + WS_Z); const bf16_t* T = (const bf16_t*)(wsg(c) + WS_T); float* car = (float*)(wsg(c) + WS_CAR);
    const int nseg = pass_nseg(p), gt = c.bid * NTHREADS + c.tid, gs = c.G * NTHREADS;
    for (int i = gt; i < nseg * 128; i += gs) {
        const int s = i >> 7, ch = 8 * (i & 127); const Seg g = seg_of(s); const Seq sq = seq_of(p, g.q);
        float ba[8], bx[8], c1[8], A[8], B[8];
#pragma unroll
        for (int j = 0; j < 8; ++j) { ba[j] = inp(c, I_LBA)[(size_t)l * D + ch + j]; bx[j] = inp(c, I_LBX)[(size_t)l * D + ch + j]; c1[j] = -8.0f * softplusf_(-inp(c, I_LLAM)[(size_t)l * D + ch + j]); A[j] = 1.f; B[j] = 0.f; }
        if (FINAL) {
            if (sq.sample) {
#pragma unroll
                for (int j = 0; j < 8; ++j) B[j] = inp(c, I_SLRU)[((size_t)l * DB + sq.b) * D + ch + j]; }
            for (int cp = 0; cp < g.c; ++cp) { const float* ca = car + (size_t)(s - g.c + cp) * 2048 + ch;
#pragma unroll
                for (int j = 0; j < 8; ++j) B[j] = ca[j] * B[j] + ca[1024 + j]; }
        }
        for (int t4 = 0; t4 < g.n; t4 += 4) {
          u32x4 rx[4], rr[4], ri[4];
#pragma unroll
          for (int u = 0; u < 4; ++u) { const size_t row = (size_t)(g.row0 + t4 + u); rx[u] = *(const u32x4*)(Z + row * ZW + C_LRU + ch); rr[u] = *(const u32x4*)(T + row * 2048 + ch); ri[u] = *(const u32x4*)(T + row * 2048 + 1024 + ch); }
#pragma unroll
          for (int u = 0; u < 4; ++u) {
            const size_t row = (size_t)(g.row0 + t4 + u); float x[8], rp[8], ip[8];
            unpack8(rx[u], x); unpack8(rr[u], rp); unpack8(ri[u], ip);
#pragma unroll
            for (int j = 0; j < 8; ++j) { const float la = c1[j] * sigmoidf_(rp[j] + ba[j]), a = __expf(la), bt = __builtin_amdgcn_sqrtf(fmaxf(1.0f - __expf(2.0f * la), 0.f)) * sigmoidf_(ip[j] + bx[j]) * x[j];
                B[j] = a * B[j] + bt; A[j] *= a; x[j] = B[j]; }
            if (FINAL) *(u32x4*)(Z + row * ZW + C_LRU + ch) = pack8(x);
          }
        }
        if (!FINAL) { float* ca = car + (size_t)s * 2048 + ch;
#pragma unroll
            for (int j = 0; j < 8; ++j) { ca[j] = A[j]; ca[1024 + j] = B[j]; } }
        else if (g.c == g.nch - 1) { float* o = outg(c) + (sq.sample ? O_SLRU + ((size_t)l * DB + sq.b) * D : O_PLRU + ((size_t)l * NB + sq.b) * D) + ch;
#pragma unroll
            for (int j = 0; j < 8; ++j) o[j] = B[j]; }
    }
}

__device__ __forceinline__ f32x4 mma_tile(const LAS bf16_t* A, int lda, const LAS bf16_t* Bt, int ldb, int K, f32x4 acc, int lane) {
    const LAS bf16_t* pa = A + (lane & 15) * lda + (lane >> 4) * 8; const LAS bf16_t* pb = Bt + (lane & 15) * ldb + (lane >> 4) * 8;
    for (int k = 0; k < K; k += 32) { const bf16x8 a = *(const LAS bf16x8*)(pa + k); const bf16x8 b = *(const LAS bf16x8*)(pb + k); acc = __builtin_amdgcn_mfma_f32_16x16x32_bf16(a, b, acc, 0, 0, 0); }
    return acc;
}

__device__ __forceinline__ void phase_mlstm_s(const Ctx& c, int p, int l) {
    const bf16_t* Z = (const bf16_t*)(wsg(c) + WS_Z); const float* gif = (const float*)(wsg(c) + WS_GIF); bf16_t* SL = (bf16_t*)(wsg(c) + WS_SL);
    int tid = c.tid, lane = c.lane; const int w = c.wave;
    const int nitems = p ? 1088 : 1024;
    for (int item = c.bid; item < nitems; item += c.G) {
        asm volatile("" : "+v"(tid), "+v"(lane));
        LAS unsigned char* L = c.lds; asm volatile("" : "+v"(L));
        LAS bf16_t* Qs = (LAS bf16_t*)(L); LAS bf16_t* Ks = (LAS bf16_t*)(L + 33792); LAS bf16_t* St = (LAS bf16_t*)(L + 67584);
        LAS float* bcum = (LAS float*)(L + 76800); LAS float* igs = bcum + 64; LAS float* mloc = bcum + 128;
        int q, h, rbase, nvalid;
        if (item < 1024) { q = item >> 9; h = (item >> 7) & 3; rbase = q * SEQ + (item & 127) * 64; nvalid = 64; }
        else { const int sid = item - 1024; q = 2 + (sid >> 2); h = sid & 3; rbase = 16384 + (sid >> 2) * DSEQ; nvalid = DSEQ; }
        const float bi = inp(c, I_IFB)[l * 8 + h], bf = inp(c, I_IFB)[l * 8 + 4 + h];
#pragma unroll
        for (int i = 0; i < 4; ++i) {
            const int piece = tid + 512 * i, t = piece >> 5, pc = piece & 31; u32x4 qv = {0u, 0u, 0u, 0u}, kv = {0u, 0u, 0u, 0u};
            if (t < nvalid) { qv = *(const u32x4*)(Z + (size_t)(rbase + t) * ZW + C_Q + 256 * h + 8 * pc); kv = *(const u32x4*)(Z + (size_t)(rbase + t) * ZW + C_K + 256 * h + 8 * pc); }
            *(LAS u32x4*)(Qs + t * 264 + 8 * pc) = qv; *(LAS u32x4*)(Ks + t * 264 + 8 * pc) = kv;
        }
        if (w == 0) {
            const int t = lane; float ig = -1e30f, lf = 0.f;
            if (t < nvalid) { ig = gif[(size_t)(rbase + t) * 8 + h] + bi; const float gf = gif[(size_t)(rbase + t) * 8 + 4 + h] + bf; lf = fminf(gf, 0.f) - __logf(1.0f + __expf(-fabsf(gf))); }
            float bc = lf;
#pragma unroll
            for (int o = 1; o < 64; o <<= 1) { const float u = __shfl_up(bc, o); if (lane >= o) bc += u; }
            float cm = ig - bc;
#pragma unroll
            for (int o = 1; o < 64; o <<= 1) { const float u = __shfl_up(cm, o); if (lane >= o) cm = fmaxf(cm, u); }
            bcum[t] = bc; igs[t] = ig; mloc[t] = bc + cm;
        }
        __syncthreads();
        const int ti = w >> 1;
#pragma unroll
        for (int e = 0; e < 2; ++e) {
            const int sj = (w & 1) * 2 + e;
            f32x4 a = {0.f, 0.f, 0.f, 0.f};
            a = mma_tile(Qs + 16 * ti * 264, 264, Ks + 16 * sj * 264, 264, 256, a, lane);
#pragma unroll
            for (int r = 0; r < 4; ++r) {
                const int t = 16 * ti + (lane >> 4) * 4 + r, s2 = 16 * sj + (lane & 15);
                const float wg = (s2 <= t && t < nvalid) ? __expf(bcum[t] - bcum[s2] + igs[s2] - mloc[t]) : 0.f;
                St[t * 72 + s2] = f2bf(a[r] * wg);
            }
        }
        __syncthreads();
        { const int row = tid >> 3, pc = tid & 7; *(u32x4*)(SL + (size_t)item * 4096 + row * 64 + 8 * pc) = *(const LAS u32x4*)(St + row * 72 + 8 * pc); }
        __syncthreads();
    }
}

__device__ __forceinline__ void mlstm_task(const Ctx& c, int p, int l, int q, int h, int slab) {
    bf16_t* Z = (bf16_t*)(wsg(c) + WS_Z); const float* gif = (const float*)(wsg(c) + WS_GIF);
    const bf16_t* SLp = (const bf16_t*)(wsg(c) + WS_SL) + (size_t)(q < 2 ? q * 512 + h * 128 : 1024 + (q - 2) * 4 + h) * 4096 + (c.tid >> 3) * 64 + 8 * (c.tid & 7);
    const Seq sq = seq_of(p, q); const int tid = c.tid, lane = c.lane, w = c.wave;
    LAS bf16_t* Qs = (LAS bf16_t*)(c.lds); LAS bf16_t* Ks = (LAS bf16_t*)(c.lds + 33792); LAS bf16_t* KT = (LAS bf16_t*)(c.lds + 67584); LAS bf16_t* VT = (LAS bf16_t*)(c.lds + 104448);
    LAS bf16_t* VgT = (LAS bf16_t*)(c.lds + 109200); LAS bf16_t* Cs = (LAS bf16_t*)(c.lds + 113952); LAS bf16_t* St = (LAS bf16_t*)(c.lds + 131376);
    LAS float* sc = (LAS float*)(c.lds + 140592);
    LAS float* bcum = sc; LAS float* igs = sc + 64; LAS float* mts = sc + 128; LAS float* wint = sc + 192; LAS float* gsrc = sc + 256; LAS float* dd = sc + 320; LAS float* misc = sc + 384; LAS float* esc = sc + 392;
    const int nvalid = sq.sample ? DSEQ : 64, nch = sq.sample ? 1 : SEQ / 64;
    const float bi = inp(c, I_IFB)[l * 8 + h], bf = inp(c, I_IFB)[l * 8 + 4 + h];
    f32x4 cacc[3][2];
#pragma unroll
    for (int vi = 0; vi < 3; ++vi)
#pragma unroll
        for (int e = 0; e < 2; ++e)
#pragma unroll
            for (int r = 0; r < 4; ++r) {
                const int vloc = 16 * vi + (lane >> 4) * 4 + r, d = 16 * (2 * w + e) + (lane & 15); float v0 = 0.f;
                if (sq.sample) { if (vloc < 32) v0 = inp(c, I_SMC)[(((size_t)l * DB + sq.b) * 4 + h) * 65536 + (size_t)(slab * 32 + vloc) * 256 + d];
                                 else if (vloc == 32) v0 = inp(c, I_SMN)[(((size_t)l * DB + sq.b) * 4 + h) * 256 + d]; }
                cacc[vi][e][r] = v0;
            }
    if (tid < 64) VT[32 * 72 + tid] = (bf16_t)0x3f80u;
    if (tid == 0) misc[0] = sq.sample ? inp(c, I_SMM)[((size_t)l * DB + sq.b) * 4 + h] : 0.f;
    unsigned zz = 0u; asm volatile("" : "+v"(zz)); const u32x4 zv = {zz, zz, zz, zz};
    u32x4 pq[4], pk[4], pvv = zv, psl = zv; float pgi = 0.f, pgf = 0.f; int pfc = 0;
#define ML_PREFETCH(RB) do { psl = *(const u32x4*)(SLp + (size_t)pfc * 4096); ++pfc; \
        _Pragma("unroll") for (int i = 0; i < 4; ++i) { const int piece = tid + 512 * i, t = piece >> 5, pc = piece & 31; pq[i] = zv; pk[i] = zv; \
            if (t < nvalid) { pq[i] = *(const u32x4*)(Z + (size_t)((RB) + t) * ZW + C_Q + 256 * h + 8 * pc); pk[i] = *(const u32x4*)(Z + (size_t)((RB) + t) * ZW + C_K + 256 * h + 8 * pc); } } \
        if (tid < 256) { const int t = tid >> 2, pc = tid & 3; pvv = zv; if (t < nvalid) pvv = *(const u32x4*)(Z + (size_t)((RB) + t) * ZW + C_V + 256 * h + slab * 32 + 8 * pc); } \
        if (w == 0 && lane < nvalid) { pgi = gif[(size_t)((RB) + lane) * 8 + h]; pgf = gif[(size_t)((RB) + lane) * 8 + 4 + h]; } } while (0)
    ML_PREFETCH(sq.row0);
    __syncthreads();
    for (int ck = 0; ck < nch; ++ck) {
        const int rbase = sq.row0 + ck * 64;
#pragma unroll
        for (int i = 0; i < 4; ++i) {
            const int piece = tid + 512 * i, t = piece >> 5, pc = piece & 31;
            *(LAS u32x4*)(Qs + t * 264 + 8 * pc) = pq[i]; *(LAS u32x4*)(Ks + t * 264 + 8 * pc) = pk[i];
        }
        *(LAS u32x4*)(St + (tid >> 3) * 72 + 8 * (tid & 7)) = psl;
        if (tid < 256) {
            const int t = tid >> 2, pc = tid & 3; const u32x4 vv = pvv;
            const unsigned vw[4] = {vv.x, vv.y, vv.z, vv.w};
#pragma unroll
            for (int e = 0; e < 4; ++e) { VT[(8 * pc + 2 * e) * 72 + t] = (bf16_t)(vw[e] & 0xffffu); VT[(8 * pc + 2 * e + 1) * 72 + t] = (bf16_t)(vw[e] >> 16); }
        }
        if (w == 0) {
            const int t = lane; float ig = -1e30f, lf = 0.f;
            if (t < nvalid) { ig = pgi + bi; const float gf = pgf + bf; lf = fminf(gf, 0.f) - __logf(1.0f + __expf(-fabsf(gf))); }
            float bc = lf;
#pragma unroll
            for (int o = 1; o < 64; o <<= 1) { const float u = __shfl_up(bc, o); if (lane >= o) bc += u; }
            float cm = ig - bc;
#pragma unroll
            for (int o = 1; o < 64; o <<= 1) { const float u = __shfl_up(cm, o); if (lane >= o) cm = fmaxf(cm, u); }
            const float mprev = misc[0];
            const float mt = bc + fmaxf(mprev, cm);
            const float wi = __expf(bc + mprev - mt);
            const float bL = __shfl(bc, 63), mnew = __shfl(mt, 63);
            const float gs_ = __expf(bL - bc + ig - mnew);
            mts[t] = mt; wint[t] = wi; gsrc[t] = gs_; VgT[32 * 72 + t] = f2bf(gs_); esc[t] = __expf(cm - fmaxf(mprev, cm));
            if (lane == 0) { misc[1] = __expf(bL + mprev - mnew); misc[2] = mnew; }
        }
#pragma unroll
        for (int vi = 0; vi < 3; ++vi)
#pragma unroll
            for (int e = 0; e < 2; ++e)
#pragma unroll
                for (int r = 0; r < 4; ++r) { const int vloc = 16 * vi + (lane >> 4) * 4 + r; if (vloc <= 32) Cs[vloc * 264 + 16 * (2 * w + e) + (lane & 15)] = f2bf(cacc[vi][e][r]); }
        __syncthreads();
        if (ck + 1 < nch) ML_PREFETCH(rbase + 64);
#pragma unroll
        for (int i = 0; i < 2; ++i) {
            const int idx = tid + 512 * i, dp = idx & 127, so = idx >> 7; unsigned wv[8];
#pragma unroll
            for (int e = 0; e < 8; ++e) wv[e] = *(const LAS unsigned*)(Ks + (8 * so + e) * 264 + 2 * dp);
            u32x4 lo, hi;
            lo.x = (wv[0] & 0xffffu) | (wv[1] << 16); lo.y = (wv[2] & 0xffffu) | (wv[3] << 16); lo.z = (wv[4] & 0xffffu) | (wv[5] << 16); lo.w = (wv[6] & 0xffffu) | (wv[7] << 16);
            hi.x = (wv[0] >> 16) | (wv[1] & 0xffff0000u); hi.y = (wv[2] >> 16) | (wv[3] & 0xffff0000u); hi.z = (wv[4] >> 16) | (wv[5] & 0xffff0000u); hi.w = (wv[6] >> 16) | (wv[7] & 0xffff0000u);
            *(LAS u32x4*)(KT + (2 * dp) * 72 + 8 * so) = lo; *(LAS u32x4*)(KT + (2 * dp + 1) * 72 + 8 * so) = hi;
        }
#pragma unroll
        for (int i = 0; i < 4; ++i) { const int idx = tid + 512 * i, v = idx >> 6, s2 = idx & 63; VgT[v * 72 + s2] = f2bf(bf2f(VT[v * 72 + s2]) * gsrc[s2]); }
        const int ti = w >> 1;
        const int vj = w & 1;
        f32x4 qc = {0.f, 0.f, 0.f, 0.f}, qc2 = {0.f, 0.f, 0.f, 0.f};
        qc = mma_tile(Qs + 16 * ti * 264, 264, Cs + 16 * vj * 264, 264, 256, qc, lane);
        if (w < 4) qc2 = mma_tile(Qs + 16 * w * 264, 264, Cs + 32 * 264, 264, 256, qc2, lane);
        __syncthreads();
        f32x4 num = {0.f, 0.f, 0.f, 0.f};
        num = mma_tile(St + 16 * ti * 72, 72, VT + 16 * vj * 72, 72, 64, num, lane);
#pragma unroll
        for (int r = 0; r < 4; ++r) { const int t = 16 * ti + (lane >> 4) * 4 + r; num[r] = qc[r] * wint[t] + esc[t] * num[r]; }
        if (w < 4) {
            f32x4 sv2 = {0.f, 0.f, 0.f, 0.f};
            sv2 = mma_tile(St + 16 * w * 72, 72, VT + 32 * 72, 72, 64, sv2, lane);
#pragma unroll
            for (int r = 0; r < 4; ++r) { const int t = 16 * w + (lane >> 4) * 4 + r; qc2[r] = qc2[r] * wint[t] + esc[t] * sv2[r]; }
            if ((lane & 15) == 0) {
#pragma unroll
                for (int r = 0; r < 4; ++r) { const int t = 16 * w + (lane >> 4) * 4 + r; dd[t] = fmaxf(fabsf(qc2[r]), __expf(-mts[t])); }
            }
        }
        __syncthreads();
#pragma unroll
        for (int r = 0; r < 4; ++r) {
            const int t = 16 * ti + (lane >> 4) * 4 + r;
            if (t < nvalid) Z[(size_t)(rbase + t) * ZW + C_V + 256 * h + slab * 32 + 16 * vj + (lane & 15)] = f2bf(num[r] * __builtin_amdgcn_rcpf(dd[t]));
        }
        const float gs = misc[1];
#pragma unroll
        for (int vi = 0; vi < 3; ++vi)
#pragma unroll
            for (int e = 0; e < 2; ++e) { cacc[vi][e] = cacc[vi][e] * gs; cacc[vi][e] = mma_tile(VgT + 16 * vi * 72, 72, KT + 16 * (2 * w + e) * 72, 72, 64, cacc[vi][e], lane); }
        if (tid == 0) misc[0] = misc[2];
        __syncthreads();
    }
#undef ML_PREFETCH
    float* oc = outg(c) + (sq.sample ? O_SMC + (((size_t)l * DB + sq.b) * 4 + h) * 65536 : O_PMC + (((size_t)l * NB + sq.b) * 4 + h) * 65536);
#pragma unroll
    for (int vi = 0; vi < 2; ++vi)
#pragma unroll
        for (int e = 0; e < 2; ++e)
#pragma unroll
            for (int r = 0; r < 4; ++r) oc[(size_t)(slab * 32 + 16 * vi + (lane >> 4) * 4 + r) * 256 + 16 * (2 * w + e) + (lane & 15)] = cacc[vi][e][r];
    if (slab == 0) {
        if (lane < 16) {
            float* on = outg(c) + (sq.sample ? O_SMN + (((size_t)l * DB + sq.b) * 4 + h) * 256 : O_PMN + (((size_t)l * NB + sq.b) * 4 + h) * 256);
#pragma unroll
            for (int e = 0; e < 2; ++e) on[16 * (2 * w + e) + lane] = cacc[2][e][0];
        }
        if (tid == 0) outg(c)[(sq.sample ? O_SMM + ((size_t)l * DB + sq.b) * 4 + h : O_PMM + ((size_t)l * NB + sq.b) * 4 + h)] = misc[0];
    }
    __syncthreads();
}

constexpr int RS = 72;
__device__ __forceinline__ void rwkv_apply_tiles(int w, int lane, const LAS bf16_t* S0b, const LAS bf16_t* GTs, const LAS bf16_t* QTs, const LAS bf16_t* Hs, const LAS bf16_t* YHTs, LAS float* yT, f32x4 (&sacc)[4]) {
    if (w < 4) {
#pragma unroll
        for (int b = 0; b < 4; ++b) {
            f32x4 a = {0.f, 0.f, 0.f, 0.f};
            a = mma_tile(S0b + 16 * w * RS, RS, GTs + 16 * b * RS, RS, 64, a, lane);
#pragma unroll
            for (int r = 0; r < 4; ++r) a[r] += bf2f(Hs[(16 * w + (lane >> 4) * 4 + r) * RS + 16 * b + (lane & 15)]);
            sacc[b] = a;
        }
    } else {
        const int wi = w - 4;
#pragma unroll
        for (int b = 0; b < 4; ++b) {
            f32x4 a = {0.f, 0.f, 0.f, 0.f};
            a = mma_tile(S0b + 16 * wi * RS, RS, QTs + 16 * b * RS, RS, 64, a, lane);
            const int t = 16 * b + (lane & 15), i0 = 16 * wi + (lane >> 4) * 4;
            const u32x2 yh = *(const LAS u32x2*)(YHTs + t * RS + i0);
            yT[t * 65 + i0 + 0] = a[0] + bflo(yh.x); yT[t * 65 + i0 + 1] = a[1] + bfhi(yh.x); yT[t * 65 + i0 + 2] = a[2] + bflo(yh.y); yT[t * 65 + i0 + 3] = a[3] + bfhi(yh.y);
        }
    }
}
__device__ __forceinline__ void rwkv_post(int tid, const LAS float* yT, const LAS bf16_t* vblk, const LAS bf16_t* gblk, const LAS float* bon, const float (&lnw)[8], const float (&lnb)[8], bf16_t* zr, int nvalid) {
    const int t = tid >> 3, i0 = 8 * (tid & 7);
    float y[8], s = 0.f;
#pragma unroll
    for (int e = 0; e < 8; ++e) { y[e] = yT[t * 65 + i0 + e]; s += y[e]; }
    s += __shfl_xor(s, 1); s += __shfl_xor(s, 2); s += __shfl_xor(s, 4);
    const float mean = s * (1.0f / 64.0f); float qv = 0.f;
#pragma unroll
    for (int e = 0; e < 8; ++e) { y[e] -= mean; qv += y[e] * y[e]; }
    qv += __shfl_xor(qv, 1); qv += __shfl_xor(qv, 2); qv += __shfl_xor(qv, 4);
    const float rstd = __builtin_amdgcn_rsqf(qv * (1.0f / 64.0f) + 64e-5f), bo = bon[t];
    float vf[8], gf[8], o[8];
    unpack8(*(const LAS u32x4*)(vblk + t * RS + i0), vf); unpack8(*(const LAS u32x4*)(gblk + t * RS + i0), gf);
#pragma unroll
    for (int e = 0; e < 8; ++e) o[e] = (y[e] * rstd * lnw[e] + lnb[e] + bo * vf[e]) * gf[e];
    if (t < nvalid) *(u32x4*)(zr + (size_t)t * ZW + i0) = pack8(o);
}

constexpr int RA_At = 0, RA_Rt = 9216, RA_Bt = 18432, RA_Kt = 27648, RA_AtT = 36864, RA_BtT = 46080, RA_KtT = 55296, RA_VT = 64512, RA_Nf = 73728, RA_MinvT = 92160, RA_AakT = 101376,
              RA_AbrT = 110592, RA_AkrT = 119808, RA_WL = 129024, RA_SEG = 129280, RA_BON = 131328, RA_GB = 131584, RA_VB = 133888  ;
__device__ __forceinline__ void phase_rwkv_ra(const Ctx& c, int p, int l) {
    bf16_t* Z = (bf16_t*)(wsg(c) + WS_Z); bf16_t* T = (bf16_t*)(wsg(c) + WS_T); float* bonus_g = (float*)(wsg(c) + WS_BONUS);
    int tid = c.tid, lane = c.lane; const int w = c.wave;
#define LAUNDER2() asm volatile("" : "+v"(tid), "+v"(lane))
    const int nitems = p ? 4352 : 4096;
    u32x4 nx0, nx1, nx2, nx3, nx4; int have_pf = 0;
#define RA_PREFETCH(IT) do { have_pf = 0; if ((IT) < 4096 && (IT) < nitems && (IT) >= 0) { const int q_ = (IT) >> 11, rem_ = (IT) & 2047, h_ = rem_ & 15; \
        const size_t row_ = (size_t)(q_ * SEQ + (rem_ >> 4) * 64 + (tid >> 3)); const int col_ = 64 * h_ + 8 * (tid & 7); \
        nx0 = *(const u32x4*)(Z + row_ * ZW + C_R + col_); nx1 = *(const u32x4*)(Z + row_ * ZW + C_RK + col_); nx2 = *(const u32x4*)(Z + row_ * ZW + C_RV + col_); \
        nx3 = *(const u32x4*)(T + row_ * 3072 + col_); nx4 = *(const u32x4*)(T + row_ * 3072 + 1024 + col_); have_pf = 1; } } while (0)
    RA_PREFETCH(c.bid - 64);
    for (int item = c.bid - 64; item < nitems; item += c.G - 64) {
        LAUNDER2();
        LAS unsigned char* L = c.lds; asm volatile("" : "+v"(L));
    LAS bf16_t* At = (LAS bf16_t*)(L + RA_At); LAS bf16_t* Rt = (LAS bf16_t*)(L + RA_Rt); LAS bf16_t* Bt_ = (LAS bf16_t*)(L + RA_Bt); LAS bf16_t* Kt = (LAS bf16_t*)(L + RA_Kt);
    LAS bf16_t* AtT = (LAS bf16_t*)(L + RA_AtT); LAS bf16_t* BtT = (LAS bf16_t*)(L + RA_BtT); LAS bf16_t* KtT = (LAS bf16_t*)(L + RA_KtT); LAS bf16_t* VT = (LAS bf16_t*)(L + RA_VT);
    LAS float* cumb = (LAS float*)(L + RA_Nf); LAS float* NfT = (LAS float*)(L + RA_Nf);
    LAS bf16_t* MinvT = (LAS bf16_t*)(L + RA_MinvT); LAS bf16_t* AakT = (LAS bf16_t*)(L + RA_AakT); LAS bf16_t* AbrT = (LAS bf16_t*)(L + RA_AbrT); LAS bf16_t* AkrT = (LAS bf16_t*)(L + RA_AkrT);
    LAS bf16_t* XHm = At; LAS bf16_t* UGm = Kt; LAS bf16_t* UHm = Bt_;
    LAS bf16_t* GT = (LAS bf16_t*)(L + RA_Nf); LAS bf16_t* QT = (LAS bf16_t*)(L + RA_Nf + 9216); LAS bf16_t* Hm = MinvT; LAS bf16_t* YHT = AakT;
    LAS float* WL = (LAS float*)(L + RA_WL); LAS float* seg = (LAS float*)(L + RA_SEG); LAS float* bon = (LAS float*)(L + RA_BON); LAS bf16_t* gblk = (LAS bf16_t*)(L + RA_GB); LAS bf16_t* vblk = (LAS bf16_t*)(L + RA_VB);
        int h, rbase, nvalid, sample, sb = 0;
        if (item < 4096) { const int q = item >> 11, rem = item & 2047; h = rem & 15; rbase = q * SEQ + (rem >> 4) * 64; nvalid = 64; sample = 0; }
        else { const int sid = item - 4096; sb = sid >> 4; h = sid & 15; rbase = 16384 + sb * DSEQ; nvalid = DSEQ; sample = 1; }
        const int t = tid >> 3, jp = tid & 7, j0 = 8 * jp, col = 64 * h + j0; const bool valid = t < nvalid;
        float rf[8], kf[8], vf[8], wpf[8], apf[8], lw[8], av[8], bv[8], kp[8];
        u32x4 vraw = {0u, 0u, 0u, 0u};
        if (have_pf) { unpack8(nx0, rf); unpack8(nx1, kf); vraw = nx2; unpack8(nx3, wpf); unpack8(nx4, apf); }
        else if (valid) {
            const size_t row = (size_t)(rbase + t);
            unpack8(*(const u32x4*)(Z + row * ZW + C_R + col), rf); unpack8(*(const u32x4*)(Z + row * ZW + C_RK + col), kf); vraw = *(const u32x4*)(Z + row * ZW + C_RV + col);
            unpack8(*(const u32x4*)(T + row * 3072 + col), wpf); unpack8(*(const u32x4*)(T + row * 3072 + 1024 + col), apf);
            if (sample) { *(LAS u32x4*)(gblk + t * RS + j0) = *(const u32x4*)(T + row * 3072 + 2048 + col); *(LAS u32x4*)(vblk + t * RS + j0) = vraw; }
        }
        unpack8(vraw, vf);
        {
            const float* pw0 = inp(c, I_W0) + (size_t)l * D + col; const float* pa0 = inp(c, I_A0) + (size_t)l * D + col; const float* pkk = inp(c, I_KK) + (size_t)l * D + col;
            const float* pka = inp(c, I_KA) + (size_t)l * D + col; const float* prk = inp(c, I_RK) + (size_t)l * D + col;
            float ssq = 0.f, bsum = 0.f;
#pragma unroll
            for (int e = 0; e < 8; ++e) {
                if (valid) {
                    const float wlog = -softplusf_(-(pw0[e] + wpf[e])) - 0.5f; lw[e] = -__expf(wlog);
                    const float a = sigmoidf_(pa0[e] + apf[e]); const float kk = kf[e] * pkk[e]; ssq += kk * kk;
                    kp[e] = kf[e] * (1.0f + (a - 1.0f) * pka[e]); bsum += rf[e] * kp[e] * prk[e]; av[e] = kk; bv[e] = a;
                } else { lw[e] = 0.f; rf[e] = 0.f; kp[e] = 0.f; av[e] = 0.f; bv[e] = 0.f; }
            }
            ssq += __shfl_xor(ssq, 1); ssq += __shfl_xor(ssq, 2); ssq += __shfl_xor(ssq, 4);
            bsum += __shfl_xor(bsum, 1); bsum += __shfl_xor(bsum, 2); bsum += __shfl_xor(bsum, 4);
            const float inv = __builtin_amdgcn_rsqf(fmaxf(ssq, 1e-24f));
#pragma unroll
            for (int e = 0; e < 8; ++e) { const float kk = av[e] * inv; av[e] = -kk; bv[e] = kk * bv[e]; }
            if (jp == 0) { bon[t] = bsum; if (!sample) bonus_g[(size_t)(rbase + t) * 16 + h] = bsum; }
        }
#pragma unroll
        for (int e = 0; e < 8; ++e) cumb[t * 64 + j0 + e] = lw[e];
        __syncthreads();
        {
            const int j = tid & 63, sg = tid >> 6; float cs[8], run = 0.f;
#pragma unroll
            for (int e = 0; e < 8; ++e) { run += cumb[(8 * sg + e) * 64 + j]; cs[e] = run; }
            seg[sg * 64 + j] = run;
            __syncthreads();
            float off = 0.f;
#pragma unroll
            for (int s2 = 0; s2 < 8; ++s2) if (s2 < sg) off += seg[s2 * 64 + j];
#pragma unroll
            for (int e = 0; e < 8; ++e) cumb[(8 * sg + e) * 64 + j] = cs[e] + off;
        }
        __syncthreads();
        {
            float cu[8], cp[8], a8[8], r8[8], b8[8], k8[8];
#pragma unroll
            for (int e = 0; e < 8; ++e) { cu[e] = cumb[t * 64 + j0 + e]; cp[e] = t > 0 ? cumb[(t - 1) * 64 + j0 + e] : 0.f; }
#pragma unroll
            for (int e = 0; e < 8; ++e) { const float E = __expf(cu[e]), Em = __expf(-cu[e]), Ep = __expf(cp[e]);
                a8[e] = av[e] * Ep; r8[e] = rf[e] * E; b8[e] = bv[e] * Em; k8[e] = kp[e] * Em; if (t == 63) WL[j0 + e] = E; }
            const u32x4 aw = pack8(a8), rw = pack8(r8), bw = pack8(b8), kw = pack8(k8);
            *(LAS u32x4*)(At + t * RS + j0) = aw; *(LAS u32x4*)(Rt + t * RS + j0) = rw; *(LAS u32x4*)(Bt_ + t * RS + j0) = bw; *(LAS u32x4*)(Kt + t * RS + j0) = kw;
            *(LAS u32x4*)(MinvT + t * RS + j0) = vraw;
        }
        __syncthreads();
        LAUNDER2();
        {
            const int dp = tid & 31, so = (tid >> 5) & 7, which = tid >> 8;
#pragma unroll
            for (int a2 = 0; a2 < 2; ++a2) {
                const int arr = which + 2 * a2;
                const LAS bf16_t* src = arr == 0 ? At : (arr == 1 ? Bt_ : (arr == 2 ? Kt : MinvT));
                LAS bf16_t* dst = arr == 0 ? AtT : (arr == 1 ? BtT : (arr == 2 ? KtT : VT));
                unsigned wv[8];
#pragma unroll
                for (int e = 0; e < 8; ++e) wv[e] = *(const LAS unsigned*)(src + (8 * so + e) * RS + 2 * dp);
                u32x4 lo, hi;
                lo.x = (wv[0] & 0xffffu) | (wv[1] << 16); lo.y = (wv[2] & 0xffffu) | (wv[3] << 16); lo.z = (wv[4] & 0xffffu) | (wv[5] << 16); lo.w = (wv[6] & 0xffffu) | (wv[7] << 16);
                hi.x = (wv[0] >> 16) | (wv[1] & 0xffff0000u); hi.y = (wv[2] >> 16) | (wv[3] & 0xffff0000u); hi.z = (wv[4] >> 16) | (wv[5] & 0xffff0000u); hi.w = (wv[6] >> 16) | (wv[7] & 0xffff0000u);
                *(LAS u32x4*)(dst + (2 * dp) * RS + 8 * so) = lo; *(LAS u32x4*)(dst + (2 * dp + 1) * RS + 8 * so) = hi;
            }
        }
        {
            const int rt = w; const LAS bf16_t* Arow = (rt < 4 ? Bt_ + 16 * rt * RS : Kt + 16 * (rt - 4) * RS);
            f32x4 res[8];
#pragma unroll
            for (int ct = 0; ct < 8; ++ct) { f32x4 a = {0.f, 0.f, 0.f, 0.f}; res[ct] = mma_tile(Arow, RS, (ct < 4 ? At + 16 * ct * RS : Rt + 16 * (ct - 4) * RS), RS, 64, a, lane); }
#pragma unroll
            for (int ct = 0; ct < 8; ++ct) {
                const int s0 = 16 * (rt & 3) + (lane >> 4) * 4, tt = 16 * (ct & 3) + (lane & 15);
                f32x4 a = res[ct];
                if (ct < 4) {
#pragma unroll
                    for (int r = 0; r < 4; ++r) a[r] = (s0 + r < tt) ? a[r] : 0.f;
                    if (rt < 4) *(LAS f32x4*)(NfT + tt * 68 + s0) = a;
                    else { u32x2 wv; wv.x = pk2(a[0], a[1]); wv.y = pk2(a[2], a[3]); *(LAS u32x2*)(AakT + tt * RS + s0) = wv; }
                } else {
#pragma unroll
                    for (int r = 0; r < 4; ++r) a[r] = (s0 + r <= tt) ? a[r] : 0.f;
                    u32x2 wv; wv.x = pk2(a[0], a[1]); wv.y = pk2(a[2], a[3]);
                    if (rt < 4) *(LAS u32x2*)(AbrT + tt * RS + s0) = wv; else *(LAS u32x2*)(AkrT + tt * RS + s0) = wv;
                }
            }
        }
        __syncthreads();
        LAUNDER2();
        if (w == 0) {
            float M[64];
#pragma unroll
            for (int tt = 0; tt < 64; ++tt) {
                float a4[4] = {(lane == tt) ? 1.f : 0.f, 0.f, 0.f, 0.f};
#pragma unroll
                for (int p4 = 0; p4 < (tt + 3) / 4; ++p4) {
                    const f32x4 nv = *(const LAS f32x4*)(NfT + tt * 68 + 4 * p4);
#pragma unroll
                    for (int e = 0; e < 4; ++e) if (4 * p4 + e < tt) a4[e] += M[4 * p4 + e] * nv[e];
                }
                const float a = (a4[0] + a4[1]) + (a4[2] + a4[3]);
                M[tt] = a;
                MinvT[tt * RS + lane] = f2bf(a);
            }
        } else {
            for (int tl = w - 1; tl < 16; tl += 7) {
                const int ti = tl >> 2, tp = tl & 3; f32x4 a = {0.f, 0.f, 0.f, 0.f};
                a = mma_tile(VT + 16 * ti * RS, RS, AakT + 16 * tp * RS, RS, 64, a, lane);
#pragma unroll
                for (int r = 0; r < 4; ++r) XHm[(16 * ti + (lane >> 4) * 4 + r) * RS + 16 * tp + (lane & 15)] = f2bf(a[r]);
            }
        }
        __syncthreads();
        LAUNDER2();
#pragma unroll
        for (int k = 0; k < 4; ++k) {
            const int id = 4 * w + k, rtile = id >> 2, tt4 = id & 3; f32x4 a = {0.f, 0.f, 0.f, 0.f};
            a = mma_tile((rtile < 4 ? AtT + 16 * rtile * RS : XHm + 16 * (rtile - 4) * RS), RS, MinvT + 16 * tt4 * RS, RS, 64, a, lane);
            LAS bf16_t* dst = rtile < 4 ? UGm + 16 * rtile * RS : UHm + 16 * (rtile - 4) * RS;
#pragma unroll
            for (int r = 0; r < 4; ++r) dst[((lane >> 4) * 4 + r) * RS + 16 * tt4 + (lane & 15)] = f2bf(a[r]);
        }
        __syncthreads();
        LAUNDER2();
#pragma unroll
        for (int k = 0; k < 8; ++k) {
            const int mat = k >> 1, tile = w + 8 * (k & 1), ta = tile >> 2, tb = tile & 3, r0 = 16 * ta + (lane >> 4) * 4, cc = 16 * tb + (lane & 15);
            f32x4 a = {0.f, 0.f, 0.f, 0.f};
            if (mat == 0) {
                a = mma_tile(UGm + 16 * ta * RS, RS, BtT + 16 * tb * RS, RS, 64, a, lane);
                const float wl = WL[cc];
#pragma unroll
                for (int r = 0; r < 4; ++r) a[r] = (a[r] + ((r0 + r == cc) ? 1.f : 0.f)) * wl;
                u32x2 wv; wv.x = pk2(a[0], a[1]); wv.y = pk2(a[2], a[3]); *(LAS u32x2*)(GT + cc * RS + r0) = wv;
            } else if (mat == 1) {
                a = mma_tile(UHm + 16 * ta * RS, RS, BtT + 16 * tb * RS, RS, 64, a, lane);
                a = mma_tile(VT + 16 * ta * RS, RS, KtT + 16 * tb * RS, RS, 64, a, lane);
                const float wl = WL[cc];
#pragma unroll
                for (int r = 0; r < 4; ++r) Hm[(r0 + r) * RS + cc] = f2bf(a[r] * wl);
            } else if (mat == 2) {
                a = mma_tile(UGm + 16 * ta * RS, RS, AbrT + 16 * tb * RS, RS, 64, a, lane);
                const u32x2 rr = *(const LAS u32x2*)(Rt + cc * RS + r0);
                u32x2 wv; wv.x = pk2(a[0] + bflo(rr.x), a[1] + bfhi(rr.x)); wv.y = pk2(a[2] + bflo(rr.y), a[3] + bfhi(rr.y)); *(LAS u32x2*)(QT + cc * RS + r0) = wv;
            } else {
                a = mma_tile(UHm + 16 * ta * RS, RS, AbrT + 16 * tb * RS, RS, 64, a, lane);
                a = mma_tile(VT + 16 * ta * RS, RS, AkrT + 16 * tb * RS, RS, 64, a, lane);
                u32x2 wv; wv.x = pk2(a[0], a[1]); wv.y = pk2(a[2], a[3]); *(LAS u32x2*)(YHT + cc * RS + r0) = wv;
            }
        }
        __syncthreads();
        LAUNDER2();
        RA_PREFETCH(item + c.G - 64);
        if (!sample) {
            const int row = tid >> 3, pc = tid & 7; const size_t gr = (size_t)(rbase + row);
            *(u32x4*)(Z + gr * ZW + C_R + 64 * h + 8 * pc) = *(const LAS u32x4*)(GT + row * RS + 8 * pc);
            *(u32x4*)(Z + gr * ZW + C_RK + 64 * h + 8 * pc) = *(const LAS u32x4*)(QT + row * RS + 8 * pc);
            *(u32x4*)(T + gr * 3072 + 64 * h + 8 * pc) = *(const LAS u32x4*)(Hm + row * RS + 8 * pc);
            *(u32x4*)(T + gr * 3072 + 1024 + 64 * h + 8 * pc) = *(const LAS u32x4*)(YHT + row * RS + 8 * pc);
        } else {
            LAS bf16_t* S0b = AtT; LAS float* yT = (LAS float*)(L + RA_BtT);
            {
                const int i = tid >> 3, jq = tid & 7; float sf[8];
                const float* sp = inp(c, I_SRS) + ((((size_t)l * DB + sb) * 16 + h) * 64 + i) * 64 + 8 * jq;
#pragma unroll
                for (int e = 0; e < 8; ++e) sf[e] = sp[e];
                *(LAS u32x4*)(S0b + i * RS + 8 * jq) = pack8(sf);
            }
            __syncthreads();
            f32x4 sacc[4];
            rwkv_apply_tiles(w, lane, S0b, GT, QT, Hm, YHT, yT, sacc);
            if (w < 4) {
                float* os = outg(c) + O_SRS + (((size_t)l * DB + sb) * 16 + h) * 4096;
#pragma unroll
                for (int b = 0; b < 4; ++b)
#pragma unroll
                    for (int r = 0; r < 4; ++r) os[(size_t)(16 * w + (lane >> 4) * 4 + r) * 64 + 16 * b + (lane & 15)] = sacc[b][r];
            }
            __syncthreads();
            float lnw[8], lnb[8];
#pragma unroll
            for (int e = 0; e < 8; ++e) { lnw[e] = inp(c, I_LNW)[(size_t)l * D + 64 * h + 8 * (tid & 7) + e]; lnb[e] = inp(c, I_LNB)[(size_t)l * D + 64 * h + 8 * (tid & 7) + e]; }
            rwkv_post(tid, yT, vblk, gblk, bon, lnw, lnb, Z + (size_t)rbase * ZW + C_R + 64 * h, nvalid);
        }
        __syncthreads();
    }
}

constexpr int RB_S0 = 0, RB_YT = 9216, RB_BUF = 25856, RB_BUFSZ = 55552;
__device__ __forceinline__ void rwkv_rb_chain(const Ctx& c, unsigned& epoch, int p, int l, int q, int h) {
    bf16_t* Z = (bf16_t*)(wsg(c) + WS_Z); const bf16_t* T = (const bf16_t*)(wsg(c) + WS_T); const float* bonus_g = (const float*)(wsg(c) + WS_BONUS);
    const int tid = c.tid, lane = c.lane, w = c.wave; const Seq sq = seq_of(p, q);
    LAS unsigned char* L = c.lds; asm volatile("" : "+v"(L));
    LAS bf16_t* S0b = (LAS bf16_t*)(L + RB_S0); LAS float* yT = (LAS float*)(L + RB_YT);
    const int row = tid >> 3, pc = tid & 7, NCH = SEQ / 64;
    float lnw[8], lnb[8];
#pragma unroll
    for (int e = 0; e < 8; ++e) { lnw[e] = inp(c, I_LNW)[(size_t)l * D + 64 * h + 8 * pc + e]; lnb[e] = inp(c, I_LNB)[(size_t)l * D + 64 * h + 8 * pc + e]; }
    { unsigned zz = 0u; asm volatile("" : "+v"(zz)); const u32x4 z4 = {zz, zz, zz, zz}; *(LAS u32x4*)(S0b + row * RS + 8 * pc) = z4; }
    f32x4 sacc[4];
#pragma unroll
    for (int b = 0; b < 4; ++b) sacc[b] = (f32x4){0.f, 0.f, 0.f, 0.f};
    u32x4 pg, pq, ph, py, pv, pgb; float pbon = 0.f;
#define RB_LOAD(RB) do { const size_t gr = (size_t)((RB) + row); \
        pg = *(const u32x4*)(Z + gr * ZW + C_R + 64 * h + 8 * pc); pq = *(const u32x4*)(Z + gr * ZW + C_RK + 64 * h + 8 * pc); pv = *(const u32x4*)(Z + gr * ZW + C_RV + 64 * h + 8 * pc); \
        ph = *(const u32x4*)(T + gr * 3072 + 64 * h + 8 * pc); py = *(const u32x4*)(T + gr * 3072 + 1024 + 64 * h + 8 * pc); pgb = *(const u32x4*)(T + gr * 3072 + 2048 + 64 * h + 8 * pc); \
        if (tid < 64) pbon = bonus_g[(size_t)((RB) + tid) * 16 + h]; } while (0)
#define RB_PARK(BUF) do { LAS unsigned char* bb_ = L + RB_BUF + (BUF) * RB_BUFSZ; const int o_ = (row * RS + 8 * pc) * 2; \
        *(LAS u32x4*)(bb_ + o_) = pg; *(LAS u32x4*)(bb_ + 9216 + o_) = pq; *(LAS u32x4*)(bb_ + 18432 + o_) = ph; *(LAS u32x4*)(bb_ + 27648 + o_) = py; \
        *(LAS u32x4*)(bb_ + 36864 + o_) = pv; *(LAS u32x4*)(bb_ + 46080 + o_) = pgb; if (tid < 64) ((LAS float*)(bb_ + 55296))[tid] = pbon; } while (0)
    RB_LOAD(sq.row0); RB_PARK(0); RB_LOAD(sq.row0 + 64);
    __syncthreads();
    for (int ck = 0; ck < NCH; ++ck) {
        const int rbase = sq.row0 + ck * 64, cur = ck & 1;
        LAS unsigned char* bb = L + RB_BUF + cur * RB_BUFSZ;
        rwkv_apply_tiles(w, lane, S0b, (const LAS bf16_t*)bb, (const LAS bf16_t*)(bb + 9216), (const LAS bf16_t*)(bb + 18432), (const LAS bf16_t*)(bb + 27648), yT, sacc);
        __syncthreads();
        if (w < 4) {
#pragma unroll
            for (int b = 0; b < 4; ++b)
#pragma unroll
                for (int r = 0; r < 4; ++r) S0b[(16 * w + (lane >> 4) * 4 + r) * RS + 16 * b + (lane & 15)] = f2bf(sacc[b][r]);
        }
        rwkv_post(tid, yT, (const LAS bf16_t*)(bb + 36864), (const LAS bf16_t*)(bb + 46080), (const LAS float*)(bb + 55296), lnw, lnb, Z + (size_t)rbase * ZW + C_R + 64 * h, 64);
        if (ck + 1 < NCH) { RB_PARK(cur ^ 1); if (ck + 2 < NCH) RB_LOAD(rbase + 128); }
        __syncthreads();
        if (ck == 15 || ck == 79) grid_bar((unsigned*)(wsg(c) + WS_BAR), epoch, (unsigned)gridDim.x);
    }
#undef RB_LOAD
#undef RB_PARK
    if (w < 4) {
        float* os = outg(c) + O_PRS + (((size_t)l * NB + sq.b) * 16 + h) * 4096;
#pragma unroll
        for (int b = 0; b < 4; ++b)
#pragma unroll
            for (int r = 0; r < 4; ++r) os[(size_t)(16 * w + (lane >> 4) * 4 + r) * 64 + 16 * b + (lane & 15)] = sacc[b][r];
    }
}

__device__ __forceinline__ void phase_seqmix_a(const Ctx& c, int p, int l) {
    if (c.bid < 64) { const int q = c.bid >> 5, h = (c.bid >> 3) & 3, slab = c.bid & 7; mlstm_task(c, p, l, q, h, slab); }
    else {
        phase_rwkv_ra(c, p, l);
        if (p == 1) { const int nw = c.G - 64, wgi = c.bid - 64;
            for (int t = wgi; t < 512; t += nw) { const int q = 2 + (t >> 5), h = (t >> 3) & 3, slab = t & 7; mlstm_task(c, p, l, q, h, slab); } }
    }
}

__device__ __forceinline__ void phase_om(const Ctx& c, int p, int l) {
    bf16_t* Z = (bf16_t*)(wsg(c) + WS_Z); const int nrows = pass_rows(p), lane = c.lane, head = lane >> 4, part = lane & 15, col = 256 * head + 16 * part;
    float nm[16];
#pragma unroll
    for (int e = 0; e < 16; ++e) nm[e] = inp(c, I_MNORM)[(size_t)l * D + col + e];
    for (int r = c.bid * 8 + c.wave; r < nrows; r += c.G * 8) {
        float hv[16], zo[16];
        unpack8(*(const u32x4*)(Z + (size_t)r * ZW + C_V + col), *(float(*)[8])&hv[0]); unpack8(*(const u32x4*)(Z + (size_t)r * ZW + C_V + col + 8), *(float(*)[8])&hv[8]);
        unpack8(*(const u32x4*)(Z + (size_t)r * ZW + C_O + col), *(float(*)[8])&zo[0]); unpack8(*(const u32x4*)(Z + (size_t)r * ZW + C_O + col + 8), *(float(*)[8])&zo[8]);
        float s = 0.f;
#pragma unroll
        for (int e = 0; e < 16; ++e) s += hv[e];
        s += __shfl_xor(s, 1); s += __shfl_xor(s, 2); s += __shfl_xor(s, 4); s += __shfl_xor(s, 8);
        const float mean = s * (1.0f / 256.0f); float q = 0.f;
#pragma unroll
        for (int e = 0; e < 16; ++e) { hv[e] -= mean; q += hv[e] * hv[e]; }
        q += __shfl_xor(q, 1); q += __shfl_xor(q, 2); q += __shfl_xor(q, 4); q += __shfl_xor(q, 8);
        const float rstd = __builtin_amdgcn_rsqf(q * (1.0f / 256.0f) + 1e-6f);
        float o0[8], o1[8];
#pragma unroll
        for (int e = 0; e < 8; ++e) { o0[e] = sigmoidf_(zo[e]) * hv[e] * rstd * nm[e]; o1[e] = sigmoidf_(zo[8 + e]) * hv[8 + e] * rstd * nm[8 + e]; }
        *(u32x4*)(Z + (size_t)r * ZW + C_O + col) = pack8(o0); *(u32x4*)(Z + (size_t)r * ZW + C_O + col + 8) = pack8(o1);
    }
}

__global__ void __launch_bounds__(NTHREADS, 2) mega_fwd(Args args) {
    extern __shared__ __attribute__((aligned(16))) unsigned char lds_raw[];
    cg::grid_group grid = cg::this_grid();
    Ctx c; c.out = args.out; c.ws = args.ws; c.lds = (LAS unsigned char*)lds_raw;
    c.tid = threadIdx.x; c.lane = c.tid & 63; c.wave = __builtin_amdgcn_readfirstlane(c.tid >> 6); c.G = gridDim.x; c.bid = blockIdx.x; c.dry = 0;
    if (c.tid < N_IN) { const unsigned long long v = (unsigned long long)args.in[c.tid]; LAS unsigned* t = (LAS unsigned*)(c.lds + TAB_OFF); t[2 * c.tid] = (unsigned)v; t[2 * c.tid + 1] = (unsigned)(v >> 32); }
    __syncthreads();
    const int lo = args.ph_lo, hi = args.ph_hi; int ph = 0;
    unsigned epoch = 0u;
    grid.sync();
#define GSYNC() grid_bar((unsigned*)(wsg(c) + WS_BAR), epoch, (unsigned)gridDim.x)
#define W ((bf16_t*)wsg(c))
#define UP ((bf16_t*)(wsg(c) + WS_UP))
#define Zb ((bf16_t*)(wsg(c) + WS_Z))
#define Tb ((bf16_t*)(wsg(c) + WS_T))
#define X (outg(c))
#define PH(body) do { if (ph >= lo && ph < hi) { asm volatile("" : "+v"(c.tid), "+v"(c.lane), "+s"(c.bid), "+s"(c.wave), "+s"(c.G), "+s"(c.ws), "+s"(c.out), "+s"(c.lds)); body; if (ph + 1 < hi) GSYNC(); } ++ph; } while (0)
#define PHD(grp, body) PH(body)
    for (int l = 0; l < 2; ++l) {
        for (int st = 0; st < 3; ++st) {
            if (st != 1) {
                const int f = st >> 1;
                PH((f == 0 ? phase_cvt(c, l) : (void)0, phase_norm(c, (l == 0 && f == 0) ? inp(c, I_XP) : nullptr, inp(c, I_XS), X, 0, NTOK, inp(c, f ? I_F2N : I_F1N) + (size_t)l * D, Tb, nullptr, nullptr)));
                PHD(1, run_gemm(c, Tb, D, W + (f ? W_GU2 : W_GU1) / 2, D, NTOK, 2 * FF, D, 0, 0, EpiSwiglu{Zb}));
                PH((run_gemm(c, Zb, FF, W + (f ? W_D2 : W_D1) / 2, FF, NPROMPT, D, FF, 0, 0, EpiResAdd{X, (l == 0 && f == 0) ? inp(c, I_XP) : (const float*)X, 0.5f}),
                    run_gemm_splitk(c, Zb + (size_t)NPROMPT * FF, FF, W + (f ? W_D2 : W_D1) / 2, FF, FF, X + (size_t)NPROMPT * D, 0.5f)));
            } else {
                for (int p = 0; p < 2; ++p) {
                    const int Mp = pass_rows(p), g0 = p * 16384;
                    PH(phase_norm(c, nullptr, nullptr, X, g0, Mp, inp(c, I_MIXN) + (size_t)l * D, UP, (const float*)(wsg(c) + W_IF), (float*)(wsg(c) + WS_GIF)));
                    PHD(1, run_gemm(c, UP, D, W + W_IN / 2, D, Mp, ZW, D, 0, 0, EpiStore{Zb, ZW, 0}));
                    PH(phase_cv1(c, p, l));
                    PH(phase_cv2(c, p, l));
                    PH(run_gemm(c, Zb + C_LRU, ZW, W + W_LRU / 2, 256, Mp, 2048, 256, 4, 256, EpiStore{Tb, 2048, 0}));
                    PH((phase_lru<0>(c, p, l), phase_mlstm_s(c, p, l)));
                    PH(phase_lru<1>(c, p, l));
                    PH(run_gemm(c, Zb + C_WD, ZW, W + W_LORA / 2, 256, Mp, 3072, 256, 0, 0, EpiStore{Tb, 3072, 0}));
                    PHD(2, phase_seqmix_a(c, p, l));
                    {
                        asm volatile("" : "+v"(c.tid), "+v"(c.lane), "+s"(c.bid), "+s"(c.wave), "+s"(c.G), "+s"(c.ws), "+s"(c.out), "+s"(c.lds));
                        if (c.bid < 32) { rwkv_rb_chain(c, epoch, p, l, c.bid >> 4, c.bid & 15); GSYNC(); }
                        else {
                            Ctx c2 = c; c2.bid = c.bid - 32; c2.G = c.G - 32;
                            phase_om(c2, p, l); GSYNC();
                            asm volatile("" : "+v"(c2.tid), "+v"(c2.lane));
                            run_gemm(c2, (bf16_t*)(wsg(c2) + WS_UP), D, (bf16_t*)wsg(c2) + W_G / 2, D, Mp, 3072, D, 0, 0, EpiStore{(bf16_t*)(wsg(c2) + WS_Z), ZW, C_Q}); GSYNC();
                            for (int b = 0; b < 2; ++b) {
                                asm volatile("" : "+v"(c2.tid), "+v"(c2.lane));
                                run_gemm(c2, (bf16_t*)(wsg(c2) + WS_Z) + (b == 0 ? C_LRU : C_O), ZW, (bf16_t*)wsg(c2) + W_BR / 2 + (size_t)b * D * D, D, Mp, D, D, 0, 0, EpiMerge{(bf16_t*)(wsg(c2) + WS_UP), (const bf16_t*)(wsg(c2) + WS_Z), C_Q + 1024 * b, b == 0});
                            }
                            GSYNC();
                        }
                    }
                    PH(run_gemm(c, Zb + C_R, ZW, W + W_BR / 2 + (size_t)2 * D * D, D, Mp, D, D, 0, 0, EpiMerge{UP, Zb, C_Q + 2048, 0}));
                    PH(run_gemm(c, UP, D, W + W_OUT / 2, D, Mp, D, D, 0, 0, EpiResAdd{X + (size_t)g0 * D, X + (size_t)g0 * D, 1.0f}));
                }
            }
        }
    }
    PH(phase_final_norm(c, X, inp(c, I_FN)));
#undef PH
#undef GSYNC
#undef PHD
#undef W
#undef UP
#undef Zb
#undef Tb
#undef X
}

extern "C" void kernel_launch(void* const* d_in, const int* in_sizes, int n_in, void* d_out, int out_size, void* d_ws, size_t ws_size, hipStream_t stream) {
    static int grid = 0;
    if (grid == 0) {
        if (n_in != N_IN || (size_t)out_size != O_END || ws_size < WS_END) { fprintf(stderr, "kernel_launch: unexpected shapes n_in %d out %d ws %zu\n", n_in, out_size, ws_size); grid = -1; return; }
        int dev = 0, cus = 0, per_cu = 0;
        hipGetDevice(&dev); hipDeviceGetAttribute(&cus, hipDeviceAttributeMultiprocessorCount, dev);
        if (hipFuncSetAttribute((const void*)mega_fwd, hipFuncAttributeMaxDynamicSharedMemorySize, LDS_BYTES) != hipSuccess) { fprintf(stderr, "hipFuncSetAttribute failed\n"); grid = -1; return; }
        hipOccupancyMaxActiveBlocksPerMultiprocessor(&per_cu, (const void*)mega_fwd, NTHREADS, LDS_BYTES);
        (void)hipGetLastError();
        if (per_cu < 1) per_cu = 1;
        grid = cus;
        if (grid > 256) grid = 256;
    }
    if (grid < 0) return;
    if (hipMemsetAsync((char*)d_ws + WS_BAR, 0, 4096, stream) != hipSuccess) { fprintf(stderr, "memset failed\n"); return; }
    Args a{};
    for (int i = 0; i < N_IN; ++i) a.in[i] = (const float*)d_in[i];
    a.out = (float*)d_out; a.ws = (unsigned char*)d_ws; a.ph_lo = 0; a.ph_hi = 1000;
    void* kargs[] = {&a};
    hipError_t e = hipLaunchCooperativeKernel((const void*)mega_fwd, dim3(grid), dim3(NTHREADS), kargs, LDS_BYTES, stream);
    if (e != hipSuccess) fprintf(stderr, "cooperative launch failed: %s (grid %d)\n", hipGetErrorString(e), grid);
}
```
